# Optimizing an MI355X kernel written in HIP

```python
import math
import jax, jax.numpy as jnp
from jax import lax
import numpy as np

D_MODEL = 1024
BATCH = 4
SEQ = 4096
DEPTH = 4

CHUNK = 64
N_MIXERS = 3
EPS = 1e-6

POOL_WINDOWS = (2, 4, 8, 16)
N_POOL_GROUPS = len(POOL_WINDOWS)
POOL_GROUP = D_MODEL // N_POOL_GROUPS

SB_HEAD_DIM = 64
SB_HEADS = D_MODEL // SB_HEAD_DIM
Q_BLOCK = 128

S5_GROUP = 16
S5_GROUPS = D_MODEL // S5_GROUP
S5_STATE = 64
S5_DT_MIN = 1e-3
S5_DT_MAX = 1e-1

MEM_LEN = 256
XA_HEADS = 4
XA_HEAD_DIM = D_MODEL // XA_HEADS

D_FF = ((8 * D_MODEL // 3 + 127) // 128) * 128
CONV_WIDTH = 3

N_POOL_LAYERS = (DEPTH + 2) // 3
N_SB_LAYERS = (DEPTH + 1) // 3
N_S5_LAYERS = DEPTH // 3

kernel_name = "hybrid_pool_stickbreak_s5_streaming_trunk"


def rms_norm(x, g):
    xf = x.astype(jnp.float32)
    y = xf * lax.rsqrt(jnp.mean(xf * xf, axis=-1, keepdims=True) + EPS)
    return (y * g.astype(jnp.float32)).astype(x.dtype)


def causal_shift(x, k):
    return jnp.pad(x, ((0, 0), (k, 0), (0, 0)))[:, : x.shape[1]]


def pool_mixer(h, w, scale):
    B, S, D = h.shape
    hf = h.astype(jnp.float32)
    cs = jnp.cumsum(hf, axis=1)
    counts = jnp.arange(1, S + 1, dtype=jnp.float32)
    groups = []
    for gi, win in enumerate(POOL_WINDOWS):
        sl = slice(gi * POOL_GROUP, (gi + 1) * POOL_GROUP)
        c = cs[..., sl]
        win_sum = c - causal_shift(c, win)
        cnt = jnp.minimum(counts, float(win))[None, :, None]
        groups.append(win_sum / cnt - hf[..., sl])
    p = jnp.stack(groups, axis=2).astype(h.dtype)
    y = jnp.einsum('bsgc,gcd->bsgd', p, w).reshape(B, S, D)
    return y * scale


def stick_breaking_attention(h, w_qkv, w_o):
    B, S, D = h.shape
    qkv = (h @ w_qkv).reshape(B, S, 3, SB_HEADS, SB_HEAD_DIM)
    q, k, v = qkv[:, :, 0], qkv[:, :, 1], qkv[:, :, 2]
    scale = SB_HEAD_DIM ** -0.5
    outs = []
    for i in range(S // Q_BLOCK):
        q0 = i * Q_BLOCK
        kend = q0 + Q_BLOCK
        z = jnp.einsum('bqhd,bkhd->bhqk', q[:, q0:kend], k[:, :kend]).astype(jnp.float32) * scale
        qpos = q0 + jnp.arange(Q_BLOCK)
        kpos = jnp.arange(kend)
        mask = kpos[None, :] < qpos[:, None]
        log_one_minus = jnp.where(mask, jax.nn.log_sigmoid(-z), 0.0)
        between = lax.cumsum(log_one_minus, axis=3, reverse=True) - log_one_minus
        a = jnp.where(mask, jnp.exp(jax.nn.log_sigmoid(z) + between), 0.0)
        outs.append(jnp.einsum('bhqk,bkhd->bqhd', a.astype(v.dtype), v[:, :kend]))
    o = jnp.concatenate(outs, axis=1).reshape(B, S, D)
    return o @ w_o


def _lin_rec_combine(left, right):
    a1, b1 = left
    a2, b2 = right
    return a1 * a2, a2 * b1 + b2


def s5_mixer(h, a_re, a_im, log_dt, b_re, b_im, c_re, c_im, d, w_glu):
    B, S, D = h.shape
    f32 = jnp.float32
    u = h.astype(f32)
    lam = lax.complex(a_re.astype(f32), a_im.astype(f32))
    dt = jnp.exp(log_dt.astype(f32))[:, None]
    dt_lam = lam * dt
    a_bar = jnp.exp(dt_lam)
    b_bar = ((a_bar - 1.0) / lam)[..., None] * lax.complex(b_re.astype(f32), b_im.astype(f32))
    c_mat = lax.complex(c_re.astype(f32), c_im.astype(f32))
    steps = jnp.arange(1, CHUNK + 1, dtype=f32)
    a_pow = jnp.exp(steps[:, None, None] * dt_lam[None])
    n_chunks = S // CHUNK
    u_chunks = u.reshape(B, n_chunks, CHUNK, S5_GROUPS, S5_GROUP).transpose(1, 0, 2, 3, 4)

    def chunk_step(state, u_blk):
        bu = jnp.einsum('bcgi,gpi->bcgp', u_blk.astype(jnp.complex64), b_bar)
        a_seq = jnp.broadcast_to(a_bar, bu.shape)
        _, xs = lax.associative_scan(_lin_rec_combine, (a_seq, bu), axis=1)
        xs = xs + a_pow[None] * state[:, None]
        y = jnp.real(jnp.einsum('bcgp,gip->bcgi', xs, c_mat))
        return xs[:, -1], y

    state0 = jnp.zeros((B, S5_GROUPS, S5_STATE), jnp.complex64)
    _, ys = lax.scan(chunk_step, state0, u_chunks)
    y = ys.transpose(1, 0, 2, 3, 4).reshape(B, S, D) + d.astype(f32) * u
    y = jax.nn.gelu(y).astype(h.dtype)
    val, gate = jnp.split(y @ w_glu, 2, axis=-1)
    return val * jax.nn.sigmoid(gate)


def memory_cross_attention(h, mem_n, wq, wkv, wo):
    B, S, D = h.shape
    M = mem_n.shape[1]
    q = (h @ wq).reshape(B, S, XA_HEADS, XA_HEAD_DIM)
    kv = (mem_n @ wkv).reshape(B, M, 2, XA_HEADS, XA_HEAD_DIM)
    k, v = kv[:, :, 0], kv[:, :, 1]
    s = jnp.einsum('bshd,bmhd->bhsm', q, k).astype(jnp.float32) * (XA_HEAD_DIM ** -0.5)
    p = jax.nn.softmax(s, axis=-1).astype(v.dtype)
    o = jnp.einsum('bhsm,bmhd->bshd', p, v).reshape(B, S, D)
    return o @ wo


def conv_glu_ffn(h, w_up, conv_w, conv_b, w_down):
    u = h @ w_up
    u = sum(conv_w[CONV_WIDTH - 1 - k] * causal_shift(u, k) for k in range(CONV_WIDTH)) + conv_b
    val, gate = jnp.split(u, 2, axis=-1)
    return (jax.nn.silu(gate) * val) @ w_down


def setup_inputs(seed: int = 0) -> dict:
    key = jax.random.key(seed)
    keys = iter(jax.random.split(key, 40))
    f32 = jnp.float32

    def nrm(shape, scale):
        return jax.random.normal(next(keys), shape, f32) * scale

    def gain(shape):
        return 1.0 + nrm(shape, 0.02)

    D, F = D_MODEL, D_FF
    G, P, Cg = S5_GROUPS, S5_STATE, S5_GROUP
    a_im_init = jnp.pi * jnp.arange(P, dtype=f32)
    return {
        "x": nrm((BATCH, SEQ, D), 1.0),
        "mem": nrm((BATCH, MEM_LEN, D), 1.0),
        "mix_norm_g": gain((DEPTH, D)),
        "pool_w": nrm((N_POOL_LAYERS, N_POOL_GROUPS, POOL_GROUP, POOL_GROUP), POOL_GROUP ** -0.5),
        "pool_scale": gain((N_POOL_LAYERS, D)),
        "sb_w_qkv": nrm((N_SB_LAYERS, D, 3 * D), D ** -0.5),
        "sb_w_o": nrm((N_SB_LAYERS, D, D), D ** -0.5),
        "s5_a_re": -0.5 + nrm((N_S5_LAYERS, G, P), 0.01),
        "s5_a_im": a_im_init + nrm((N_S5_LAYERS, G, P), 0.01),
        "s5_log_dt": jax.random.uniform(next(keys), (N_S5_LAYERS, G), f32,
                                        minval=math.log(S5_DT_MIN), maxval=math.log(S5_DT_MAX)),
        "s5_b_re": nrm((N_S5_LAYERS, G, P, Cg), (2 * Cg) ** -0.5),
        "s5_b_im": nrm((N_S5_LAYERS, G, P, Cg), (2 * Cg) ** -0.5),
        "s5_c_re": nrm((N_S5_LAYERS, G, Cg, P), (2 * P) ** -0.5),
        "s5_c_im": nrm((N_S5_LAYERS, G, Cg, P), (2 * P) ** -0.5),
        "s5_d": nrm((N_S5_LAYERS, D), 1.0),
        "s5_w_glu": nrm((N_S5_LAYERS, D, 2 * D), D ** -0.5),
        "xa_norm_g": gain((DEPTH, D)),
        "mem_norm_g": gain((DEPTH, D)),
        "xa_wq": nrm((DEPTH, D, D), D ** -0.5),
        "xa_wkv": nrm((DEPTH, D, 2 * D), D ** -0.5),
        "xa_wo": nrm((DEPTH, D, D), D ** -0.5),
        "ffn_norm_g": gain((DEPTH, D)),
        "ffn_w_up": nrm((DEPTH, D, 2 * F), D ** -0.5),
        "ffn_conv_w": nrm((DEPTH, CONV_WIDTH, 2 * F), CONV_WIDTH ** -0.5),
        "ffn_conv_b": nrm((DEPTH, 2 * F), 0.01),
        "ffn_w_down": nrm((DEPTH, F, D), F ** -0.5),
        "final_norm_g": gain((D,)),
    }


def reference(x, mem, mix_norm_g, pool_w, pool_scale, sb_w_qkv, sb_w_o,
              s5_a_re, s5_a_im, s5_log_dt, s5_b_re, s5_b_im, s5_c_re, s5_c_im, s5_d, s5_w_glu,
              xa_norm_g, mem_norm_g, xa_wq, xa_wkv, xa_wo,
              ffn_norm_g, ffn_w_up, ffn_conv_w, ffn_conv_b, ffn_w_down, final_norm_g):
    h = x
    for i in range(DEPTH):
        kind = i % N_MIXERS
        j = i // N_MIXERS
        hn = rms_norm(h, mix_norm_g[i])
        if kind == 0:
            t = pool_mixer(hn, pool_w[j], pool_scale[j])
        elif kind == 1:
            t = stick_breaking_attention(hn, sb_w_qkv[j], sb_w_o[j])
        else:
            t = s5_mixer(hn, s5_a_re[j], s5_a_im[j], s5_log_dt[j], s5_b_re[j], s5_b_im[j],
                         s5_c_re[j], s5_c_im[j], s5_d[j], s5_w_glu[j])
        h = h + t.astype(h.dtype)
        m = memory_cross_attention(rms_norm(h, xa_norm_g[i]), rms_norm(mem, mem_norm_g[i]),
                                   xa_wq[i], xa_wkv[i], xa_wo[i])
        h = h + m.astype(h.dtype)
        f = conv_glu_ffn(rms_norm(h, ffn_norm_g[i]), ffn_w_up[i], ffn_conv_w[i], ffn_conv_b[i], ffn_w_down[i])
        h = h + f.astype(h.dtype)
    return rms_norm(h, final_norm_g)
```

```cpp
#include <hip/hip_runtime.h>
#include <hip/hip_cooperative_groups.h>
#include <cstdio>
#include <cstdint>
namespace cg = cooperative_groups;
#define HYBRID 0
#define OPT_MASK 63
#define DUP 0
#define SEAMS 1
#define MK_SP2 1
#define MK_BAUX 0
#define MK_AAUX 0
namespace mk {
#define LAS __attribute__((address_space(3)))
typedef unsigned short bf16_t;
typedef short bf16x8 __attribute__((ext_vector_type(8)));
typedef float f32x4 __attribute__((ext_vector_type(4)));
typedef float f32x16 __attribute__((ext_vector_type(16)));
typedef float f32x2 __attribute__((ext_vector_type(2)));
typedef unsigned u32x4 __attribute__((ext_vector_type(4)));
typedef unsigned u32x2 __attribute__((ext_vector_type(2)));
typedef __bf16 bf16x2_t __attribute__((ext_vector_type(2)));
constexpr int T = 16384, D = 1024, SEQ = 4096, FF = 2816, NB = 4;
constexpr float EPS = 1e-6f, LOG2E = 1.4426950408889634f;
constexpr int BM = 256, BK = 64, HALF = 128, HTB = HALF * BK * 2, STAGE_BYTES = 8 * HTB, NXCD = 8, WGM = 8;
constexpr int XLDS_OFF = STAGE_BYTES;
constexpr int LDS_BYTES = 147456;

__device__ __forceinline__ unsigned cvtpk(float lo, float hi) { f32x2 v = {lo, hi}; bf16x2_t b = __builtin_convertvector(v, bf16x2_t); return __builtin_bit_cast(unsigned, b); }
__device__ __forceinline__ float bf2f(bf16_t b) { return __builtin_bit_cast(float, (unsigned)b << 16); }
__device__ __forceinline__ float fast_exp2(float x) { return __builtin_amdgcn_exp2f(x); }
__device__ __forceinline__ float fast_log2(float x) { return __builtin_amdgcn_logf(x); }
__device__ __forceinline__ float fast_rcp(float x) { return __builtin_amdgcn_rcpf(x); }
__device__ __forceinline__ float sigmoidf_(float x) { return fast_rcp(1.f + fast_exp2(-x * LOG2E)); }
__device__ __forceinline__ int lane_id_v() { int l; asm volatile("v_mbcnt_lo_u32_b32 %0, -1, 0\n\tv_mbcnt_hi_u32_b32 %0, -1, %0" : "=v"(l)); return l; }
__device__ __forceinline__ float shx(float v, int mask, int lane) { return __builtin_bit_cast(float, __builtin_amdgcn_ds_bpermute((lane ^ mask) << 2, __builtin_bit_cast(int, v))); }
__device__ __forceinline__ float wave_sum(float v, int lane) {
#pragma unroll
    for (int o = 1; o < 64; o <<= 1) v += shx(v, o, lane);
    return v;
}
template <int CTRL> __device__ __forceinline__ float dppf(float v) { return __builtin_bit_cast(float, __builtin_amdgcn_update_dpp(0, __builtin_bit_cast(int, v), CTRL, 0xf, 0xf, false)); }

__host__ __device__ __forceinline__ int lds_byte(int r, int c) { const int st = (r >> 4) * 2 + (c >> 5), rr = r & 15, cc = c & 31, ob = rr * 64 + cc * 2; return st * 1024 + (ob ^ (((ob >> 9) & 1) << 5)); }
__host__ __device__ __forceinline__ void stage_rc(int b, int& R, int& C) { const int st = b / 1024, sb = b % 1024, swz = sb ^ (((sb >> 9) & 1) << 5); R = (st >> 1) * 16 + swz / 64; C = (st & 1) * 32 + (swz % 64) / 2; }
__host__ __device__ __forceinline__ int perm_sw(int rho) { const int n = rho >> 4, i = rho & 15, q = i >> 2, j = i & 3; return 16 * n + 8 * (q & 1) + 4 * (q >> 1) + j; }
__host__ __device__ __forceinline__ int perm32(int rho) { const int n = rho >> 4, i = rho & 15; return 8 * (i >> 2) + 4 * n + (i & 3); }

struct Unit { int pm, pn; };
struct GemmDesc { int lda, ldb, K; };

struct Sched {
    int kind, nM, nN, nwg, G, c, bdiv;
    const char* A; const char* B;
    long a_pm, a_pn, a_pb, b_pm, b_pn, b_pb;
    unsigned* done_cnt; unsigned* wait_cnt; int wait_target, done_kind, wait_kind;
    __device__ __forceinline__ void wait_one(unsigned* w) const {
        unsigned sp = 0; while (__builtin_amdgcn_readfirstlane(__hip_atomic_load(w, __ATOMIC_RELAXED, __HIP_MEMORY_SCOPE_AGENT)) < (unsigned)wait_target) { __builtin_amdgcn_s_sleep(2); if (++sp > (1u << 20)) break; }
    }
    __device__ __forceinline__ void a_ready(const Unit& u, int wid) const {
        if (!wait_cnt) return;
        if (wid == 0) {
            if (wait_kind == 0) wait_one(wait_cnt + u.pm);
            __builtin_amdgcn_fence(__ATOMIC_ACQUIRE, "agent"); asm volatile("s_waitcnt vmcnt(0)" ::: "memory");
        }
        __builtin_amdgcn_s_barrier(); asm volatile("" ::: "memory");
    }
    __device__ __forceinline__ void done(const Unit& u, int wid, int lane) const {
        if (!done_cnt) return;
        asm volatile("s_waitcnt vmcnt(0)" ::: "memory"); __builtin_amdgcn_s_barrier(); asm volatile("" ::: "memory");
        if (wid == 0 && lane == 0) { __builtin_amdgcn_fence(__ATOMIC_RELEASE, "agent"); asm volatile("s_waitcnt vmcnt(0)" ::: "memory");
            __hip_atomic_fetch_add(done_cnt + u.pm, 1u, __ATOMIC_RELAXED, __HIP_MEMORY_SCOPE_AGENT); }
    }
    __device__ __forceinline__ bool next(int i, Unit& u) const {
        const long L = (long)i * G + c; if (L >= nwg) return false;
        int wgid = (int)L;
        if (kind >= 2) { u.pm = wgid; u.pn = 0; return true; }
        { const int q = nwg / NXCD, r = nwg % NXCD, xcd = wgid % NXCD, off = wgid / NXCD; wgid = (xcd < r ? xcd * (q + 1) : r * (q + 1) + (xcd - r) * q) + off; }
        const int nig = WGM * nN, gid = wgid / nig, fm = gid * WGM, gsz = (nM - fm) < WGM ? (nM - fm) : WGM;
        u.pm = fm + ((wgid % nig) % gsz); u.pn = (wgid % nig) / gsz; return true;
    }
    __device__ __forceinline__ void base(const Unit& u, const char*& a, const char*& b) const {
        if (kind == 0) { const int pb = u.pm / bdiv; a = A + u.pm * a_pm + u.pn * a_pn + pb * a_pb; b = B + u.pm * b_pm + u.pn * b_pn + pb * b_pb; }
        else if (kind == 1) { const int bt = u.pm / 17, j = u.pm % 17; int o0 = 254 * j; if (o0 > 3842) o0 = 3842; const long start = (long)bt * SEQ + o0 - 2; a = A + start * a_pm; b = B + u.pn * b_pn; }
        else if (kind == 2) { const int L = u.pm, layer = L >> 5, r = L & 31, tm = r >> 3, tn = r & 7;
            a = A + (long)tm * 256 * 2048; b = B + (long)layer * b_pb + (long)tn * 256 * 2048; }
        else if (kind == 3) { const int L = u.pm, layer = L >> 6, r = L & 63, bt = r >> 4, hh = (r >> 2) & 3, kt = r & 3;
            a = A + (long)layer * a_pb + (long)bt * 256 * 4096 + hh * 512; b = B + (long)layer * b_pb + (long)kt * 256 * 2048 + hh * 512; }
        else { const int L = u.pm, layer = L >> 6, r = L & 63, bt = r >> 4, hh = (r >> 2) & 3, nt = r & 3;
            a = A + (long)layer * a_pb + (long)nt * 256 * 2048 + hh * 512; b = B + (long)layer * b_pb + (long)bt * 256 * 4096 + (1024 + hh * 256) * 2; }
    }
};
__device__ __forceinline__ Sched make_sched(int nM, int nN, const void* A, long a_pm, long a_pn, const void* B, long b_pm, long b_pn, int bdiv = 1 << 30, long a_pb = 0, long b_pb = 0) {
    Sched s; s.done_cnt = nullptr; s.wait_cnt = nullptr; s.wait_target = 0; s.done_kind = 0; s.wait_kind = 0; s.kind = 0; s.nM = nM; s.nN = nN; s.nwg = nM * nN; s.G = gridDim.x; s.c = blockIdx.x; s.bdiv = bdiv; s.A = (const char*)A; s.B = (const char*)B;
    s.a_pm = a_pm; s.a_pn = a_pn; s.a_pb = a_pb; s.b_pm = b_pm; s.b_pn = b_pn; s.b_pb = b_pb; return s;
}

template <class Epi>
__device__ __forceinline__ void gemm_phase(LAS unsigned char* lds, const GemmDesc g, const Sched& S, const Epi& E, int wv) {
    int tid_ = wv * 64 + lane_id_v();
    const int tid = tid_, wid = __builtin_amdgcn_readfirstlane(tid >> 6), lane = tid & 63, wr = wid >> 2, wc = wid & 3, fr = lane & 15, fq = lane >> 4;
    const int K = g.K, nt = K / BK;
    unsigned voffA[2], voffB[2];
#pragma unroll
    for (int i = 0; i < 2; ++i) { int R, C; stage_rc(tid * 16 + i * 8192, R, C); const int Rb = (int)Epi::PERM == 2 ? ((R & ~31) + perm_sw(R & 31)) : (int)Epi::PERM == 1 ? ((R & ~31) + perm32(R & 31)) : R;
        voffA[i] = (unsigned)(R * g.lda + C) * 2u; voffB[i] = (unsigned)(Rb * g.ldb + C) * 2u; }
    const size_t kstep = (size_t)(BK * 2);
    const size_t hstepA = (size_t)HALF * g.lda * 2, hstepB = (size_t)HALF * g.ldb * 2;
    const unsigned ldsw = (unsigned)wid * 1024u;
    const int aoff = lds_byte(wr * 64 + fr, fq * 8), boff = lds_byte(wc * 32 + fr, fq * 8);
#define PG8_SA(b, h) (((b) * 2 + (h)) * HTB)
#define PG8_SB(b, h) ((4 + (b) * 2 + (h)) * HTB)
#define PG8_STAGE(bufoff, gbase, voff) do { _Pragma("unroll") for (int _i = 0; _i < 2; ++_i) \
        __builtin_amdgcn_global_load_lds((const unsigned*)((const char*)(gbase) + (voff)[_i]), (LAS unsigned*)(lds + (bufoff) + ldsw + _i * 8192), 16, 0, 0); } while (0)
#define PG8_LDA(dst, b, h) do { _Pragma("unroll") for (int m = 0; m < 4; ++m) _Pragma("unroll") for (int k = 0; k < 2; ++k) dst[m][k] = *(const LAS bf16x8*)(lds + PG8_SA(b, h) + aoff + m * 2048 + k * 1024); } while (0)
#define PG8_LDB(dst, b, h) do { _Pragma("unroll") for (int n = 0; n < 2; ++n) _Pragma("unroll") for (int k = 0; k < 2; ++k) dst[n][k] = *(const LAS bf16x8*)(lds + PG8_SB(b, h) + boff + n * 2048 + k * 1024); } while (0)
#define PG8_MMA(ai, bj, At, Bt) do { __builtin_amdgcn_s_setprio(1); _Pragma("unroll") for (int m = 0; m < 4; ++m) _Pragma("unroll") for (int n = 0; n < 2; ++n) _Pragma("unroll") for (int k = 0; k < 2; ++k) \
        acc[ai][bj][m][n] = __builtin_amdgcn_mfma_f32_16x16x32_bf16(Bt[n][k], At[m][k], acc[ai][bj][m][n], 0, 0, 0); __builtin_amdgcn_s_setprio(0); } while (0)
#define PG8_WAIT_V(n) asm volatile("s_waitcnt vmcnt(" #n ")" ::: "memory")
#define PG8_WAIT_L(n) asm volatile("s_waitcnt lgkmcnt(" #n ")" ::: "memory")
#define PG8_BAR __builtin_amdgcn_s_barrier()
#define PG8_SCHED __builtin_amdgcn_sched_barrier(0)
    Unit cur, nxt; int ui = 0;
    if (!S.next(0, cur)) return;
    f32x4 acc[2][2][4][2];
#pragma unroll
    for (int a = 0; a < 2; ++a)
#pragma unroll
        for (int b = 0; b < 2; ++b)
#pragma unroll
            for (int m = 0; m < 4; ++m)
#pragma unroll
                for (int n = 0; n < 2; ++n) acc[a][b][m][n] = (f32x4){0.f, 0.f, 0.f, 0.f};
    bf16x8 At[4][2], B0[2][2], B1[2][2];
    const char* cA; const char* cB; S.base(cur, cA, cB);
    S.a_ready(cur, wid);
    PG8_STAGE(PG8_SB(0, 0), cB, voffB); PG8_STAGE(PG8_SB(0, 1), cB + hstepB, voffB); PG8_STAGE(PG8_SA(0, 0), cA, voffA); PG8_STAGE(PG8_SA(0, 1), cA + hstepA, voffA);
    if (wr == 1) PG8_BAR;
    PG8_WAIT_V(2); PG8_BAR;
    PG8_STAGE(PG8_SB(1, 0), cB + kstep, voffB); PG8_STAGE(PG8_SA(1, 0), cA + kstep, voffA); PG8_STAGE(PG8_SB(1, 1), cB + hstepB + kstep, voffB);
    PG8_WAIT_V(6); PG8_BAR;
    for (;;) {
        const bool has_next = S.next(ui + 1, nxt);
        const char* nA = cA; const char* nB = cB; if (has_next) S.base(nxt, nA, nB);
        for (int t = 0; t < nt; t += 2) {
            const bool last = (t == nt - 2);
            if (last && has_next) S.a_ready(nxt, wid);
            const char* a1 = cA + (size_t)(t + 1) * kstep;
            const char* a2 = last ? nA : cA + (size_t)(t + 2) * kstep; const char* b2 = last ? nB : cB + (size_t)(t + 2) * kstep;
            const char* a3 = a2 + kstep; const char* b3 = b2 + kstep;
            PG8_LDB(B0, 0, 0); PG8_LDB(B1, 0, 1); PG8_SCHED; PG8_LDA(At, 0, 0); PG8_STAGE(PG8_SA(1, 1), a1 + hstepA, voffA);
            PG8_WAIT_V(8); PG8_WAIT_L(0); PG8_BAR; PG8_MMA(0, 0, At, B0); PG8_MMA(0, 1, At, B1); PG8_BAR; PG8_SCHED;
            PG8_LDA(At, 0, 1); PG8_STAGE(PG8_SB(0, 0), b2, voffB); PG8_STAGE(PG8_SB(0, 1), b2 + hstepB, voffB); PG8_STAGE(PG8_SA(0, 0), a2, voffA);
            PG8_WAIT_V(8); PG8_WAIT_L(0); PG8_BAR; PG8_MMA(1, 0, At, B0); PG8_MMA(1, 1, At, B1); PG8_BAR; PG8_SCHED;
            PG8_LDB(B0, 1, 0); PG8_LDB(B1, 1, 1); PG8_SCHED; PG8_LDA(At, 1, 0); PG8_STAGE(PG8_SA(0, 1), a2 + hstepA, voffA);
            PG8_WAIT_V(8); PG8_WAIT_L(0); PG8_BAR; PG8_MMA(0, 0, At, B0); PG8_MMA(0, 1, At, B1); PG8_BAR; PG8_SCHED;
            PG8_LDA(At, 1, 1); PG8_STAGE(PG8_SB(1, 0), b3, voffB); PG8_STAGE(PG8_SB(1, 1), b3 + hstepB, voffB); PG8_STAGE(PG8_SA(1, 0), a3, voffA);
            PG8_WAIT_V(8); PG8_WAIT_L(0); PG8_BAR; PG8_MMA(1, 0, At, B0); PG8_MMA(1, 1, At, B1); PG8_BAR; PG8_SCHED;
        }
        if (wr == 0) PG8_BAR;
        { int fr_e = fr, fq_e = fq; asm volatile("" : "+v"(fr_e), "+v"(fq_e)); E(acc, cur, wr, wc, fr_e, fq_e); }
        S.done(cur, wid, lane);
        if (!has_next) break;
#pragma unroll
        for (int a = 0; a < 2; ++a)
#pragma unroll
            for (int b = 0; b < 2; ++b)
#pragma unroll
                for (int m = 0; m < 4; ++m)
#pragma unroll
                    for (int n = 0; n < 2; ++n) acc[a][b][m][n] = (f32x4){0.f, 0.f, 0.f, 0.f};
        cur = nxt; cA = nA; cB = nB; ++ui;
        if (wr == 1) PG8_BAR;
    }
    PG8_WAIT_V(0);
    PG8_BAR;
#undef PG8_SA
#undef PG8_SB
#undef PG8_STAGE
#undef PG8_LDA
#undef PG8_LDB
#undef PG8_MMA
#undef PG8_WAIT_V
#undef PG8_WAIT_L
#undef PG8_SCHED
}
#define MK_BAR() do { asm volatile("s_waitcnt vmcnt(0) lgkmcnt(0)" ::: "memory"); __builtin_amdgcn_s_barrier(); asm volatile("" ::: "memory"); } while (0)
#define MK_LBAR() do { asm volatile("s_waitcnt lgkmcnt(0)" ::: "memory"); __builtin_amdgcn_s_barrier(); asm volatile("" ::: "memory"); } while (0)

typedef f32x4 AccT[2][2][4][2];
__device__ __forceinline__ f32x4 unpack_bf4(u32x2 w) { f32x4 r; r[0] = __builtin_bit_cast(float, w.x << 16); r[1] = __builtin_bit_cast(float, w.x & 0xffff0000u); r[2] = __builtin_bit_cast(float, w.y << 16); r[3] = __builtin_bit_cast(float, w.y & 0xffff0000u); return r; }
__device__ __forceinline__ f32x4 load_hilo4(const bf16_t* hi, const bf16_t* lo, size_t off) { return unpack_bf4(*(const u32x2*)(hi + off)) + unpack_bf4(*(const u32x2*)(lo + off)); }
__device__ __forceinline__ void load_hilo8(const bf16_t* hi, const bf16_t* lo, size_t off, f32x4& a, f32x4& b) { const u32x4 h4 = *(const u32x4*)(hi + off), l4 = *(const u32x4*)(lo + off);
    u32x2 ha, hb_, la, lb; ha.x = h4.x; ha.y = h4.y; hb_.x = h4.z; hb_.y = h4.w; la.x = l4.x; la.y = l4.y; lb.x = l4.z; lb.y = l4.w; a = unpack_bf4(ha) + unpack_bf4(la); b = unpack_bf4(hb_) + unpack_bf4(lb); }
__device__ __forceinline__ void store_hilo4(bf16_t* hi, bf16_t* lo, size_t off, f32x4 v) { u32x2 w; w.x = cvtpk(v[0], v[1]); w.y = cvtpk(v[2], v[3]); const f32x4 d = v - unpack_bf4(w); u32x2 l; l.x = cvtpk(d[0], d[1]); l.y = cvtpk(d[2], d[3]);
    *(u32x2*)(hi + off) = w; *(u32x2*)(lo + off) = l; }
__device__ __forceinline__ float rs_of(const float* rsq, int row) { return rsqrtf(rsq[row] * (1.f / D) + EPS); }

struct EpiBf {
    static constexpr bool PERM = true;
    bf16_t* O; int ldc; long o_pm, o_pn; const float* rsq; const float* csq;
    __device__ __forceinline__ void operator()(const AccT& acc, const Unit& u, int wr, int wc, int fr, int fq) const {
        bf16_t* base = O + u.pm * o_pm + u.pn * o_pn;
        float cs[2][8];
#pragma unroll
        for (int bj = 0; bj < 2; ++bj)
#pragma unroll
            for (int e = 0; e < 8; ++e) cs[bj][e] = csq ? rs_of(csq, u.pn * 256 + bj * HALF + wc * 32 + 8 * fq + e) : 1.f;
#pragma unroll
        for (int ai = 0; ai < 2; ++ai)
#pragma unroll
            for (int m = 0; m < 4; ++m) { const int row = ai * HALF + wr * 64 + m * 16 + fr; const float r = rsq ? rs_of(rsq, u.pm * 256 + row) : 1.f;
#pragma unroll
                for (int bj = 0; bj < 2; ++bj) { const f32x4 v0 = acc[ai][bj][m][0], v1 = acc[ai][bj][m][1]; u32x4 w;
                    w.x = cvtpk(v0[0] * r * cs[bj][0], v0[1] * r * cs[bj][1]); w.y = cvtpk(v0[2] * r * cs[bj][2], v0[3] * r * cs[bj][3]);
                    w.z = cvtpk(v1[0] * r * cs[bj][4], v1[1] * r * cs[bj][5]); w.w = cvtpk(v1[2] * r * cs[bj][6], v1[3] * r * cs[bj][7]);
                    *(u32x4*)(base + (size_t)row * ldc + bj * HALF + wc * 32 + 8 * fq) = w; } }
    }
};
struct EpiKV {
    static constexpr bool PERM = true;
    bf16_t* KV; const float* msq;
    __device__ __forceinline__ void operator()(const AccT& acc, const Unit& u, int wr, int wc, int fr, int fq) const {
        const int L = u.pm, layer = L >> 5, r = L & 31, tm = r >> 3, tn = r & 7;
        EpiBf e; e.ldc = 2048; e.o_pm = 256 * 2048; e.o_pn = 256; e.O = KV + (size_t)layer * 1024 * 2048; e.rsq = msq; e.csq = nullptr; Unit v; v.pm = tm; v.pn = tn;
        e(acc, v, wr, wc, fr, fq);
    }
};
template <int ISN> struct EpiMN {
    static constexpr bool PERM = true;
    bf16_t* O;
    __device__ __forceinline__ void operator()(const AccT& acc, const Unit& u, int wr, int wc, int fr, int fq) const {
        const int L = u.pm, layer = L >> 6, r = L & 63, bt = r >> 4, hh = (r >> 2) & 3, t4 = r & 3;
        EpiBf e; e.ldc = 1024; e.o_pm = 256 * 1024; e.o_pn = 256; e.O = O + ((size_t)layer * 4 + bt) * 1024 * 1024; e.rsq = nullptr; e.csq = nullptr; Unit v;
        if (!ISN) { v.pm = hh; v.pn = t4; } else { v.pm = t4; v.pn = hh; }
        e(acc, v, wr, wc, fr, fq);
    }
};
template <int GLU> struct EpiRes {
    static constexpr bool PERM = true;
    const float* base32; bf16_t* hi; bf16_t* lo; float* rsq; LAS float* xl;
    __device__ __forceinline__ void operator()(const AccT& acc, const Unit& u, int wr, int wc, int fr, int fq) const {
        constexpr int NBJ = GLU ? 1 : 2;
#pragma unroll
        for (int q = 0; q < 4; ++q) { const int ai = q >> 1, m0 = (q & 1) * 2;
            f32x4 bv[2][NBJ][2];
#pragma unroll
            for (int mm = 0; mm < 2; ++mm) { const int row = u.pm * 256 + ai * HALF + wr * 64 + (m0 + mm) * 16 + fr;
#pragma unroll
                for (int bj = 0; bj < NBJ; ++bj) { const int col = GLU ? (u.pn * 128 + wc * 32 + 8 * fq) : (u.pn * 256 + bj * HALF + wc * 32 + 8 * fq); const size_t off = (size_t)row * D + col;
                    if (base32) { bv[mm][bj][0] = *(const f32x4*)(base32 + off); bv[mm][bj][1] = *(const f32x4*)(base32 + off + 4); }
                    else { const u32x4 h4 = *(const u32x4*)(hi + off), l4 = *(const u32x4*)(lo + off); u32x2 ha, hb_, la, lb; ha.x = h4.x; ha.y = h4.y; hb_.x = h4.z; hb_.y = h4.w; la.x = l4.x; la.y = l4.y; lb.x = l4.z; lb.y = l4.w;
                        bv[mm][bj][0] = unpack_bf4(ha) + unpack_bf4(la); bv[mm][bj][1] = unpack_bf4(hb_) + unpack_bf4(lb); } } }
#pragma unroll
            for (int mm = 0; mm < 2; ++mm) { const int m = m0 + mm; const int row = u.pm * 256 + ai * HALF + wr * 64 + m * 16 + fr; float ss = 0.f;
#pragma unroll
                for (int bj = 0; bj < NBJ; ++bj) { const int col = GLU ? (u.pn * 128 + wc * 32 + 8 * fq) : (u.pn * 256 + bj * HALF + wc * 32 + 8 * fq); const size_t off = (size_t)row * D + col;
                    f32x4 v[2];
#pragma unroll
                    for (int n = 0; n < 2; ++n) { f32x4 t = acc[ai][bj][m][n];
                        if (GLU) { const f32x4 gt = acc[ai][1][m][n]; t[0] *= sigmoidf_(gt[0]); t[1] *= sigmoidf_(gt[1]); t[2] *= sigmoidf_(gt[2]); t[3] *= sigmoidf_(gt[3]); }
                        t = t + bv[mm][bj][n]; v[n] = t; ss += (t[0] * t[0] + t[1] * t[1]) + (t[2] * t[2] + t[3] * t[3]); }
                    u32x4 h4; h4.x = cvtpk(v[0][0], v[0][1]); h4.y = cvtpk(v[0][2], v[0][3]); h4.z = cvtpk(v[1][0], v[1][1]); h4.w = cvtpk(v[1][2], v[1][3]);
                    u32x2 ha, hb_; ha.x = h4.x; ha.y = h4.y; hb_.x = h4.z; hb_.y = h4.w; const f32x4 d0 = v[0] - unpack_bf4(ha), d1 = v[1] - unpack_bf4(hb_);
                    u32x4 l4; l4.x = cvtpk(d0[0], d0[1]); l4.y = cvtpk(d0[2], d0[3]); l4.z = cvtpk(d1[0], d1[1]); l4.w = cvtpk(d1[2], d1[3]);
                    *(u32x4*)(hi + off) = h4; *(u32x4*)(lo + off) = l4; }
                ss += shx(ss, 16, fq * 16 + fr); ss += shx(ss, 32, fq * 16 + fr);
                if (fq == 0) xl[wc * 256 + ai * HALF + wr * 64 + m * 16 + fr] = ss; }
        }
        MK_LBAR();
        { const int t = (wr * 4 + wc) * 64 + fq * 16 + fr; if (t < 256) { const float s = (xl[t] + xl[256 + t]) + (xl[512 + t] + xl[768 + t]); __hip_atomic_fetch_add(rsq + u.pm * 256 + t, s, __ATOMIC_RELAXED, __HIP_MEMORY_SCOPE_AGENT); } }
    }
};
struct EpiSoftmax {
    static constexpr bool PERM = true;
    bf16_t* P; LAS float* xl; const float* rsq;
    __device__ __forceinline__ void operator()(AccT& acc, const Unit& u, int wr, int wc, int fr, int fq) const {
        LAS float* mx = xl; LAS float* sm = xl + 1024;
#pragma unroll
        for (int ai = 0; ai < 2; ++ai)
#pragma unroll
            for (int m = 0; m < 4; ++m) { float mm = -3.0e38f; const float rr = rs_of(rsq, u.pm * 256 + ai * HALF + wr * 64 + m * 16 + fr);
#pragma unroll
                for (int bj = 0; bj < 2; ++bj)
#pragma unroll
                    for (int n = 0; n < 2; ++n) { const f32x4 v = acc[ai][bj][m][n] * rr; acc[ai][bj][m][n] = v; mm = fmaxf(mm, fmaxf(fmaxf(v[0], v[1]), fmaxf(v[2], v[3]))); }
                mm = fmaxf(mm, shx(mm, 16, fq * 16 + fr)); mm = fmaxf(mm, shx(mm, 32, fq * 16 + fr));
                if (fq == 0) mx[wc * 256 + ai * HALF + wr * 64 + m * 16 + fr] = mm; }
        MK_LBAR();
#pragma unroll
        for (int ai = 0; ai < 2; ++ai)
#pragma unroll
            for (int m = 0; m < 4; ++m) { const int row = ai * HALF + wr * 64 + m * 16 + fr;
                const float mm = fmaxf(fmaxf(mx[row], mx[256 + row]), fmaxf(mx[512 + row], mx[768 + row])); float s = 0.f;
#pragma unroll
                for (int bj = 0; bj < 2; ++bj)
#pragma unroll
                    for (int n = 0; n < 2; ++n)
#pragma unroll
                        for (int j = 0; j < 4; ++j) { const float e = fast_exp2(acc[ai][bj][m][n][j] - mm); acc[ai][bj][m][n][j] = e; s += e; }
                s += shx(s, 16, fq * 16 + fr); s += shx(s, 32, fq * 16 + fr);
                if (fq == 0) sm[wc * 256 + row] = s; }
        MK_LBAR();
#pragma unroll
        for (int ai = 0; ai < 2; ++ai)
#pragma unroll
            for (int m = 0; m < 4; ++m) { int zo = 0; asm volatile("" : "+v"(zo)); const int row = ai * HALF + wr * 64 + m * 16 + fr + zo;
                const float inv = fast_rcp((sm[row] + sm[256 + row]) + (sm[512 + row] + sm[768 + row]));
#pragma unroll
                for (int bj = 0; bj < 2; ++bj) { const f32x4 v0 = acc[ai][bj][m][0], v1 = acc[ai][bj][m][1]; u32x4 w;
                    w.x = cvtpk(v0[0] * inv, v0[1] * inv); w.y = cvtpk(v0[2] * inv, v0[3] * inv);
                    w.z = cvtpk(v1[0] * inv, v1[1] * inv); w.w = cvtpk(v1[2] * inv, v1[3] * inv);
                    *(u32x4*)(P + (size_t)(u.pm * 256 + row) * D + u.pn * 256 + bj * HALF + wc * 32 + 8 * fq) = w; } }
    }
};
struct EpiConvGlu {
    static constexpr int PERM = 2;
    bf16_t* Gb; const float* rsq; const float* cw; const float* cb; LAS float* xl;
    __device__ __forceinline__ void operator()(AccT& acc, const Unit& u, int wr, int wc, int fr, int fq) const {
        const int bt = u.pm / 17, jt = u.pm % 17; int o0 = 254 * jt; if (o0 > 3842) o0 = 3842;
        const int tib0 = o0 - 2; const long tok0 = (long)bt * SEQ + tib0;
#pragma unroll
        for (int ai = 0; ai < 2; ++ai)
#pragma unroll
            for (int m = 0; m < 4; ++m) { const int R = ai * HALF + wr * 64 + m * 16 + fr; const bool ok = (tib0 + R) >= 0; const float r = ok ? rs_of(rsq, (int)(tok0 + R)) : 0.f;
#pragma unroll
                for (int bj = 0; bj < 2; ++bj)
#pragma unroll
                    for (int n = 0; n < 2; ++n) acc[ai][bj][m][n] = acc[ai][bj][m][n] * r; }
        if (fr >= 14) {
#pragma unroll
            for (int ai = 0; ai < 2; ++ai) { LAS float* hp = xl + ((((ai * 2 + wr) * 4 + wc) * 2 + (fr - 14)) * 4 + fq) * 16;
#pragma unroll
                for (int bj = 0; bj < 2; ++bj)
#pragma unroll
                    for (int n = 0; n < 2; ++n) *(LAS f32x4*)(hp + (bj * 2 + n) * 4) = acc[ai][bj][3][n]; }
        }
        MK_LBAR();
        const int f0 = u.pn * 128 + wc * 32 + 8 * (fq & 1) + 4 * (fq >> 1);
        unsigned dep = 0u;
#pragma unroll
        for (int n = 0; n < 2; ++n) {
            int zo = 0; asm volatile("" : "+v"(zo) : "v"(dep));
            const float* cwp = cw + f0 + 16 * n + zo; const float* cbp = cb + f0 + 16 * n + zo;
            f32x4 w0[2], w1[2], w2[2], bb[2];
#pragma unroll
            for (int bj = 0; bj < 2; ++bj) { w0[bj] = *(const f32x4*)(cwp + bj * FF); w1[bj] = *(const f32x4*)(cwp + 2 * FF + bj * FF); w2[bj] = *(const f32x4*)(cwp + 4 * FF + bj * FF); bb[bj] = *(const f32x4*)(cbp + bj * FF); }
#pragma unroll
            for (int ai = 0; ai < 2; ++ai) { const int grp = ai * 2 + wr;
                f32x4 pv[2]; u32x2 wprev; wprev.x = 0u; wprev.y = 0u;
#pragma unroll
                for (int bj = 0; bj < 2; ++bj) { f32x4 hv = (f32x4){0.f, 0.f, 0.f, 0.f};
                    if (grp > 0 && fr >= 14) hv = *(const LAS f32x4*)(xl + (((((grp - 1) * 4 + wc) * 2 + (fr - 14)) * 4 + fq) * 16) + (bj * 2 + n) * 4);
                    pv[bj] = hv; }
#pragma unroll
                for (int m = 0; m < 4; ++m) { const int R = ai * HALF + wr * 64 + m * 16 + fr;
                    f32x4 res[2];
#pragma unroll
                    for (int bj = 0; bj < 2; ++bj) { const f32x4 cur = acc[ai][bj][m][n]; f32x4 x1, x2;
#pragma unroll
                        for (int j = 0; j < 4; ++j) {
                            const float c1 = fr == 15 ? pv[bj][j] : cur[j], c2 = fr >= 14 ? pv[bj][j] : cur[j];
                            x1[j] = dppf<0x121>(c1); x2[j] = dppf<0x122>(c2); }
                        res[bj] = w2[bj] * cur + w1[bj] * x1 + w0[bj] * x2 + bb[bj]; pv[bj] = cur; }
                    f32x4 e4;
#pragma unroll
                    for (int j = 0; j < 4; ++j) e4[j] = fast_exp2(res[1][j] * -LOG2E);
                    e4 = e4 + 1.f;
#pragma unroll
                    for (int j = 0; j < 4; ++j) e4[j] = fast_rcp(e4[j]);
                    const f32x4 a = res[1] * e4 * res[0];
                    u32x2 w; w.x = cvtpk(a[0], a[1]); w.y = cvtpk(a[2], a[3]); dep = w.y;
                    if (!(m & 1)) wprev = w;
                    else {
                        const auto r0 = __builtin_amdgcn_permlane32_swap(wprev.x, w.x, false, false); const auto r1 = __builtin_amdgcn_permlane32_swap(wprev.y, w.y, false, false);
                        u32x4 w4; w4.x = r0[0]; w4.y = r1[0]; w4.z = r0[1]; w4.w = r1[1];
                        const int Rs = (fq < 2) ? R - 16 : R;
                        if (Rs >= 2) *(u32x4*)(Gb + (size_t)(tok0 + Rs) * FF + u.pn * 128 + wc * 32 + 16 * n + 8 * (fq & 1)) = w4; } } }
        }
        MK_LBAR();
    }
};
struct EpiS5S {
    static constexpr bool PERM = false;
    float* Sst;
    __device__ __forceinline__ void operator()(const AccT& acc, const Unit& u, int wr, int wc, int fr, int fq) const {
#pragma unroll
        for (int ai = 0; ai < 2; ++ai)
#pragma unroll
            for (int m = 0; m < 4; ++m) { const int row = u.pm * 256 + ai * HALF + wr * 64 + m * 16 + fr;
#pragma unroll
                for (int n = 0; n < 2; ++n) *(f32x4*)(Sst + (size_t)row * 128 + wc * 32 + n * 16 + fq * 4) = acc[ai][0][m][n]; }
    }
};
__device__ __forceinline__ float gelu_tanh(float x) { const float uu = 0.7978845608028654f * (x + 0.044715f * x * x * x); const float e = fast_exp2(2.f * LOG2E * uu); return x * (1.f - fast_rcp(1.f + e)); }
struct EpiS5Y {
    static constexpr bool PERM = false;
    bf16_t* Y; const bf16_t* Z; const float* dvec;
    __device__ __forceinline__ void operator()(const AccT& acc, const Unit& u, int wr, int wc, int fr, int fq) const {
        const int g = u.pm >> 2, mt = u.pm & 3;
#pragma unroll
        for (int ai = 0; ai < 2; ++ai)
#pragma unroll
            for (int m = 0; m < 4; ++m) { const int nrow = mt * 256 + ai * HALF + wr * 64 + m * 16 + fr;
#pragma unroll
                for (int bj = 0; bj < 2; ++bj)
#pragma unroll
                    for (int n = 0; n < 2; ++n) { const int col = bj * HALF + wc * 32 + n * 16 + fq * 4; const int t = col >> 4, i0 = col & 15;
                        const u32x2 uz = *(const u32x2*)(Z + ((size_t)g * 1024 + nrow) * 384 + col);
                        const float u0 = __builtin_bit_cast(float, uz.x << 16), u1 = __builtin_bit_cast(float, uz.x & 0xffff0000u), u2 = __builtin_bit_cast(float, uz.y << 16), u3 = __builtin_bit_cast(float, uz.y & 0xffff0000u);
                        const f32x4 dv = *(const f32x4*)(dvec + g * 16 + i0); const f32x4 a = acc[ai][bj][m][n];
                        u32x2 w; w.x = cvtpk(gelu_tanh(a[0] + dv[0] * u0), gelu_tanh(a[1] + dv[1] * u1)); w.y = cvtpk(gelu_tanh(a[2] + dv[2] * u2), gelu_tanh(a[3] + dv[3] * u3));
                        *(u32x2*)(Y + (size_t)(nrow * 16 + t) * D + g * 16 + i0) = w; } }
    }
};
}
namespace mk {
#define RLX_AGENT __ATOMIC_RELAXED, __HIP_MEMORY_SCOPE_AGENT
#define XB_TMO      128
#define XB_XCNT(j)  (256  + 64 * (j))
#define XB_XSUB(j)  (1280 + 64 * (j))
#define XB_XGEN(j)  (2304 + 64 * (j))
#define XB_TOP      3328
#define XB_TOPGEN   3392
#define XCD_BAR_WORDS 3456
#define XB_SPIN_CAP (1u << 18)

__device__ __forceinline__ unsigned xb_ld(unsigned* p)              { return __hip_atomic_load(p, __ATOMIC_RELAXED, __HIP_MEMORY_SCOPE_AGENT); }
__device__ __forceinline__ unsigned xb_add(unsigned* p, unsigned v) { return __hip_atomic_fetch_add(p, v, __ATOMIC_RELAXED, __HIP_MEMORY_SCOPE_AGENT); }
__device__ __forceinline__ unsigned xb_xcc_id() { return (unsigned)__builtin_amdgcn_s_getreg((3 << 11) | 20) & 0xFu; }
#define XB_SPIN(cond, bar) do { unsigned _sp = 0; while (cond) { __builtin_amdgcn_s_sleep(1); \
    if ((++_sp & 255u) == 0u) { if (xb_ld(&(bar)[XB_TMO])) break; if (_sp > XB_SPIN_CAP) { atomicAdd(&(bar)[XB_TMO], 1u); break; } } } } while (0)

struct XcdBarrier {
    unsigned* bar; unsigned x;
    volatile LAS unsigned* st;
};

__device__ __forceinline__ XcdBarrier xcd_barrier_post(unsigned* bar, volatile LAS unsigned* st) {
    XcdBarrier b; b.bar = bar; b.x = xb_xcc_id(); b.st = st;
    if (threadIdx.x == 0) (void)xb_add(&bar[XB_XCNT(b.x)], 1u);
    return b;
}
__device__ __forceinline__ void xcd_barrier_complete(unsigned* bar, unsigned x, unsigned& nloc, unsigned& nx) {
    const unsigned G = gridDim.x * gridDim.y * gridDim.z;
    unsigned sum, cnt, mine, sp = 0u;
    for (;;) {
        sum = 0u; cnt = 0u; mine = 0u;
#pragma unroll
        for (unsigned j = 0; j < 16; ++j) { const unsigned c = xb_ld(&bar[XB_XCNT(j)]); sum += c; cnt += (c > 0u) ? 1u : 0u; mine = (j == x) ? c : mine; }
        if (sum == G) break;
        __builtin_amdgcn_s_sleep(1);
        if ((++sp & 255u) == 0u) { if (xb_ld(&bar[XB_TMO])) break; if (sp > XB_SPIN_CAP) { atomicAdd(&bar[XB_TMO], 1u); break; } }
    }
    nloc = mine > 0u ? mine : 1u; nx = cnt > 0u ? cnt : 1u;
}

__device__ __forceinline__ void xcd_barrier(const XcdBarrier& b) {
    asm volatile("s_waitcnt vmcnt(0)" ::: "memory");
    __syncthreads();
    if (threadIdx.x == 0) {
        unsigned* bar = b.bar;
        __builtin_amdgcn_s_waitcnt(0);
        unsigned nloc = b.st[0], nx = b.st[1];
        if (nloc == 0u) { xcd_barrier_complete(bar, b.x, nloc, nx); b.st[0] = nloc; b.st[1] = nx; }
        const unsigned old = xb_add(&bar[XB_XSUB(b.x)], 1u);
        const unsigned gen = old / nloc;
        if (old + 1u == (gen + 1u) * nloc) {
            __builtin_amdgcn_fence(__ATOMIC_RELEASE, "agent");
            asm volatile("s_waitcnt vmcnt(0)" ::: "memory");
            const unsigned og = xb_add(&bar[XB_TOP], 1u);
            const unsigned tg = og / nx;
            if (og + 1u == (tg + 1u) * nx) xb_add(&bar[XB_TOPGEN], 1u);
            else XB_SPIN(xb_ld(&bar[XB_TOPGEN]) == tg, bar);
            __builtin_amdgcn_fence(__ATOMIC_ACQUIRE, "agent");
            xb_add(&bar[XB_XGEN(b.x)], 1u);
            asm volatile("s_waitcnt vmcnt(0)" ::: "memory");
        } else {
            XB_SPIN(xb_ld(&bar[XB_XGEN(b.x)]) == gen, bar);
            __builtin_amdgcn_fence(__ATOMIC_ACQUIRE, "agent");
            asm volatile("s_waitcnt vmcnt(0)" ::: "memory");
        }
    }
    __syncthreads();
}
}
namespace mk {
constexpr size_t MiB = 1u << 20;
constexpr size_t OFF_RS = 1 * MiB;
constexpr size_t OFF_W = 2 * MiB;
constexpr size_t OFF_WQP = 113 * MiB;
constexpr size_t OFF_HB = 122 * MiB;
constexpr size_t OFF_MEMB = 154 * MiB;
constexpr size_t OFF_KV = 156 * MiB;
constexpr size_t OFF_S5WB = 172 * MiB;
constexpr size_t OFF_S5TW = 180 * MiB;
constexpr size_t OFF_MT = 192 * MiB;
constexpr size_t OFF_NT = 224 * MiB;
constexpr size_t OFF_SCR = 256 * MiB;
constexpr size_t WS_NEED = 352 * MiB;
constexpr size_t W_PW = 0, W_QKV = 524288, W_SO = 3670016, W_GLU = 4718592, W_L0 = 6815744, W_LSTRIDE = 12845056;
constexpr size_t WL_Q = 0, WL_KV = 1048576, WL_O = 3145728, WL_UP = 4194304, WL_DN = 9961472;

struct P { const float* in[27]; float* out; unsigned char* ws; int lo, hi; };
__device__ __forceinline__ int otid(int wv) { return wv * 64 + lane_id_v(); }

__device__ __forceinline__ void transpose_item(const float* W, int ldw, int k0, int n0, bf16_t* WT, int ldk, int drow0, const float* sk, const float* sn, float cst, LAS float* scr, int lane) {
    float v[32];
#pragma unroll
    for (int i = 0; i < 32; ++i) { const int kk = 2 * i + (lane >> 5); v[i] = W[(size_t)(k0 + kk) * ldw + n0 + (lane & 31)]; }
#pragma unroll
    for (int i = 0; i < 32; ++i) { const int kk = 2 * i + (lane >> 5); scr[kk * 33 + (lane & 31)] = v[i]; }
    asm volatile("s_waitcnt lgkmcnt(0)" ::: "memory");
    const int c = lane & 7;
    f32x4 ka = (f32x4){1.f, 1.f, 1.f, 1.f}, kb = ka; if (sk) { ka = *(const f32x4*)(sk + k0 + 8 * c); kb = *(const f32x4*)(sk + k0 + 8 * c + 4); }
#pragma unroll
    for (int j = 0; j < 4; ++j) { const int n = (lane >> 3) + 8 * j; const LAS float* s = scr + (8 * c) * 33 + n; const float sc = cst * (sn ? sn[n0 + n] : 1.f);
        u32x4 o; o.x = cvtpk(s[0 * 33] * sc * ka[0], s[1 * 33] * sc * ka[1]); o.y = cvtpk(s[2 * 33] * sc * ka[2], s[3 * 33] * sc * ka[3]); o.z = cvtpk(s[4 * 33] * sc * kb[0], s[5 * 33] * sc * kb[1]); o.w = cvtpk(s[6 * 33] * sc * kb[2], s[7 * 33] * sc * kb[3]);
        *(u32x4*)(WT + (size_t)(drow0 + n) * ldk + k0 + 8 * c) = o; }
    asm volatile("s_waitcnt lgkmcnt(0)" ::: "memory");
}
struct WJob { const float* W; int K, N; bf16_t* dst; const float* sk; const float* sn; int half; float cst; int qcols; };
__device__ __forceinline__ WJob wjob(const P& p, int id) {
    bf16_t* Wb = (bf16_t*)(p.ws + OFF_W); WJob j; j.sk = nullptr; j.sn = nullptr; j.half = 0; j.cst = 1.f; j.qcols = 1 << 30;
    if (id < 8) { const int jj = id >> 2, g = id & 3; j.W = p.in[3] + (size_t)id * 65536; j.K = 256; j.N = 256; j.dst = Wb + W_PW + (size_t)id * 65536; j.sk = p.in[2] + (jj * 3) * D + g * 256; j.sn = p.in[4] + jj * D + g * 256; }
    else if (id == 8) { j.W = p.in[5]; j.K = D; j.N = 3 * D; j.dst = Wb + W_QKV; j.sk = p.in[2] + 1 * D; j.cst = 0.125f * LOG2E; j.qcols = D; }
    else if (id == 9) { j.W = p.in[6]; j.K = D; j.N = D; j.dst = Wb + W_SO; }
    else if (id == 10) { j.W = p.in[15]; j.K = D; j.N = 2 * D; j.dst = Wb + W_GLU; j.half = D; }
    else { const int i = (id - 11) / 5, w = (id - 11) % 5; bf16_t* L = Wb + W_L0 + (size_t)i * W_LSTRIDE;
        if (w == 0) { j.W = p.in[18] + (size_t)i * D * D; j.K = D; j.N = D; j.dst = L + WL_Q; j.sk = p.in[16] + i * D; j.cst = 0.0625f * LOG2E; }
        else if (w == 1) { j.W = p.in[19] + (size_t)i * D * 2 * D; j.K = D; j.N = 2 * D; j.dst = L + WL_KV; j.sk = p.in[17] + i * D; }
        else if (w == 2) { j.W = p.in[20] + (size_t)i * D * D; j.K = D; j.N = D; j.dst = L + WL_O; }
        else if (w == 3) { j.W = p.in[22] + (size_t)i * D * 2 * FF; j.K = D; j.N = 2 * FF; j.dst = L + WL_UP; j.sk = p.in[21] + i * D; j.half = FF; }
        else { j.W = p.in[25] + (size_t)i * FF * D; j.K = FF; j.N = D; j.dst = L + WL_DN; } }
    return j;
}
constexpr int N_WJOBS = 31;
__device__ __forceinline__ int wjob_items(int id) {
    if (id < 8) return 4 * 8; if (id == 8) return 16 * 96; if (id == 9) return 16 * 32; if (id == 10) return 16 * 64;
    const int w = (id - 11) % 5; return w == 0 ? 0   : w == 1 ? 16 * 64 : w == 2 ? 16 * 32 : w == 3 ? 16 * 176 : 44 * 32;
}
__device__ __forceinline__ void row_to_bf16(const float* xrow, bf16_t* orow, float* sq, float* copy, int lane) {
    const f32x4* xr = (const f32x4*)xrow + lane; f32x4 v[4]; float s = 0.f;
#pragma unroll
    for (int j = 0; j < 4; ++j) { v[j] = xr[64 * j]; s += (v[j][0] * v[j][0] + v[j][1] * v[j][1]) + (v[j][2] * v[j][2] + v[j][3] * v[j][3]); }
    s = wave_sum(s, lane); if (lane == 0) *sq = s;
#pragma unroll
    for (int j = 0; j < 4; ++j) { if (orow) { u32x2 w; w.x = cvtpk(v[j][0], v[j][1]); w.y = cvtpk(v[j][2], v[j][3]); *((u32x2*)orow + lane + 64 * j) = w; } if (copy) *((f32x4*)copy + lane + 64 * j) = v[j]; }
}
__device__ __forceinline__ void s5_items(const P& p, LAS float* sl, int wv) {
    const int tid = otid(wv); bf16_t* WB = (bf16_t*)(p.ws + OFF_S5WB); bf16_t* TW = (bf16_t*)(p.ws + OFF_S5TW);
    const float* a_re = p.in[7]; const float* a_im = p.in[8]; const float* ldt = p.in[9]; const float* b_re = p.in[10]; const float* b_im = p.in[11]; const float* c_re = p.in[12]; const float* c_im = p.in[13];
    LAS float* sCr = sl; LAS float* sCi = sl + 1024; LAS float* sBr = sl + 2048; LAS float* sBi = sl + 3072;
    LAS float* pwr = sl + 4096; LAS float* pwi = pwr + 17 * 64; LAS float* wfr = pwi + 17 * 64; LAS float* wfi = wfr + 17 * 64;
    for (int task = blockIdx.x; task < 256; task += gridDim.x) {
        const int g = task >> 2, part = task & 3;
        __syncthreads();
        for (int q = tid; q < 1024; q += 512) { sCr[q] = c_re[g * 1024 + q]; sCi[q] = c_im[g * 1024 + q]; sBr[q] = b_re[g * 1024 + q]; sBi[q] = b_im[g * 1024 + q]; }
        if (tid < 64) { const int pp = tid; const float lr = a_re[g * 64 + pp], li = a_im[g * 64 + pp], dt = expf(ldt[g]); const float xr = lr * dt, xi = li * dt;
            float s1, c1; sincosf(xi, &s1, &c1); const float ex = expf(xr); const float ar = ex * c1, ai = ex * s1;
            const float sh = sinf(0.5f * xi); const float nr = expm1f(xr) * c1 - 2.f * sh * sh, ni = ex * s1; const float den = lr * lr + li * li;
            const float fr_ = (nr * lr + ni * li) / den, fi_ = (ni * lr - nr * li) / den;
            float cr = 1.f, ci = 0.f;
            for (int e = 0; e <= 16; ++e) { pwr[e * 64 + pp] = cr; pwi[e * 64 + pp] = ci; wfr[e * 64 + pp] = cr * fr_ - ci * fi_; wfi[e * 64 + pp] = cr * fi_ + ci * fr_;
                const float tr = cr * ar - ci * ai, ti = cr * ai + ci * ar; cr = tr; ci = ti; } }
        __syncthreads();
        const int r0 = part * 16, r1 = (part == 3) ? 63 : r0 + 16;
        for (int r = r0; r < r1; ++r) {
            if (r < 31) {
                const int l = r - 15;
                if (tid < 256) { const int i = tid >> 4, j = tid & 15; float val = 0.f;
                    if (l >= 0) { for (int pp = 0; pp < 64; ++pp) { const float cr = sCr[i * 64 + pp], ci = sCi[i * 64 + pp], br = sBr[pp * 16 + j], bi = sBi[pp * 16 + j];
                            const float wr_ = wfr[l * 64 + pp], wi_ = wfi[l * 64 + pp]; val += (cr * wr_ - ci * wi_) * br - (cr * wi_ + ci * wr_) * bi; } }
                    const bf16_t bv = (bf16_t)(cvtpk(val, 0.f) & 0xffffu);
                    for (int t = 0; t < 16; ++t) { const int s = t - l; if (s >= 0 && s < 16) TW[((size_t)g * 256 + t * 16 + i) * 384 + s * 16 + j] = bv; } }
            } else if (r < 47) {
                const int s = r - 31, e = 15 - s;
                for (int q4 = tid; q4 < 2048; q4 += 512) { const int q = q4 >> 4, j = q4 & 15, pp = q >> 1, im = q & 1; const float br = sBr[pp * 16 + j], bi = sBi[pp * 16 + j]; const float wr_ = wfr[e * 64 + pp], wi_ = wfi[e * 64 + pp];
                    const float val = im ? (wr_ * bi + wi_ * br) : (wr_ * br - wi_ * bi);
                    WB[((size_t)g * 256 + q) * 256 + s * 16 + j] = (bf16_t)(cvtpk(val, 0.f) & 0xffffu); WB[((size_t)g * 256 + 128 + q) * 256 + s * 16 + j] = 0; }
            } else {
                const int t = r - 47, e = t + 1;
                for (int q4 = tid; q4 < 2048; q4 += 512) { const int i = q4 >> 7, q = q4 & 127, pp = q >> 1, im = q & 1; const float cr = sCr[i * 64 + pp], ci = sCi[i * 64 + pp]; const float wr_ = pwr[e * 64 + pp], wi_ = pwi[e * 64 + pp];
                    const float val = im ? -(cr * wi_ + ci * wr_) : (cr * wr_ - ci * wi_);
                    TW[((size_t)g * 256 + t * 16 + i) * 384 + 256 + q] = (bf16_t)(cvtpk(val, 0.f) & 0xffffu); }
            }
        }
    }
    __syncthreads();
}
__device__ __forceinline__ void prologue(const P& p, LAS unsigned char* lds, int wv) {
    const int tid = otid(wv), lane = tid & 63, wave = tid >> 6; const int gw = blockIdx.x * 8 + wave, NGW = gridDim.x * 8;
    float* RS = (float*)(p.ws + OFF_RS);
    if (blockIdx.x & 1) { s5_items(p, (LAS float*)lds, wv); __syncthreads(); }
    for (size_t i = (size_t)blockIdx.x * 512 + tid; i < (size_t)12 * T / 4; i += (size_t)gridDim.x * 512) ((f32x4*)(RS + T))[i] = (f32x4){0.f, 0.f, 0.f, 0.f};
    bf16_t* HB = (bf16_t*)(p.ws + OFF_HB);
    for (int m = gw; m < T; m += NGW) row_to_bf16(p.in[0] + (size_t)m * D, nullptr, RS + m, nullptr, lane);
    bf16_t* MB = (bf16_t*)(p.ws + OFF_MEMB);
    for (int m = gw; m < 1024; m += NGW) row_to_bf16(p.in[1] + (size_t)m * D, MB + (size_t)m * D, RS + 13 * T + m, nullptr, lane);
    LAS float* scr = (LAS float*)(lds + wave * 16384);
    int total = 0;
    for (int id = 0; id < N_WJOBS; ++id) total += wjob_items(id);
    for (int it = gw; it < total; it += NGW) {
        int r = it, id = 0; for (;; ++id) { const int c = wjob_items(id); if (r < c) break; r -= c; }
        const WJob j = wjob(p, id); const int nblk = j.N / 32, kb = r / nblk, nb = r % nblk, k0 = 64 * kb, n0 = 32 * nb;
        int drow0 = n0; if (j.half) { const int hf = n0 / j.half, f = n0 % j.half; drow0 = (f / 128) * 256 + hf * 128 + (f % 128); }
        transpose_item(j.W, j.N, k0, n0, j.dst, j.K, drow0, j.sk, j.sn, n0 < j.qcols ? j.cst : 1.f, scr, lane);
    }
    { bf16_t* WQP = (bf16_t*)(p.ws + OFF_WQP);
      for (size_t idx = (size_t)blockIdx.x * 512 + tid; idx < (size_t)4 * D * D / 8; idx += (size_t)gridDim.x * 512) { const size_t e0 = idx * 8; const int i = (int)(e0 >> 20), k = (int)(e0 >> 10) & 1023;
          const float sc = p.in[16][i * D + k] * (0.0625f * LOG2E); const f32x4 x0 = *(const f32x4*)(p.in[18] + e0), x1 = *(const f32x4*)(p.in[18] + e0 + 4);
          u32x4 w; w.x = cvtpk(x0[0] * sc, x0[1] * sc); w.y = cvtpk(x0[2] * sc, x0[3] * sc); w.z = cvtpk(x1[0] * sc, x1[1] * sc); w.w = cvtpk(x1[2] * sc, x1[3] * sc); *(u32x4*)(WQP + e0) = w; } }
    __syncthreads();
    if (!(blockIdx.x & 1)) s5_items(p, (LAS float*)lds, wv);
}
__device__ __forceinline__ void ld8(const float* h32, const bf16_t* hi, const bf16_t* lo, size_t off, f32x4& a, f32x4& b) {
    if (h32) { a = *(const f32x4*)(h32 + off); b = *(const f32x4*)(h32 + off + 4); } else load_hilo8(hi, lo, off, a, b); }
__device__ __forceinline__ void pool_prep(const float* h32, const bf16_t* hi, const bf16_t* lo, const float* rsq, bf16_t* ph, int wv) {
    for (size_t idx = (size_t)blockIdx.x * 512 + otid(wv); idx < (size_t)(T / 16) * 128; idx += (size_t)gridDim.x * 512) {
        const int tok0 = (int)(idx >> 7) * 16, c = ((int)idx & 127) * 8; const int win = 2 << (c >> 8); const int tib0 = tok0 & (SEQ - 1);
        f32x4 sa = (f32x4){0.f, 0.f, 0.f, 0.f}, sb = sa;
        for (int k = win - 1; k >= 1; --k) if (tib0 - k >= 0) { const float r = rs_of(rsq, tok0 - k); f32x4 xa, xb; ld8(h32, hi, lo, (size_t)(tok0 - k) * D + c, xa, xb); sa = sa + xa * r; sb = sb + xb * r; }
#pragma unroll
        for (int t = 0; t < 16; ++t) { const int row = tok0 + t; const float r = rs_of(rsq, row); f32x4 xa, xb; ld8(h32, hi, lo, (size_t)row * D + c, xa, xb); xa = xa * r; xb = xb * r; sa = sa + xa; sb = sb + xb;
            const int cnt = min(tib0 + t + 1, win); const float ic = 1.f / (float)cnt; const f32x4 oa = sa * ic - xa, ob = sb * ic - xb;
            u32x4 w; w.x = cvtpk(oa[0], oa[1]); w.y = cvtpk(oa[2], oa[3]); w.z = cvtpk(ob[0], ob[1]); w.w = cvtpk(ob[2], ob[3]);
            *(u32x4*)(ph + (size_t)row * D + c) = w;
            const int ro = tib0 + t - (win - 1);
            if (ro >= 0) { const float r2 = rs_of(rsq, row - (win - 1)); f32x4 ya, yb; ld8(h32, hi, lo, (size_t)(row - (win - 1)) * D + c, ya, yb); sa = sa - ya * r2; sb = sb - yb * r2; } }
    }
}
__device__ __forceinline__ void s5_zfill(const bf16_t* hi, const bf16_t* lo, const float* rsq, const float* gain, bf16_t* Z, int wv) {
    for (size_t idx = (size_t)blockIdx.x * 512 + otid(wv); idx < (size_t)T * 128; idx += (size_t)gridDim.x * 512) {
        const int tok = (int)(idx >> 7), c = ((int)idx & 127) * 8; const float r = rs_of(rsq, tok);
        f32x4 a, b; load_hilo8(hi, lo, (size_t)tok * D + c, a, b); const f32x4 ga = *(const f32x4*)(gain + c), gb = *(const f32x4*)(gain + c + 4);
        u32x4 w; w.x = cvtpk(a[0] * r * ga[0], a[1] * r * ga[1]); w.y = cvtpk(a[2] * r * ga[2], a[3] * r * ga[3]); w.z = cvtpk(b[0] * r * gb[0], b[1] * r * gb[1]); w.w = cvtpk(b[2] * r * gb[2], b[3] * r * gb[3]);
        const int g = c >> 4, n = tok >> 4, t = tok & 15;
        *(u32x4*)(Z + ((size_t)g * 1024 + n) * 384 + t * 16 + (c & 15)) = w;
    }
}
__device__ __forceinline__ void s5_scan(const P& p, const float* Sst, bf16_t* Z, int j5, int wv) {
    const int tid = otid(wv); const int lane = tid & 63, wave = tid >> 6; const int gw = blockIdx.x * 8 + wave, NGW = gridDim.x * 8;
    for (int task = gw; task < 256; task += NGW) {
        const int b = task >> 6, g = task & 63;
        const float lr = p.in[7][j5 * 4096 + g * 64 + lane], li = p.in[8][j5 * 4096 + g * 64 + lane], dt = expf(p.in[9][j5 * 64 + g]);
        const float mg = expf(16.f * lr * dt); float sn, cs; sincosf(16.f * li * dt, &sn, &cs); const float ar = mg * cs, ai = mg * sn;
        float xr = 0.f, xi = 0.f;
        for (int n0 = 0; n0 < 256; n0 += 16) {
            f32x2 sv[16];
#pragma unroll
            for (int k = 0; k < 16; ++k) sv[k] = *(const f32x2*)(Sst + ((size_t)g * 1024 + b * 256 + n0 + k) * 128 + 2 * lane);
#pragma unroll
            for (int k = 0; k < 16; ++k) { *(unsigned*)(Z + ((size_t)g * 1024 + b * 256 + n0 + k) * 384 + 256 + 2 * lane) = cvtpk(xr, xi);
                const float nr = ar * xr - ai * xi + sv[k][0], ni = ar * xi + ai * xr + sv[k][1]; xr = nr; xi = ni; }
        }
    }
}
__device__ __forceinline__ void sync_state(const float* h, bf16_t* HB, float* rsq, int wv) {
    const int tid = otid(wv); const int lane = tid & 63, wave = tid >> 6; const int gw = blockIdx.x * 8 + wave, NGW = gridDim.x * 8;
    for (int m = gw; m < T; m += NGW) row_to_bf16(h + (size_t)m * D, HB + (size_t)m * D, rsq + m, nullptr, lane);
}

#define MFMA32(a, b, c) __builtin_amdgcn_mfma_f32_32x32x16_bf16((a), (b), (c), 0, 0, 0)
__device__ __forceinline__ void sb_attn(const bf16_t* QK, const bf16_t* VT, bf16_t* O, int opitch, int wv) {
    const int tid = otid(wv); const int lane = tid & 63, wave = tid >> 6; const int n = lane & 31, half = lane >> 5;
    const int gw = blockIdx.x * 8 + wave, NGW = gridDim.x * 8;
    for (int task = gw; task < 8192; task += NGW) {
        const int qt = 127 - (task >> 6), bh = task & 63, b = bh >> 4, h = bh & 15;
        const int tok0 = b * SEQ + qt * 32;
        bf16x8 qf[4];
#pragma unroll
        for (int kk = 0; kk < 4; ++kk) qf[kk] = *(const bf16x8*)(QK + (size_t)(tok0 + n) * 2048 + h * 64 + 16 * kk + 8 * half);
        f32x16 o0, o1;
#pragma unroll
        for (int i = 0; i < 16; ++i) { o0[i] = 0.f; o1[i] = 0.f; }
        float R = 0.f;
        for (int kt = qt; kt >= 0; --kt) {
            const int key0 = b * SEQ + kt * 32;
            bf16x8 kf[4];
#pragma unroll
            for (int kk = 0; kk < 4; ++kk) kf[kk] = *(const bf16x8*)(QK + (size_t)(key0 + n) * 2048 + 1024 + h * 64 + 16 * kk + 8 * half);
            u32x2 vlo[2][2], vhi[2][2];
#pragma unroll
            for (int dd = 0; dd < 2; ++dd)
#pragma unroll
                for (int s = 0; s < 2; ++s) { const bf16_t* vp = VT + (size_t)(h * 64 + 32 * dd + n) * T + key0 + 16 * s + 4 * half; vlo[dd][s] = *(const u32x2*)vp; vhi[dd][s] = *(const u32x2*)(vp + 8); }
            f32x16 sa;
#pragma unroll
            for (int i = 0; i < 16; ++i) sa[i] = 0.f;
#pragma unroll
            for (int kk = 0; kk < 4; ++kk) sa = MFMA32(kf[kk], qf[kk], sa);
            const bool diag = (kt == qt);
            float Lv[16], go[4], gp[4];
#pragma unroll
            for (int r = 0; r < 16; ++r) { const float w = sa[r]; const int m = (r & 3) + 8 * (r >> 2) + 4 * half; const bool valid = !diag || (m < n);
                const float sp = fmaxf(w, 0.f) + fast_log2(1.f + fast_exp2(-fabsf(w))); Lv[r] = valid ? -sp : 0.f; sa[r] = valid ? w : -1.0e30f; }
#pragma unroll
            for (int j = 0; j < 4; ++j) { go[j] = (Lv[4 * j] + Lv[4 * j + 1]) + (Lv[4 * j + 2] + Lv[4 * j + 3]); gp[j] = shx(go[j], 32, lane); }
            float G[4]; G[3] = 0.f; G[2] = go[3] + gp[3]; G[1] = G[2] + (go[2] + gp[2]); G[0] = G[1] + (go[1] + gp[1]); const float tot = G[0] + (go[0] + gp[0]);
            float av[16];
#pragma unroll
            for (int j = 0; j < 4; ++j) { const float bs = R + G[j] + (half == 0 ? gp[j] : 0.f);
                const float s3 = 0.f, s2 = Lv[4 * j + 3], s1 = s2 + Lv[4 * j + 2], s0 = s1 + Lv[4 * j + 1];
                av[4 * j + 0] = fast_exp2(sa[4 * j + 0] + Lv[4 * j + 0] + bs + s0); av[4 * j + 1] = fast_exp2(sa[4 * j + 1] + Lv[4 * j + 1] + bs + s1);
                av[4 * j + 2] = fast_exp2(sa[4 * j + 2] + Lv[4 * j + 2] + bs + s2); av[4 * j + 3] = fast_exp2(sa[4 * j + 3] + Lv[4 * j + 3] + bs + s3); }
            R += tot;
#pragma unroll
            for (int s = 0; s < 2; ++s) { u32x4 pk; pk.x = cvtpk(av[8 * s + 0], av[8 * s + 1]); pk.y = cvtpk(av[8 * s + 2], av[8 * s + 3]); pk.z = cvtpk(av[8 * s + 4], av[8 * s + 5]); pk.w = cvtpk(av[8 * s + 6], av[8 * s + 7]);
                const bf16x8 pf = __builtin_bit_cast(bf16x8, pk);
                u32x4 v0; v0.x = vlo[0][s].x; v0.y = vlo[0][s].y; v0.z = vhi[0][s].x; v0.w = vhi[0][s].y; u32x4 v1; v1.x = vlo[1][s].x; v1.y = vlo[1][s].y; v1.z = vhi[1][s].x; v1.w = vhi[1][s].y;
                o0 = MFMA32(__builtin_bit_cast(bf16x8, v0), pf, o0); o1 = MFMA32(__builtin_bit_cast(bf16x8, v1), pf, o1); }
            if (__ballot(R >= -150.f) == 0ull) break;
        }
#pragma unroll
        for (int j = 0; j < 4; ++j) { u32x2 w0, w1; w0.x = cvtpk(o0[4 * j], o0[4 * j + 1]); w0.y = cvtpk(o0[4 * j + 2], o0[4 * j + 3]); w1.x = cvtpk(o1[4 * j], o1[4 * j + 1]); w1.y = cvtpk(o1[4 * j + 2], o1[4 * j + 3]);
            bf16_t* op = O + (size_t)(tok0 + n) * opitch + h * 64 + 8 * j + 4 * half; *(u32x2*)op = w0; *(u32x2*)(op + 32) = w1; }
    }
}

__global__ void __launch_bounds__(512, 2) mega(P p) {
    extern __shared__ __attribute__((aligned(16))) unsigned char lds_raw[];
    LAS unsigned char* lds = (LAS unsigned char*)lds_raw;
    LAS float* xl = (LAS float*)(lds + XLDS_OFF);
    cg::grid_group grid = cg::this_grid();
    const int wv = __builtin_amdgcn_readfirstlane((int)threadIdx.x >> 6);
    unsigned char* ws = p.ws;
    float* RS = (float*)(ws + OFF_RS); const float* MSQ = RS + 13 * T;
    bf16_t* Wb = (bf16_t*)(ws + OFF_W); bf16_t* HB = (bf16_t*)(ws + OFF_HB); bf16_t* MB = (bf16_t*)(ws + OFF_MEMB);
    bf16_t* KVm = (bf16_t*)(ws + OFF_KV); bf16_t* MT = (bf16_t*)(ws + OFF_MT); bf16_t* NT = (bf16_t*)(ws + OFF_NT);
    unsigned char* scr = ws + OFF_SCR;
    bf16_t* LO = (bf16_t*)p.out;
    unsigned* CNT = (unsigned*)ws + 8192;
    int ph = 0;
#define PH_BEGIN if (ph >= p.lo && ph < p.hi) {
#ifndef DUP
#define DUP 0
#endif
#if HYBRID
#define GRID_SYNC() grid.sync()
#else
    if (otid(wv) == 0) { ((volatile LAS unsigned*)(lds + XLDS_OFF + 12288))[0] = 0u; ((volatile LAS unsigned*)(lds + XLDS_OFF + 12288))[1] = 0u; }
    __syncthreads();
    (void)xcd_barrier_post((unsigned*)p.ws + 1024, (volatile LAS unsigned*)(lds + XLDS_OFF + 12288));
    if (p.lo < 0) grid.sync();
#define GRID_SYNC() do { XcdBarrier xb_; xb_.bar = (unsigned*)p.ws + 1024; xb_.x = xb_xcc_id(); xb_.st = (volatile LAS unsigned*)(lds + XLDS_OFF + 12288); xcd_barrier(xb_); } while (0)
#endif
#define PH_END_NOSYNC } ++ph;
#define PH_END } ++ph; if (ph > p.lo && ph < p.hi) { GRID_SYNC(); if (DUP == 3) GRID_SYNC(); }

    PH_BEGIN prologue(p, lds, wv); if (DUP == 2) { __syncthreads(); prologue(p, lds, wv); } PH_END
    PH_BEGIN
        Sched S; S.done_cnt = nullptr; S.wait_cnt = nullptr; S.wait_target = 0; S.done_kind = 0; S.wait_kind = 0; S.kind = 2; S.nM = 128; S.nN = 1; S.nwg = 128; S.G = gridDim.x; S.c = blockIdx.x; S.bdiv = 1; S.A = (const char*)MB; S.B = (const char*)(Wb + W_L0 + WL_KV);
        S.a_pm = S.a_pn = S.a_pb = S.b_pm = S.b_pn = 0; S.b_pb = (long)W_LSTRIDE * 2;
        EpiKV E{KVm, MSQ}; gemm_phase(lds, GemmDesc{D, D, D}, S, E, wv);
        pool_prep(p.in[0], HB, LO, RS, (bf16_t*)scr, wv);
    PH_END
    PH_BEGIN
        { Sched S; S.done_cnt = nullptr; S.wait_cnt = nullptr; S.wait_target = 0; S.done_kind = 0; S.wait_kind = 0; S.kind = 3; S.nM = 256; S.nN = 1; S.nwg = 256; S.G = gridDim.x; S.c = blockIdx.x; S.bdiv = 1; S.A = (const char*)KVm; S.B = (const char*)(ws + OFF_WQP);
          S.a_pm = S.a_pn = S.b_pm = S.b_pn = 0; S.a_pb = 1024L * 2048 * 2; S.b_pb = 1024L * 1024 * 2;
          EpiMN<0> E{MT}; gemm_phase(lds, GemmDesc{2048, D, 256}, S, E, wv); }
        { Sched S; S.done_cnt = nullptr; S.wait_cnt = nullptr; S.wait_target = 0; S.done_kind = 0; S.wait_kind = 0; S.kind = 4; S.nM = 256; S.nN = 1; S.nwg = 256; S.G = gridDim.x; S.c = blockIdx.x; S.bdiv = 1; S.A = (const char*)(Wb + W_L0 + WL_O); S.B = (const char*)KVm;
          S.a_pm = S.a_pn = S.b_pm = S.b_pn = 0; S.a_pb = (long)W_LSTRIDE * 2; S.b_pb = 1024L * 2048 * 2;
          EpiMN<1> E{NT}; gemm_phase(lds, GemmDesc{D, 2048, 256}, S, E, wv); }
        { Sched S = make_sched(64, 4, (bf16_t*)scr, 256L * D * 2, 256 * 2, Wb + W_PW, 0, 65536L * 2);
          EpiRes<0> E{p.in[0], HB, LO, RS + (size_t)1 * T, xl}; gemm_phase(lds, GemmDesc{D, 256, 256}, S, E, wv); }
    PH_END
    for (int i = 0; i < 4; ++i) {
        const int kind = i % 3, j = i / 3; bf16_t* WL = Wb + W_L0 + (size_t)i * W_LSTRIDE;
        float* rs_mix = RS + (size_t)(3 * i) * T; float* rs_xa = RS + (size_t)(3 * i + 1) * T; float* rs_ffn = RS + (size_t)(3 * i + 2) * T; float* rs_next = RS + (size_t)(3 * i + 3) * T;
        if (kind == 0) {
            bf16_t* PH = (bf16_t*)scr;
            const float* hin = (i == 0) ? p.in[0] : nullptr;
            if (i != 0) {
            PH_BEGIN pool_prep(hin, HB, LO, rs_mix, PH, wv); PH_END
            PH_BEGIN
                Sched S = make_sched(64, 4, PH, 256L * D * 2, 256 * 2, Wb + W_PW + (size_t)j * 4 * 65536, 0, 65536L * 2);
                EpiRes<0> E{hin, HB, LO, rs_xa, xl}; gemm_phase(lds, GemmDesc{D, 256, 256}, S, E, wv);
            PH_END
            }
        } else if (kind == 1) {
            bf16_t* QK = (bf16_t*)scr; bf16_t* VT = (bf16_t*)(scr + 64 * MiB);
            PH_BEGIN
                { Sched S = make_sched(64, 8, HB, 256L * D * 2, 0, Wb + W_QKV, 0, 256L * D * 2); EpiBf E{QK, 2048, 256L * 2048, 256, rs_mix, nullptr}; gemm_phase(lds, GemmDesc{D, D, D}, S, E, wv); }
                { Sched S = make_sched(4, 64, Wb + W_QKV + (size_t)2048 * D, 256L * D * 2, 0, HB, 0, 256L * D * 2); EpiBf E{VT, T, 256L * T, 256, nullptr, rs_mix}; gemm_phase(lds, GemmDesc{D, D, D}, S, E, wv); }
            PH_END
            PH_BEGIN sb_attn(QK, VT, QK, 2048, wv); PH_END
            PH_BEGIN
                Sched S = make_sched(64, 4, QK, 256L * 2048 * 2, 0, Wb + W_SO, 0, 256L * D * 2);
                EpiRes<0> E{nullptr, HB, LO, rs_xa, xl}; gemm_phase(lds, GemmDesc{2048, D, D}, S, E, wv);
            PH_END
        } else {
            bf16_t* Z = (bf16_t*)scr; float* Sst = (float*)(scr + 48 * MiB); bf16_t* Y = (bf16_t*)(scr + 48 * MiB);
            bf16_t* WB5 = (bf16_t*)(ws + OFF_S5WB); bf16_t* TW5 = (bf16_t*)(ws + OFF_S5TW);
            PH_BEGIN s5_zfill(HB, LO, rs_mix, p.in[2] + i * D, Z, wv); if (DUP == 9) s5_zfill(HB, LO, rs_mix, p.in[2] + i * D, Z, wv); PH_END
            PH_BEGIN
                Sched S = make_sched(256, 1, Z, 256L * 384 * 2, 0, WB5, 0, 0, 4, 0, 256L * 256 * 2);
                EpiS5S E{Sst}; gemm_phase(lds, GemmDesc{384, 256, 256}, S, E, wv); if (DUP == 9) gemm_phase(lds, GemmDesc{384, 256, 256}, S, E, wv);
            PH_END
            PH_BEGIN s5_scan(p, Sst, Z, j, wv); if (DUP == 7) s5_scan(p, Sst, Z, j, wv); PH_END
            PH_BEGIN
                Sched S = make_sched(256, 1, Z, 256L * 384 * 2, 0, TW5, 0, 0, 4, 0, 256L * 384 * 2);
                EpiS5Y E{Y, Z, p.in[14] + j * D}; gemm_phase(lds, GemmDesc{384, 384, 384}, S, E, wv); if (DUP == 9) gemm_phase(lds, GemmDesc{384, 384, 384}, S, E, wv);
            PH_END
            PH_BEGIN
                Sched S = make_sched(64, 8, Y, 256L * D * 2, 0, Wb + W_GLU, 0, 256L * D * 2);
                EpiRes<1> E{nullptr, HB, LO, rs_xa, xl}; gemm_phase(lds, GemmDesc{D, D, D}, S, E, wv);
            PH_END
        }
        {
            bf16_t* Pm = (bf16_t*)scr;
            PH_BEGIN
                Sched S = make_sched(64, 4, HB, 256L * D * 2, 0, MT + (size_t)i * 4 * 1024 * 1024, 0, 256L * D * 2, 16, 0, 1024L * 1024 * 2);
                if (!HYBRID) S.done_cnt = CNT + (i * 8 + 0) * 128;
                EpiSoftmax E{Pm, xl, rs_xa}; gemm_phase(lds, GemmDesc{D, D, D}, S, E, wv);
            PH_END_NOSYNC
            PH_BEGIN
                Sched S = make_sched(64, 4, Pm, 256L * D * 2, 0, NT + (size_t)i * 4 * 1024 * 1024, 0, 256L * D * 2, 16, 0, 1024L * 1024 * 2);
                if (!HYBRID) { S.wait_cnt = CNT + (i * 8 + 0) * 128; S.wait_target = 4; }
                EpiRes<0> E{nullptr, HB, LO, rs_ffn, xl}; gemm_phase(lds, GemmDesc{D, D, D}, S, E, wv);
            PH_END
        }
        {
            bf16_t* Gb = (bf16_t*)scr;
            PH_BEGIN
                Sched S; S.done_cnt = nullptr; S.wait_cnt = nullptr; S.wait_target = 0; S.done_kind = 0; S.wait_kind = 0; S.kind = 1; S.nM = 68; S.nN = 22; S.nwg = 68 * 22; S.G = gridDim.x; S.c = blockIdx.x; S.bdiv = 1; S.A = (const char*)HB; S.B = (const char*)(WL + WL_UP);
                S.a_pm = D * 2; S.a_pn = S.a_pb = S.b_pm = S.b_pb = 0; S.b_pn = 256L * D * 2;
                EpiConvGlu E{Gb, rs_ffn, p.in[23] + (size_t)i * 3 * 2 * FF, p.in[24] + (size_t)i * 2 * FF, xl}; gemm_phase(lds, GemmDesc{D, D, D}, S, E, wv); if (DUP == 1) gemm_phase(lds, GemmDesc{D, D, D}, S, E, wv);
            PH_END
            PH_BEGIN
                Sched S = make_sched(64, 4, Gb, 256L * FF * 2, 0, WL + WL_DN, 0, 256L * FF * 2);
                EpiRes<0> E{nullptr, HB, LO, rs_next, xl}; gemm_phase(lds, GemmDesc{FF, FF, FF}, S, E, wv);
            PH_END
        }
    }
    PH_BEGIN
        const int tid = otid(wv), lane = tid & 63, wave = tid >> 6; const int gw = blockIdx.x * 8 + wave, NGW = gridDim.x * 8;
        f32x4 fv[8][4]; float fr_[8];
#pragma unroll
        for (int k = 0; k < 8; ++k) { const int m = gw + k * NGW; float s = 0.f;
#pragma unroll
            for (int j = 0; j < 2; ++j) { if (m < T) load_hilo8(HB, LO, (size_t)m * D + 8 * lane + 512 * j, fv[k][2 * j], fv[k][2 * j + 1]); else { fv[k][2 * j] = (f32x4){0.f, 0.f, 0.f, 0.f}; fv[k][2 * j + 1] = fv[k][2 * j]; } }
#pragma unroll
            for (int j = 0; j < 4; ++j) s += (fv[k][j][0] * fv[k][j][0] + fv[k][j][1] * fv[k][j][1]) + (fv[k][j][2] * fv[k][j][2] + fv[k][j][3] * fv[k][j][3]);
            fr_[k] = rsqrtf(wave_sum(s, lane) * (1.f / D) + EPS); }
        GRID_SYNC();
#pragma unroll
        for (int k = 0; k < 8; ++k) { const int m = gw + k * NGW;
            if (m < T) {
#pragma unroll
                for (int j = 0; j < 4; ++j) { const int col = 8 * lane + 512 * (j >> 1) + 4 * (j & 1); const f32x4 gg = *(const f32x4*)(p.in[26] + col); *(f32x4*)(p.out + (size_t)m * D + col) = fv[k][j] * fr_[k] * gg; } } }
        for (int m = gw + 8 * NGW; m < T; m += NGW) { }
    PH_END
#undef PH_BEGIN
#undef PH_END
}
__global__ void __launch_bounds__(512) k_sync_state(const float* h, bf16_t* HB, float* rsq) { sync_state(h, HB, rsq, threadIdx.x >> 6); }
}
#ifndef OPT_MASK
#define OPT_MASK 63
#endif
#ifndef HYBRID
#define HYBRID 0
#endif
static void mega_launch(hipStream_t stream, mk::P p, int lo, int hi, int grid) {
    p.lo = lo; p.hi = hi; void* args[] = {&p};
    hipError_t e = hipLaunchCooperativeKernel((const void*)mk::mega, dim3(grid), dim3(512), args, mk::LDS_BYTES, stream);
    if (e != hipSuccess) fprintf(stderr, "cooperative launch failed: %s (grid %d)\n", hipGetErrorString(e), grid);
}
extern "C" void kernel_launch(void* const* d_in, const int* in_sizes, int n_in, void* d_out, int out_size, void* d_ws, size_t ws_size, hipStream_t stream) {
    static int grid = 0;
    if (grid == 0) {
        if (n_in != 27 || ws_size < mk::WS_NEED) { fprintf(stderr, "kernel_launch: unexpected n_in %d / ws %zu\n", n_in, ws_size); grid = -1; return; }
        int dev = 0, cus = 0, per_cu = 0;
        hipGetDevice(&dev); hipDeviceGetAttribute(&cus, hipDeviceAttributeMultiprocessorCount, dev);
        hipFuncSetAttribute((const void*)mk::mega, hipFuncAttributeMaxDynamicSharedMemorySize, mk::LDS_BYTES);
        hipOccupancyMaxActiveBlocksPerMultiprocessor(&per_cu, (const void*)mk::mega, 512, mk::LDS_BYTES);
        if (per_cu < 1) per_cu = 1;
        (void)hipGetLastError();
        grid = cus * per_cu;
    }
    if (grid < 0) return;
    mk::P p{}; for (int i = 0; i < 27; ++i) p.in[i] = (const float*)d_in[i];
    p.out = (float*)d_out; p.ws = (unsigned char*)d_ws;
#if !HYBRID
    hipMemsetAsync(d_ws, 0, 65536, stream);
    mega_launch(stream, p, 0, 1000, grid);
#else
    nv::In in{}; for (int i = 0; i < 27; ++i) in.p[i] = (const float*)d_in[i];
    float* h = (float*)d_out; float* scr = (float*)((unsigned char*)d_ws + mk::OFF_SCR);
    mega_launch(stream, p, 0, 2, grid);
    int ph = 2;
    for (int i = 0; i < 4; ++i) {
        const int kind = i % 3; const int nmix = kind == 0 ? 2 : kind == 1 ? 3 : 5;
        for (int sub = 0; sub < 3; ++sub) {
            const int np = sub == 0 ? nmix : sub == 1 ? 4 : 2; const int bit = sub == 0 ? kind : sub == 1 ? 3 : 4;
            if ((OPT_MASK >> bit) & 1) {
                mk::k_sync_state<<<256, 512, 0, stream>>>(h, (mk::bf16_t*)((unsigned char*)d_ws + mk::OFF_HB), (float*)((unsigned char*)d_ws + mk::OFF_RS) + (size_t)(3 * i + sub) * mk::T);
                mega_launch(stream, p, ph, ph + np, grid);
            } else nv::sublayer(stream, in, h, scr, i, sub);
            ph += np;
        }
    }
    if ((OPT_MASK >> 5) & 1) mega_launch(stream, p, 38, 39, grid); else nv::final_norm(stream, in, h);
#endif
}
```

```cpp
#include <hip/hip_runtime.h>
#include <hip/hip_cooperative_groups.h>
#include <cstdio>
#include <cstdint>
namespace cg = cooperative_groups;
#define HYBRID 0
#define OPT_MASK 63
#define DUP 0
#define SEAMS 1
#define MK_SP2 1
#define MK_BAUX 0
#define MK_AAUX 0
#define MK_LO 0
namespace mk {
#define LAS __attribute__((address_space(3)))
typedef unsigned short bf16_t;
typedef short bf16x8 __attribute__((ext_vector_type(8)));
typedef float f32x4 __attribute__((ext_vector_type(4)));
typedef float f32x16 __attribute__((ext_vector_type(16)));
typedef float f32x2 __attribute__((ext_vector_type(2)));
typedef unsigned u32x4 __attribute__((ext_vector_type(4)));
typedef unsigned u32x2 __attribute__((ext_vector_type(2)));
typedef __bf16 bf16x2_t __attribute__((ext_vector_type(2)));
constexpr int T = 16384, D = 1024, SEQ = 4096, FF = 2816, NB = 4;
constexpr float EPS = 1e-6f, LOG2E = 1.4426950408889634f;
constexpr int BM = 256, BK = 64, HALF = 128, HTB = HALF * BK * 2, STAGE_BYTES = 8 * HTB, NXCD = 8, WGM = 8;
constexpr int XLDS_OFF = STAGE_BYTES;
constexpr int LDS_BYTES = 147456;

__device__ __forceinline__ unsigned cvtpk(float lo, float hi) { f32x2 v = {lo, hi}; bf16x2_t b = __builtin_convertvector(v, bf16x2_t); return __builtin_bit_cast(unsigned, b); }
__device__ __forceinline__ float bf2f(bf16_t b) { return __builtin_bit_cast(float, (unsigned)b << 16); }
__device__ __forceinline__ float fast_exp2(float x) { return __builtin_amdgcn_exp2f(x); }
__device__ __forceinline__ float fast_log2(float x) { return __builtin_amdgcn_logf(x); }
__device__ __forceinline__ float fast_rcp(float x) { return __builtin_amdgcn_rcpf(x); }
__device__ __forceinline__ float sigmoidf_(float x) { return fast_rcp(1.f + fast_exp2(-x * LOG2E)); }
__device__ __forceinline__ int lane_id_v() { int l; asm volatile("v_mbcnt_lo_u32_b32 %0, -1, 0\n\tv_mbcnt_hi_u32_b32 %0, -1, %0" : "=v"(l)); return l; }
__device__ __forceinline__ float shx(float v, int mask, int lane) { return __builtin_bit_cast(float, __builtin_amdgcn_ds_bpermute((lane ^ mask) << 2, __builtin_bit_cast(int, v))); }
__device__ __forceinline__ float wave_sum(float v, int lane) {
#pragma unroll
    for (int o = 1; o < 64; o <<= 1) v += shx(v, o, lane);
    return v;
}
template <int CTRL> __device__ __forceinline__ float dppf(float v) { return __builtin_bit_cast(float, __builtin_amdgcn_update_dpp(0, __builtin_bit_cast(int, v), CTRL, 0xf, 0xf, false)); }

__host__ __device__ __forceinline__ int lds_byte(int r, int c) { const int st = (r >> 4) * 2 + (c >> 5), rr = r & 15, cc = c & 31, ob = rr * 64 + cc * 2; return st * 1024 + (ob ^ (((ob >> 9) & 1) << 5)); }
__host__ __device__ __forceinline__ void stage_rc(int b, int& R, int& C) { const int st = b / 1024, sb = b % 1024, swz = sb ^ (((sb >> 9) & 1) << 5); R = (st >> 1) * 16 + swz / 64; C = (st & 1) * 32 + (swz % 64) / 2; }
__host__ __device__ __forceinline__ int perm_sw(int rho) { const int n = rho >> 4, i = rho & 15, q = i >> 2, j = i & 3; return 16 * n + 8 * (q & 1) + 4 * (q >> 1) + j; }
__host__ __device__ __forceinline__ int perm32(int rho) { const int n = rho >> 4, i = rho & 15; return 8 * (i >> 2) + 4 * n + (i & 3); }

struct Unit { int pm, pn; };
struct GemmDesc { int lda, ldb, K; };

struct Sched {
    int kind, nM, nN, nwg, G, c, bdiv;
    const char* A; const char* B;
    long a_pm, a_pn, a_pb, b_pm, b_pn, b_pb;
    unsigned* done_cnt; unsigned* wait_cnt; int wait_target, done_kind, wait_kind;
    __device__ __forceinline__ void wait_one(unsigned* w) const {
        unsigned sp = 0; while (__builtin_amdgcn_readfirstlane(__hip_atomic_load(w, __ATOMIC_RELAXED, __HIP_MEMORY_SCOPE_AGENT)) < (unsigned)wait_target) { __builtin_amdgcn_s_sleep(2); if (++sp > (1u << 20)) break; }
    }
    __device__ __forceinline__ void a_ready(const Unit& u, int wid) const {
        if (!wait_cnt) return;
        if (wid == 0) {
            if (wait_kind == 0) wait_one(wait_cnt + u.pm);
            __builtin_amdgcn_fence(__ATOMIC_ACQUIRE, "agent"); asm volatile("s_waitcnt vmcnt(0)" ::: "memory");
        }
        __builtin_amdgcn_s_barrier(); asm volatile("" ::: "memory");
    }
    __device__ __forceinline__ void done(const Unit& u, int wid, int lane) const {
        if (!done_cnt) return;
        asm volatile("s_waitcnt vmcnt(0)" ::: "memory"); __builtin_amdgcn_s_barrier(); asm volatile("" ::: "memory");
        if (wid == 0 && lane == 0) { __builtin_amdgcn_fence(__ATOMIC_RELEASE, "agent"); asm volatile("s_waitcnt vmcnt(0)" ::: "memory");
            __hip_atomic_fetch_add(done_cnt + u.pm, 1u, __ATOMIC_RELAXED, __HIP_MEMORY_SCOPE_AGENT); }
    }
    __device__ __forceinline__ bool next(int i, Unit& u) const {
        const long L = (long)i * G + c; if (L >= nwg) return false;
        int wgid = (int)L;
        if (kind >= 2) { u.pm = wgid; u.pn = 0; return true; }
        { const int q = nwg / NXCD, r = nwg % NXCD, xcd = wgid % NXCD, off = wgid / NXCD; wgid = (xcd < r ? xcd * (q + 1) : r * (q + 1) + (xcd - r) * q) + off; }
        const int nig = WGM * nN, gid = wgid / nig, fm = gid * WGM, gsz = (nM - fm) < WGM ? (nM - fm) : WGM;
        u.pm = fm + ((wgid % nig) % gsz); u.pn = (wgid % nig) / gsz; return true;
    }
    __device__ __forceinline__ void base(const Unit& u, const char*& a, const char*& b) const {
        if (kind == 0) { const int pb = u.pm / bdiv; a = A + u.pm * a_pm + u.pn * a_pn + pb * a_pb; b = B + u.pm * b_pm + u.pn * b_pn + pb * b_pb; }
        else if (kind == 1) { const int bt = u.pm / 17, j = u.pm % 17; int o0 = 254 * j; if (o0 > 3842) o0 = 3842; const long start = (long)bt * SEQ + o0 - 2; a = A + start * a_pm; b = B + u.pn * b_pn; }
        else if (kind == 2) { const int L = u.pm, layer = L >> 5, r = L & 31, tm = r >> 3, tn = r & 7;
            a = A + (long)tm * 256 * 2048; b = B + (long)layer * b_pb + (long)tn * 256 * 2048; }
        else if (kind == 3) { const int L = u.pm, layer = L >> 6, r = L & 63, bt = r >> 4, hh = (r >> 2) & 3, kt = r & 3;
            a = A + (long)layer * a_pb + (long)bt * 256 * 4096 + hh * 512; b = B + (long)layer * b_pb + (long)kt * 256 * 2048 + hh * 512; }
        else { const int L = u.pm, layer = L >> 6, r = L & 63, bt = r >> 4, hh = (r >> 2) & 3, nt = r & 3;
            a = A + (long)layer * a_pb + (long)nt * 256 * 2048 + hh * 512; b = B + (long)layer * b_pb + (long)bt * 256 * 4096 + (1024 + hh * 256) * 2; }
    }
};
__device__ __forceinline__ Sched make_sched(int nM, int nN, const void* A, long a_pm, long a_pn, const void* B, long b_pm, long b_pn, int bdiv = 1 << 30, long a_pb = 0, long b_pb = 0) {
    Sched s; s.done_cnt = nullptr; s.wait_cnt = nullptr; s.wait_target = 0; s.done_kind = 0; s.wait_kind = 0; s.kind = 0; s.nM = nM; s.nN = nN; s.nwg = nM * nN; s.G = gridDim.x; s.c = blockIdx.x; s.bdiv = bdiv; s.A = (const char*)A; s.B = (const char*)B;
    s.a_pm = a_pm; s.a_pn = a_pn; s.a_pb = a_pb; s.b_pm = b_pm; s.b_pn = b_pn; s.b_pb = b_pb; return s;
}

template <class Epi>
__device__ __forceinline__ void gemm_phase(LAS unsigned char* lds, const GemmDesc g, const Sched& S, const Epi& E, int wv) {
    int tid_ = wv * 64 + lane_id_v();
    const int tid = tid_, wid = __builtin_amdgcn_readfirstlane(tid >> 6), lane = tid & 63, wr = wid >> 2, wc = wid & 3, fr = lane & 15, fq = lane >> 4;
    const int K = g.K, nt = K / BK;
    unsigned voffA[2], voffB[2];
#pragma unroll
    for (int i = 0; i < 2; ++i) { int R, C; stage_rc(tid * 16 + i * 8192, R, C); const int Rb = (int)Epi::PERM == 2 ? ((R & ~31) + perm_sw(R & 31)) : (int)Epi::PERM == 1 ? ((R & ~31) + perm32(R & 31)) : R;
        voffA[i] = (unsigned)(R * g.lda + C) * 2u; voffB[i] = (unsigned)(Rb * g.ldb + C) * 2u; }
    const size_t kstep = (size_t)(BK * 2);
    const size_t hstepA = (size_t)HALF * g.lda * 2, hstepB = (size_t)HALF * g.ldb * 2;
    const unsigned ldsw = (unsigned)wid * 1024u;
    const int aoff = lds_byte(wr * 64 + fr, fq * 8), boff = lds_byte(wc * 32 + fr, fq * 8);
#define PG8_SA(b, h) (((b) * 2 + (h)) * HTB)
#define PG8_SB(b, h) ((4 + (b) * 2 + (h)) * HTB)
#define PG8_STAGE(bufoff, gbase, voff) do { _Pragma("unroll") for (int _i = 0; _i < 2; ++_i) \
        __builtin_amdgcn_global_load_lds((const unsigned*)((const char*)(gbase) + (voff)[_i]), (LAS unsigned*)(lds + (bufoff) + ldsw + _i * 8192), 16, 0, 0); } while (0)
#define PG8_LDA(dst, b, h) do { _Pragma("unroll") for (int m = 0; m < 4; ++m) _Pragma("unroll") for (int k = 0; k < 2; ++k) dst[m][k] = *(const LAS bf16x8*)(lds + PG8_SA(b, h) + aoff + m * 2048 + k * 1024); } while (0)
#define PG8_LDB(dst, b, h) do { _Pragma("unroll") for (int n = 0; n < 2; ++n) _Pragma("unroll") for (int k = 0; k < 2; ++k) dst[n][k] = *(const LAS bf16x8*)(lds + PG8_SB(b, h) + boff + n * 2048 + k * 1024); } while (0)
#define PG8_MMA(ai, bj, At, Bt) do { __builtin_amdgcn_s_setprio(1); _Pragma("unroll") for (int m = 0; m < 4; ++m) _Pragma("unroll") for (int n = 0; n < 2; ++n) _Pragma("unroll") for (int k = 0; k < 2; ++k) \
        acc[ai][bj][m][n] = __builtin_amdgcn_mfma_f32_16x16x32_bf16(Bt[n][k], At[m][k], acc[ai][bj][m][n], 0, 0, 0); __builtin_amdgcn_s_setprio(0); } while (0)
#define PG8_WAIT_V(n) asm volatile("s_waitcnt vmcnt(" #n ")" ::: "memory")
#define PG8_WAIT_L(n) asm volatile("s_waitcnt lgkmcnt(" #n ")" ::: "memory")
#define PG8_BAR __builtin_amdgcn_s_barrier()
#define PG8_SCHED __builtin_amdgcn_sched_barrier(0)
    Unit cur, nxt; int ui = 0;
    if (!S.next(0, cur)) return;
    f32x4 acc[2][2][4][2];
#pragma unroll
    for (int a = 0; a < 2; ++a)
#pragma unroll
        for (int b = 0; b < 2; ++b)
#pragma unroll
            for (int m = 0; m < 4; ++m)
#pragma unroll
                for (int n = 0; n < 2; ++n) acc[a][b][m][n] = (f32x4){0.f, 0.f, 0.f, 0.f};
    bf16x8 At[4][2], B0[2][2], B1[2][2];
    const char* cA; const char* cB; S.base(cur, cA, cB);
    S.a_ready(cur, wid);
    PG8_STAGE(PG8_SB(0, 0), cB, voffB); PG8_STAGE(PG8_SB(0, 1), cB + hstepB, voffB); PG8_STAGE(PG8_SA(0, 0), cA, voffA); PG8_STAGE(PG8_SA(0, 1), cA + hstepA, voffA);
    if (wr == 1) PG8_BAR;
    PG8_WAIT_V(2); PG8_BAR;
    PG8_STAGE(PG8_SB(1, 0), cB + kstep, voffB); PG8_STAGE(PG8_SA(1, 0), cA + kstep, voffA); PG8_STAGE(PG8_SB(1, 1), cB + hstepB + kstep, voffB);
    PG8_WAIT_V(6); PG8_BAR;
    for (;;) {
        const bool has_next = S.next(ui + 1, nxt);
        const char* nA = cA; const char* nB = cB; if (has_next) S.base(nxt, nA, nB);
        for (int t = 0; t < nt; t += 2) {
            const bool last = (t == nt - 2);
            if (last && has_next) S.a_ready(nxt, wid);
            const char* a1 = cA + (size_t)(t + 1) * kstep;
            const char* a2 = last ? nA : cA + (size_t)(t + 2) * kstep; const char* b2 = last ? nB : cB + (size_t)(t + 2) * kstep;
            const char* a3 = a2 + kstep; const char* b3 = b2 + kstep;
            PG8_LDB(B0, 0, 0); PG8_LDB(B1, 0, 1); PG8_SCHED; PG8_LDA(At, 0, 0); PG8_STAGE(PG8_SA(1, 1), a1 + hstepA, voffA);
            PG8_WAIT_V(8); PG8_WAIT_L(0); PG8_BAR; PG8_MMA(0, 0, At, B0); PG8_MMA(0, 1, At, B1); PG8_BAR; PG8_SCHED;
            PG8_LDA(At, 0, 1); PG8_STAGE(PG8_SB(0, 0), b2, voffB); PG8_STAGE(PG8_SB(0, 1), b2 + hstepB, voffB); PG8_STAGE(PG8_SA(0, 0), a2, voffA);
            PG8_WAIT_V(8); PG8_WAIT_L(0); PG8_BAR; PG8_MMA(1, 0, At, B0); PG8_MMA(1, 1, At, B1); PG8_BAR; PG8_SCHED;
            PG8_LDB(B0, 1, 0); PG8_LDB(B1, 1, 1); PG8_SCHED; PG8_LDA(At, 1, 0); PG8_STAGE(PG8_SA(0, 1), a2 + hstepA, voffA);
            PG8_WAIT_V(8); PG8_WAIT_L(0); PG8_BAR; PG8_MMA(0, 0, At, B0); PG8_MMA(0, 1, At, B1); PG8_BAR; PG8_SCHED;
            PG8_LDA(At, 1, 1); PG8_STAGE(PG8_SB(1, 0), b3, voffB); PG8_STAGE(PG8_SB(1, 1), b3 + hstepB, voffB); PG8_STAGE(PG8_SA(1, 0), a3, voffA);
            PG8_WAIT_V(8); PG8_WAIT_L(0); PG8_BAR; PG8_MMA(1, 0, At, B0); PG8_MMA(1, 1, At, B1); PG8_BAR; PG8_SCHED;
        }
        if (wr == 0) PG8_BAR;
        { int fr_e = fr, fq_e = fq; asm volatile("" : "+v"(fr_e), "+v"(fq_e)); E(acc, cur, wr, wc, fr_e, fq_e); }
        S.done(cur, wid, lane);
        if (!has_next) break;
#pragma unroll
        for (int a = 0; a < 2; ++a)
#pragma unroll
            for (int b = 0; b < 2; ++b)
#pragma unroll
                for (int m = 0; m < 4; ++m)
#pragma unroll
                    for (int n = 0; n < 2; ++n) acc[a][b][m][n] = (f32x4){0.f, 0.f, 0.f, 0.f};
        cur = nxt; cA = nA; cB = nB; ++ui;
        if (wr == 1) PG8_BAR;
    }
    PG8_WAIT_V(0);
    PG8_BAR;
#undef PG8_SA
#undef PG8_SB
#undef PG8_STAGE
#undef PG8_LDA
#undef PG8_LDB
#undef PG8_MMA
#undef PG8_WAIT_V
#undef PG8_WAIT_L
#undef PG8_SCHED
}
#define MK_BAR() do { asm volatile("s_waitcnt vmcnt(0) lgkmcnt(0)" ::: "memory"); __builtin_amdgcn_s_barrier(); asm volatile("" ::: "memory"); } while (0)
#define MK_LBAR() do { asm volatile("s_waitcnt lgkmcnt(0)" ::: "memory"); __builtin_amdgcn_s_barrier(); asm volatile("" ::: "memory"); } while (0)

typedef f32x4 AccT[2][2][4][2];
#ifndef MK_LO
#define MK_LO 1
#endif
__device__ __forceinline__ f32x4 unpack_bf4(u32x2 w) { f32x4 r; r[0] = __builtin_bit_cast(float, w.x << 16); r[1] = __builtin_bit_cast(float, w.x & 0xffff0000u); r[2] = __builtin_bit_cast(float, w.y << 16); r[3] = __builtin_bit_cast(float, w.y & 0xffff0000u); return r; }
__device__ __forceinline__ f32x4 load_hilo4(const bf16_t* hi, const bf16_t* lo, size_t off) { return unpack_bf4(*(const u32x2*)(hi + off)) + unpack_bf4(*(const u32x2*)(lo + off)); }
__device__ __forceinline__ void load_hilo8(const bf16_t* hi, const bf16_t* lo, size_t off, f32x4& a, f32x4& b) { const u32x4 h4 = *(const u32x4*)(hi + off); u32x4 l4 = (u32x4){0u, 0u, 0u, 0u}; if (MK_LO) l4 = *(const u32x4*)(lo + off);
    u32x2 ha, hb_, la, lb; ha.x = h4.x; ha.y = h4.y; hb_.x = h4.z; hb_.y = h4.w; la.x = l4.x; la.y = l4.y; lb.x = l4.z; lb.y = l4.w; a = unpack_bf4(ha) + unpack_bf4(la); b = unpack_bf4(hb_) + unpack_bf4(lb); }
__device__ __forceinline__ void store_hilo4(bf16_t* hi, bf16_t* lo, size_t off, f32x4 v) { u32x2 w; w.x = cvtpk(v[0], v[1]); w.y = cvtpk(v[2], v[3]); const f32x4 d = v - unpack_bf4(w); u32x2 l; l.x = cvtpk(d[0], d[1]); l.y = cvtpk(d[2], d[3]);
    *(u32x2*)(hi + off) = w; *(u32x2*)(lo + off) = l; }
constexpr int RSN = MK_LO ? 1 : 8;
__device__ __forceinline__ float rs_of(const float* rsq, int row) {
    if (RSN == 1) return rsqrtf(rsq[row] * (1.f / D) + EPS);
    const f32x4 x = *(const f32x4*)(rsq + (size_t)row * 8), y = *(const f32x4*)(rsq + (size_t)row * 8 + 4);
    return rsqrtf((((x[0] + x[1]) + (x[2] + x[3])) + ((y[0] + y[1]) + (y[2] + y[3]))) * (1.f / D) + EPS); }

struct EpiBf {
    static constexpr bool PERM = true;
    bf16_t* O; int ldc; long o_pm, o_pn; const float* rsq; const float* csq;
    __device__ __forceinline__ void operator()(const AccT& acc, const Unit& u, int wr, int wc, int fr, int fq) const {
        bf16_t* base = O + u.pm * o_pm + u.pn * o_pn;
        float cs[2][8];
#pragma unroll
        for (int bj = 0; bj < 2; ++bj)
#pragma unroll
            for (int e = 0; e < 8; ++e) cs[bj][e] = csq ? rs_of(csq, u.pn * 256 + bj * HALF + wc * 32 + 8 * fq + e) : 1.f;
#pragma unroll
        for (int ai = 0; ai < 2; ++ai)
#pragma unroll
            for (int m = 0; m < 4; ++m) { const int row = ai * HALF + wr * 64 + m * 16 + fr; const float r = rsq ? rs_of(rsq, u.pm * 256 + row) : 1.f;
#pragma unroll
                for (int bj = 0; bj < 2; ++bj) { const f32x4 v0 = acc[ai][bj][m][0], v1 = acc[ai][bj][m][1]; u32x4 w;
                    w.x = cvtpk(v0[0] * r * cs[bj][0], v0[1] * r * cs[bj][1]); w.y = cvtpk(v0[2] * r * cs[bj][2], v0[3] * r * cs[bj][3]);
                    w.z = cvtpk(v1[0] * r * cs[bj][4], v1[1] * r * cs[bj][5]); w.w = cvtpk(v1[2] * r * cs[bj][6], v1[3] * r * cs[bj][7]);
                    *(u32x4*)(base + (size_t)row * ldc + bj * HALF + wc * 32 + 8 * fq) = w; } }
    }
};
struct EpiKV {
    static constexpr bool PERM = true;
    bf16_t* KV; const float* msq;
    __device__ __forceinline__ void operator()(const AccT& acc, const Unit& u, int wr, int wc, int fr, int fq) const {
        const int L = u.pm, layer = L >> 5, r = L & 31, tm = r >> 3, tn = r & 7;
        EpiBf e; e.ldc = 2048; e.o_pm = 256 * 2048; e.o_pn = 256; e.O = KV + (size_t)layer * 1024 * 2048; e.rsq = msq; e.csq = nullptr; Unit v; v.pm = tm; v.pn = tn;
        e(acc, v, wr, wc, fr, fq);
    }
};
template <int ISN> struct EpiMN {
    static constexpr bool PERM = true;
    bf16_t* O;
    __device__ __forceinline__ void operator()(const AccT& acc, const Unit& u, int wr, int wc, int fr, int fq) const {
        const int L = u.pm, layer = L >> 6, r = L & 63, bt = r >> 4, hh = (r >> 2) & 3, t4 = r & 3;
        EpiBf e; e.ldc = 1024; e.o_pm = 256 * 1024; e.o_pn = 256; e.O = O + ((size_t)layer * 4 + bt) * 1024 * 1024; e.rsq = nullptr; e.csq = nullptr; Unit v;
        if (!ISN) { v.pm = hh; v.pn = t4; } else { v.pm = t4; v.pn = hh; }
        e(acc, v, wr, wc, fr, fq);
    }
};
template <int GLU> struct EpiRes {
    static constexpr bool PERM = true;
    const float* base32; bf16_t* hi; bf16_t* lo; float* rsq; LAS float* xl;
    __device__ __forceinline__ void operator()(const AccT& acc, const Unit& u, int wr, int wc, int fr, int fq) const {
        constexpr int NBJ = GLU ? 1 : 2;
#pragma unroll
        for (int q = 0; q < 4; ++q) { const int ai = q >> 1, m0 = (q & 1) * 2;
            f32x4 bv[2][NBJ][2];
#pragma unroll
            for (int mm = 0; mm < 2; ++mm) { const int row = u.pm * 256 + ai * HALF + wr * 64 + (m0 + mm) * 16 + fr;
#pragma unroll
                for (int bj = 0; bj < NBJ; ++bj) { const int col = GLU ? (u.pn * 128 + wc * 32 + 8 * fq) : (u.pn * 256 + bj * HALF + wc * 32 + 8 * fq); const size_t off = (size_t)row * D + col;
                    if (base32) { bv[mm][bj][0] = *(const f32x4*)(base32 + off); bv[mm][bj][1] = *(const f32x4*)(base32 + off + 4); }
                    else { const u32x4 h4 = *(const u32x4*)(hi + off); u32x4 l4 = (u32x4){0u, 0u, 0u, 0u}; if (MK_LO) l4 = *(const u32x4*)(lo + off); u32x2 ha, hb_, la, lb; ha.x = h4.x; ha.y = h4.y; hb_.x = h4.z; hb_.y = h4.w; la.x = l4.x; la.y = l4.y; lb.x = l4.z; lb.y = l4.w;
                        bv[mm][bj][0] = unpack_bf4(ha) + unpack_bf4(la); bv[mm][bj][1] = unpack_bf4(hb_) + unpack_bf4(lb); } } }
#pragma unroll
            for (int mm = 0; mm < 2; ++mm) { const int m = m0 + mm; const int row = u.pm * 256 + ai * HALF + wr * 64 + m * 16 + fr; float ss = 0.f;
#pragma unroll
                for (int bj = 0; bj < NBJ; ++bj) { const int col = GLU ? (u.pn * 128 + wc * 32 + 8 * fq) : (u.pn * 256 + bj * HALF + wc * 32 + 8 * fq); const size_t off = (size_t)row * D + col;
                    f32x4 v[2];
#pragma unroll
                    for (int n = 0; n < 2; ++n) { f32x4 t = acc[ai][bj][m][n];
                        if (GLU) { const f32x4 gt = acc[ai][1][m][n]; t[0] *= sigmoidf_(gt[0]); t[1] *= sigmoidf_(gt[1]); t[2] *= sigmoidf_(gt[2]); t[3] *= sigmoidf_(gt[3]); }
                        t = t + bv[mm][bj][n]; v[n] = t; ss += (t[0] * t[0] + t[1] * t[1]) + (t[2] * t[2] + t[3] * t[3]); }
                    u32x4 h4; h4.x = cvtpk(v[0][0], v[0][1]); h4.y = cvtpk(v[0][2], v[0][3]); h4.z = cvtpk(v[1][0], v[1][1]); h4.w = cvtpk(v[1][2], v[1][3]);
                    u32x2 ha, hb_; ha.x = h4.x; ha.y = h4.y; hb_.x = h4.z; hb_.y = h4.w; const f32x4 d0 = v[0] - unpack_bf4(ha), d1 = v[1] - unpack_bf4(hb_);
                    u32x4 l4; l4.x = cvtpk(d0[0], d0[1]); l4.y = cvtpk(d0[2], d0[3]); l4.z = cvtpk(d1[0], d1[1]); l4.w = cvtpk(d1[2], d1[3]);
                    *(u32x4*)(hi + off) = h4; if (MK_LO) *(u32x4*)(lo + off) = l4; }
                ss += shx(ss, 16, fq * 16 + fr); ss += shx(ss, 32, fq * 16 + fr);
                if (fq == 0) xl[wc * 256 + ai * HALF + wr * 64 + m * 16 + fr] = ss; }
        }
        MK_LBAR();
        { const int t = (wr * 4 + wc) * 64 + fq * 16 + fr; if (t < 256) { const float s = (xl[t] + xl[256 + t]) + (xl[512 + t] + xl[768 + t]); if (RSN == 1) __hip_atomic_fetch_add(rsq + u.pm * 256 + t, s, __ATOMIC_RELAXED, __HIP_MEMORY_SCOPE_AGENT);
                else { float* rp = rsq + (size_t)(u.pm * 256 + t) * 8; rp[u.pn] = s; if (!GLU) rp[4 + u.pn] = 0.f; } } }
    }
};
struct EpiSoftmax {
    static constexpr bool PERM = true;
    bf16_t* P; LAS float* xl; const float* rsq;
    __device__ __forceinline__ void operator()(AccT& acc, const Unit& u, int wr, int wc, int fr, int fq) const {
        LAS float* mx = xl; LAS float* sm = xl + 1024;
#pragma unroll
        for (int ai = 0; ai < 2; ++ai)
#pragma unroll
            for (int m = 0; m < 4; ++m) { float mm = -3.0e38f; const float rr = rs_of(rsq, u.pm * 256 + ai * HALF + wr * 64 + m * 16 + fr);
#pragma unroll
                for (int bj = 0; bj < 2; ++bj)
#pragma unroll
                    for (int n = 0; n < 2; ++n) { const f32x4 v = acc[ai][bj][m][n] * rr; acc[ai][bj][m][n] = v; mm = fmaxf(mm, fmaxf(fmaxf(v[0], v[1]), fmaxf(v[2], v[3]))); }
                mm = fmaxf(mm, shx(mm, 16, fq * 16 + fr)); mm = fmaxf(mm, shx(mm, 32, fq * 16 + fr));
                if (fq == 0) mx[wc * 256 + ai * HALF + wr * 64 + m * 16 + fr] = mm; }
        MK_LBAR();
#pragma unroll
        for (int ai = 0; ai < 2; ++ai)
#pragma unroll
            for (int m = 0; m < 4; ++m) { const int row = ai * HALF + wr * 64 + m * 16 + fr;
                const float mm = fmaxf(fmaxf(mx[row], mx[256 + row]), fmaxf(mx[512 + row], mx[768 + row])); float s = 0.f;
#pragma unroll
                for (int bj = 0; bj < 2; ++bj)
#pragma unroll
                    for (int n = 0; n < 2; ++n)
#pragma unroll
                        for (int j = 0; j < 4; ++j) { const float e = fast_exp2(acc[ai][bj][m][n][j] - mm); acc[ai][bj][m][n][j] = e; s += e; }
                s += shx(s, 16, fq * 16 + fr); s += shx(s, 32, fq * 16 + fr);
                if (fq == 0) sm[wc * 256 + row] = s; }
        MK_LBAR();
#pragma unroll
        for (int ai = 0; ai < 2; ++ai)
#pragma unroll
            for (int m = 0; m < 4; ++m) { int zo = 0; asm volatile("" : "+v"(zo)); const int row = ai * HALF + wr * 64 + m * 16 + fr + zo;
                const float inv = fast_rcp((sm[row] + sm[256 + row]) + (sm[512 + row] + sm[768 + row]));
#pragma unroll
                for (int bj = 0; bj < 2; ++bj) { const f32x4 v0 = acc[ai][bj][m][0], v1 = acc[ai][bj][m][1]; u32x4 w;
                    w.x = cvtpk(v0[0] * inv, v0[1] * inv); w.y = cvtpk(v0[2] * inv, v0[3] * inv);
                    w.z = cvtpk(v1[0] * inv, v1[1] * inv); w.w = cvtpk(v1[2] * inv, v1[3] * inv);
                    *(u32x4*)(P + (size_t)(u.pm * 256 + row) * D + u.pn * 256 + bj * HALF + wc * 32 + 8 * fq) = w; } }
    }
};
struct EpiConvGlu {
    static constexpr int PERM = 2;
    bf16_t* Gb; const float* rsq; const float* cw; const float* cb; LAS float* xl;
    __device__ __forceinline__ void operator()(AccT& acc, const Unit& u, int wr, int wc, int fr, int fq) const {
        const int bt = u.pm / 17, jt = u.pm % 17; int o0 = 254 * jt; if (o0 > 3842) o0 = 3842;
        const int tib0 = o0 - 2; const long tok0 = (long)bt * SEQ + tib0;
#pragma unroll
        for (int ai = 0; ai < 2; ++ai)
#pragma unroll
            for (int m = 0; m < 4; ++m) { const int R = ai * HALF + wr * 64 + m * 16 + fr; const bool ok = (tib0 + R) >= 0; const float r = ok ? rs_of(rsq, (int)(tok0 + R)) : 0.f;
#pragma unroll
                for (int bj = 0; bj < 2; ++bj)
#pragma unroll
                    for (int n = 0; n < 2; ++n) acc[ai][bj][m][n] = acc[ai][bj][m][n] * r; }
        if (fr >= 14) {
#pragma unroll
            for (int ai = 0; ai < 2; ++ai) { LAS float* hp = xl + ((((ai * 2 + wr) * 4 + wc) * 2 + (fr - 14)) * 4 + fq) * 16;
#pragma unroll
                for (int bj = 0; bj < 2; ++bj)
#pragma unroll
                    for (int n = 0; n < 2; ++n) *(LAS f32x4*)(hp + (bj * 2 + n) * 4) = acc[ai][bj][3][n]; }
        }
        MK_LBAR();
        const int f0 = u.pn * 128 + wc * 32 + 8 * (fq & 1) + 4 * (fq >> 1);
        unsigned dep = 0u;
#pragma unroll
        for (int n = 0; n < 2; ++n) {
            int zo = 0; asm volatile("" : "+v"(zo) : "v"(dep));
            const float* cwp = cw + f0 + 16 * n + zo; const float* cbp = cb + f0 + 16 * n + zo;
            f32x4 w0[2], w1[2], w2[2], bb[2];
#pragma unroll
            for (int bj = 0; bj < 2; ++bj) { w0[bj] = *(const f32x4*)(cwp + bj * FF); w1[bj] = *(const f32x4*)(cwp + 2 * FF + bj * FF); w2[bj] = *(const f32x4*)(cwp + 4 * FF + bj * FF); bb[bj] = *(const f32x4*)(cbp + bj * FF); }
#pragma unroll
            for (int ai = 0; ai < 2; ++ai) { const int grp = ai * 2 + wr;
                f32x4 pv[2]; u32x2 wprev; wprev.x = 0u; wprev.y = 0u;
#pragma unroll
                for (int bj = 0; bj < 2; ++bj) { f32x4 hv = (f32x4){0.f, 0.f, 0.f, 0.f};
                    if (grp > 0 && fr >= 14) hv = *(const LAS f32x4*)(xl + (((((grp - 1) * 4 + wc) * 2 + (fr - 14)) * 4 + fq) * 16) + (bj * 2 + n) * 4);
                    pv[bj] = hv; }
#pragma unroll
                for (int m = 0; m < 4; ++m) { const int R = ai * HALF + wr * 64 + m * 16 + fr;
                    f32x4 res[2];
#pragma unroll
                    for (int bj = 0; bj < 2; ++bj) { const f32x4 cur = acc[ai][bj][m][n]; f32x4 x1, x2;
#pragma unroll
                        for (int j = 0; j < 4; ++j) {
                            const float c1 = fr == 15 ? pv[bj][j] : cur[j], c2 = fr >= 14 ? pv[bj][j] : cur[j];
                            x1[j] = dppf<0x121>(c1); x2[j] = dppf<0x122>(c2); }
                        res[bj] = w2[bj] * cur + w1[bj] * x1 + w0[bj] * x2 + bb[bj]; pv[bj] = cur; }
                    f32x4 e4;
#pragma unroll
                    for (int j = 0; j < 4; ++j) e4[j] = fast_exp2(res[1][j] * -LOG2E);
                    e4 = e4 + 1.f;
#pragma unroll
                    for (int j = 0; j < 4; ++j) e4[j] = fast_rcp(e4[j]);
                    const f32x4 a = res[1] * e4 * res[0];
                    u32x2 w; w.x = cvtpk(a[0], a[1]); w.y = cvtpk(a[2], a[3]); dep = w.y;
                    if (!(m & 1)) wprev = w;
                    else {
                        const auto r0 = __builtin_amdgcn_permlane32_swap(wprev.x, w.x, false, false); const auto r1 = __builtin_amdgcn_permlane32_swap(wprev.y, w.y, false, false);
                        u32x4 w4; w4.x = r0[0]; w4.y = r1[0]; w4.z = r0[1]; w4.w = r1[1];
                        const int Rs = (fq < 2) ? R - 16 : R;
                        if (Rs >= 2) *(u32x4*)(Gb + (size_t)(tok0 + Rs) * FF + u.pn * 128 + wc * 32 + 16 * n + 8 * (fq & 1)) = w4; } } }
        }
        MK_LBAR();
    }
};
struct EpiS5S {
    static constexpr bool PERM = false;
    float* Sst;
    __device__ __forceinline__ void operator()(const AccT& acc, const Unit& u, int wr, int wc, int fr, int fq) const {
#pragma unroll
        for (int ai = 0; ai < 2; ++ai)
#pragma unroll
            for (int m = 0; m < 4; ++m) { const int row = u.pm * 256 + ai * HALF + wr * 64 + m * 16 + fr;
#pragma unroll
                for (int n = 0; n < 2; ++n) *(f32x4*)(Sst + (size_t)row * 128 + wc * 32 + n * 16 + fq * 4) = acc[ai][0][m][n]; }
    }
};
__device__ __forceinline__ float gelu_tanh(float x) { const float uu = 0.7978845608028654f * (x + 0.044715f * x * x * x); const float e = fast_exp2(2.f * LOG2E * uu); return x * (1.f - fast_rcp(1.f + e)); }
struct EpiS5Y {
    static constexpr bool PERM = false;
    bf16_t* Y; const bf16_t* Z; const float* dvec;
    __device__ __forceinline__ void operator()(const AccT& acc, const Unit& u, int wr, int wc, int fr, int fq) const {
        const int g = u.pm >> 2, mt = u.pm & 3;
#pragma unroll
        for (int ai = 0; ai < 2; ++ai)
#pragma unroll
            for (int m = 0; m < 4; ++m) { const int nrow = mt * 256 + ai * HALF + wr * 64 + m * 16 + fr;
#pragma unroll
                for (int bj = 0; bj < 2; ++bj)
#pragma unroll
                    for (int n = 0; n < 2; ++n) { const int col = bj * HALF + wc * 32 + n * 16 + fq * 4; const int t = col >> 4, i0 = col & 15;
                        const u32x2 uz = *(const u32x2*)(Z + ((size_t)g * 1024 + nrow) * 384 + col);
                        const float u0 = __builtin_bit_cast(float, uz.x << 16), u1 = __builtin_bit_cast(float, uz.x & 0xffff0000u), u2 = __builtin_bit_cast(float, uz.y << 16), u3 = __builtin_bit_cast(float, uz.y & 0xffff0000u);
                        const f32x4 dv = *(const f32x4*)(dvec + g * 16 + i0); const f32x4 a = acc[ai][bj][m][n];
                        u32x2 w; w.x = cvtpk(gelu_tanh(a[0] + dv[0] * u0), gelu_tanh(a[1] + dv[1] * u1)); w.y = cvtpk(gelu_tanh(a[2] + dv[2] * u2), gelu_tanh(a[3] + dv[3] * u3));
                        *(u32x2*)(Y + (size_t)(nrow * 16 + t) * D + g * 16 + i0) = w; } }
    }
};
}
namespace mk {
#define RLX_AGENT __ATOMIC_RELAXED, __HIP_MEMORY_SCOPE_AGENT
#define XB_TMO      128
#define XB_XCNT(j)  (256  + 64 * (j))
#define XB_XSUB(j)  (1280 + 64 * (j))
#define XB_XGEN(j)  (2304 + 64 * (j))
#define XB_TOP      3328
#define XB_TOPGEN   3392
#define XCD_BAR_WORDS 3456
#define XB_SPIN_CAP (1u << 18)

__device__ __forceinline__ unsigned xb_ld(unsigned* p)              { return __hip_atomic_load(p, __ATOMIC_RELAXED, __HIP_MEMORY_SCOPE_AGENT); }
__device__ __forceinline__ unsigned xb_add(unsigned* p, unsigned v) { return __hip_atomic_fetch_add(p, v, __ATOMIC_RELAXED, __HIP_MEMORY_SCOPE_AGENT); }
__device__ __forceinline__ unsigned xb_xcc_id() { return (unsigned)__builtin_amdgcn_s_getreg((3 << 11) | 20) & 0xFu; }
#define XB_SPIN(cond, bar) do { unsigned _sp = 0; while (cond) { __builtin_amdgcn_s_sleep(1); \
    if ((++_sp & 255u) == 0u) { if (xb_ld(&(bar)[XB_TMO])) break; if (_sp > XB_SPIN_CAP) { atomicAdd(&(bar)[XB_TMO], 1u); break; } } } } while (0)

struct XcdBarrier {
    unsigned* bar; unsigned x;
    volatile LAS unsigned* st;
};

__device__ __forceinline__ XcdBarrier xcd_barrier_post(unsigned* bar, volatile LAS unsigned* st) {
    XcdBarrier b; b.bar = bar; b.x = xb_xcc_id(); b.st = st;
    if (threadIdx.x == 0) (void)xb_add(&bar[XB_XCNT(b.x)], 1u);
    return b;
}
__device__ __forceinline__ void xcd_barrier_complete(unsigned* bar, unsigned x, unsigned& nloc, unsigned& nx) {
    const unsigned G = gridDim.x * gridDim.y * gridDim.z;
    unsigned sum, cnt, mine, sp = 0u;
    for (;;) {
        sum = 0u; cnt = 0u; mine = 0u;
#pragma unroll
        for (unsigned j = 0; j < 16; ++j) { const unsigned c = xb_ld(&bar[XB_XCNT(j)]); sum += c; cnt += (c > 0u) ? 1u : 0u; mine = (j == x) ? c : mine; }
        if (sum == G) break;
        __builtin_amdgcn_s_sleep(1);
        if ((++sp & 255u) == 0u) { if (xb_ld(&bar[XB_TMO])) break; if (sp > XB_SPIN_CAP) { atomicAdd(&bar[XB_TMO], 1u); break; } }
    }
    nloc = mine > 0u ? mine : 1u; nx = cnt > 0u ? cnt : 1u;
}

__device__ __forceinline__ void xcd_barrier(const XcdBarrier& b) {
    asm volatile("s_waitcnt vmcnt(0)" ::: "memory");
    __syncthreads();
    if (threadIdx.x == 0) {
        unsigned* bar = b.bar;
        __builtin_amdgcn_s_waitcnt(0);
        unsigned nloc = b.st[0], nx = b.st[1];
        if (nloc == 0u) { xcd_barrier_complete(bar, b.x, nloc, nx); b.st[0] = nloc; b.st[1] = nx; }
        const unsigned old = xb_add(&bar[XB_XSUB(b.x)], 1u);
        const unsigned gen = old / nloc;
        if (old + 1u == (gen + 1u) * nloc) {
            __builtin_amdgcn_fence(__ATOMIC_RELEASE, "agent");
            asm volatile("s_waitcnt vmcnt(0)" ::: "memory");
            const unsigned og = xb_add(&bar[XB_TOP], 1u);
            const unsigned tg = og / nx;
            if (og + 1u == (tg + 1u) * nx) xb_add(&bar[XB_TOPGEN], 1u);
            else XB_SPIN(xb_ld(&bar[XB_TOPGEN]) == tg, bar);
            __builtin_amdgcn_fence(__ATOMIC_ACQUIRE, "agent");
            xb_add(&bar[XB_XGEN(b.x)], 1u);
            asm volatile("s_waitcnt vmcnt(0)" ::: "memory");
        } else {
            XB_SPIN(xb_ld(&bar[XB_XGEN(b.x)]) == gen, bar);
            __builtin_amdgcn_fence(__ATOMIC_ACQUIRE, "agent");
            asm volatile("s_waitcnt vmcnt(0)" ::: "memory");
        }
    }
    __syncthreads();
}
}
namespace mk {
constexpr size_t MiB = 1u << 20;
constexpr size_t OFF_RS = 1 * MiB;
constexpr size_t OFF_W = 2 * MiB;
constexpr size_t OFF_WQP = 113 * MiB;
constexpr size_t OFF_HB = 122 * MiB;
constexpr size_t OFF_MEMB = 154 * MiB;
constexpr size_t OFF_KV = 156 * MiB;
constexpr size_t OFF_S5WB = 172 * MiB;
constexpr size_t OFF_S5TW = 180 * MiB;
constexpr size_t OFF_MT = 192 * MiB;
constexpr size_t OFF_NT = 224 * MiB;
constexpr size_t OFF_SCR = 256 * MiB;
constexpr size_t WS_NEED = 352 * MiB;
constexpr size_t W_PW = 0, W_QKV = 524288, W_SO = 3670016, W_GLU = 4718592, W_L0 = 6815744, W_LSTRIDE = 12845056;
constexpr size_t WL_Q = 0, WL_KV = 1048576, WL_O = 3145728, WL_UP = 4194304, WL_DN = 9961472;

struct P { const float* in[27]; float* out; unsigned char* ws; int lo, hi; };
__device__ __forceinline__ int otid(int wv) { return wv * 64 + lane_id_v(); }

__device__ __forceinline__ void transpose_item(const float* W, int ldw, int k0, int n0, bf16_t* WT, int ldk, int drow0, const float* sk, const float* sn, float cst, LAS float* scr, int lane) {
    float v[32];
#pragma unroll
    for (int i = 0; i < 32; ++i) { const int kk = 2 * i + (lane >> 5); v[i] = W[(size_t)(k0 + kk) * ldw + n0 + (lane & 31)]; }
#pragma unroll
    for (int i = 0; i < 32; ++i) { const int kk = 2 * i + (lane >> 5); scr[kk * 33 + (lane & 31)] = v[i]; }
    asm volatile("s_waitcnt lgkmcnt(0)" ::: "memory");
    const int c = lane & 7;
    f32x4 ka = (f32x4){1.f, 1.f, 1.f, 1.f}, kb = ka; if (sk) { ka = *(const f32x4*)(sk + k0 + 8 * c); kb = *(const f32x4*)(sk + k0 + 8 * c + 4); }
#pragma unroll
    for (int j = 0; j < 4; ++j) { const int n = (lane >> 3) + 8 * j; const LAS float* s = scr + (8 * c) * 33 + n; const float sc = cst * (sn ? sn[n0 + n] : 1.f);
        u32x4 o; o.x = cvtpk(s[0 * 33] * sc * ka[0], s[1 * 33] * sc * ka[1]); o.y = cvtpk(s[2 * 33] * sc * ka[2], s[3 * 33] * sc * ka[3]); o.z = cvtpk(s[4 * 33] * sc * kb[0], s[5 * 33] * sc * kb[1]); o.w = cvtpk(s[6 * 33] * sc * kb[2], s[7 * 33] * sc * kb[3]);
        *(u32x4*)(WT + (size_t)(drow0 + n) * ldk + k0 + 8 * c) = o; }
    asm volatile("s_waitcnt lgkmcnt(0)" ::: "memory");
}
struct WJob { const float* W; int K, N; bf16_t* dst; const float* sk; const float* sn; int half; float cst; int qcols; };
__device__ __forceinline__ WJob wjob(const P& p, int id) {
    bf16_t* Wb = (bf16_t*)(p.ws + OFF_W); WJob j; j.sk = nullptr; j.sn = nullptr; j.half = 0; j.cst = 1.f; j.qcols = 1 << 30;
    if (id < 8) { const int jj = id >> 2, g = id & 3; j.W = p.in[3] + (size_t)id * 65536; j.K = 256; j.N = 256; j.dst = Wb + W_PW + (size_t)id * 65536; j.sk = p.in[2] + (jj * 3) * D + g * 256; j.sn = p.in[4] + jj * D + g * 256; }
    else if (id == 8) { j.W = p.in[5]; j.K = D; j.N = 3 * D; j.dst = Wb + W_QKV; j.sk = p.in[2] + 1 * D; j.cst = 0.125f * LOG2E; j.qcols = D; }
    else if (id == 9) { j.W = p.in[6]; j.K = D; j.N = D; j.dst = Wb + W_SO; }
    else if (id == 10) { j.W = p.in[15]; j.K = D; j.N = 2 * D; j.dst = Wb + W_GLU; j.half = D; }
    else { const int i = (id - 11) / 5, w = (id - 11) % 5; bf16_t* L = Wb + W_L0 + (size_t)i * W_LSTRIDE;
        if (w == 0) { j.W = p.in[18] + (size_t)i * D * D; j.K = D; j.N = D; j.dst = L + WL_Q; j.sk = p.in[16] + i * D; j.cst = 0.0625f * LOG2E; }
        else if (w == 1) { j.W = p.in[19] + (size_t)i * D * 2 * D; j.K = D; j.N = 2 * D; j.dst = L + WL_KV; j.sk = p.in[17] + i * D; }
        else if (w == 2) { j.W = p.in[20] + (size_t)i * D * D; j.K = D; j.N = D; j.dst = L + WL_O; }
        else if (w == 3) { j.W = p.in[22] + (size_t)i * D * 2 * FF; j.K = D; j.N = 2 * FF; j.dst = L + WL_UP; j.sk = p.in[21] + i * D; j.half = FF; }
        else { j.W = p.in[25] + (size_t)i * FF * D; j.K = FF; j.N = D; j.dst = L + WL_DN; } }
    return j;
}
constexpr int N_WJOBS = 31;
__device__ __forceinline__ int wjob_items(int id) {
    if (id < 8) return 4 * 8; if (id == 8) return 16 * 96; if (id == 9) return 16 * 32; if (id == 10) return 16 * 64;
    const int w = (id - 11) % 5; return w == 0 ? 0   : w == 1 ? 16 * 64 : w == 2 ? 16 * 32 : w == 3 ? 16 * 176 : 44 * 32;
}
__device__ __forceinline__ void row_to_bf16(const float* xrow, bf16_t* orow, float* sq, float* copy, int lane) {
    const f32x4* xr = (const f32x4*)xrow + lane; f32x4 v[4]; float s = 0.f;
#pragma unroll
    for (int j = 0; j < 4; ++j) { v[j] = xr[64 * j]; s += (v[j][0] * v[j][0] + v[j][1] * v[j][1]) + (v[j][2] * v[j][2] + v[j][3] * v[j][3]); }
    s = wave_sum(s, lane); if (lane < RSN) sq[lane] = lane == 0 ? s : 0.f;
#pragma unroll
    for (int j = 0; j < 4; ++j) { if (orow) { u32x2 w; w.x = cvtpk(v[j][0], v[j][1]); w.y = cvtpk(v[j][2], v[j][3]); *((u32x2*)orow + lane + 64 * j) = w; } if (copy) *((f32x4*)copy + lane + 64 * j) = v[j]; }
}
__device__ __forceinline__ void s5_items(const P& p, LAS float* sl, int wv) {
    const int tid = otid(wv); bf16_t* WB = (bf16_t*)(p.ws + OFF_S5WB); bf16_t* TW = (bf16_t*)(p.ws + OFF_S5TW);
    const float* a_re = p.in[7]; const float* a_im = p.in[8]; const float* ldt = p.in[9]; const float* b_re = p.in[10]; const float* b_im = p.in[11]; const float* c_re = p.in[12]; const float* c_im = p.in[13];
    LAS float* sCr = sl; LAS float* sCi = sl + 1024; LAS float* sBr = sl + 2048; LAS float* sBi = sl + 3072;
    LAS float* pwr = sl + 4096; LAS float* pwi = pwr + 17 * 64; LAS float* wfr = pwi + 17 * 64; LAS float* wfi = wfr + 17 * 64;
    for (int task = blockIdx.x; task < 256; task += gridDim.x) {
        const int g = task >> 2, part = task & 3;
        __syncthreads();
        for (int q = tid; q < 1024; q += 512) { sCr[q] = c_re[g * 1024 + q]; sCi[q] = c_im[g * 1024 + q]; sBr[q] = b_re[g * 1024 + q]; sBi[q] = b_im[g * 1024 + q]; }
        if (tid < 64) { const int pp = tid; const float lr = a_re[g * 64 + pp], li = a_im[g * 64 + pp], dt = expf(ldt[g]); const float xr = lr * dt, xi = li * dt;
            float s1, c1; sincosf(xi, &s1, &c1); const float ex = expf(xr); const float ar = ex * c1, ai = ex * s1;
            const float sh = sinf(0.5f * xi); const float nr = expm1f(xr) * c1 - 2.f * sh * sh, ni = ex * s1; const float den = lr * lr + li * li;
            const float fr_ = (nr * lr + ni * li) / den, fi_ = (ni * lr - nr * li) / den;
            float cr = 1.f, ci = 0.f;
            for (int e = 0; e <= 16; ++e) { pwr[e * 64 + pp] = cr; pwi[e * 64 + pp] = ci; wfr[e * 64 + pp] = cr * fr_ - ci * fi_; wfi[e * 64 + pp] = cr * fi_ + ci * fr_;
                const float tr = cr * ar - ci * ai, ti = cr * ai + ci * ar; cr = tr; ci = ti; } }
        __syncthreads();
        const int r0 = part * 16, r1 = (part == 3) ? 63 : r0 + 16;
        for (int r = r0; r < r1; ++r) {
            if (r < 31) {
                const int l = r - 15;
                if (tid < 256) { const int i = tid >> 4, j = tid & 15; float val = 0.f;
                    if (l >= 0) { for (int pp = 0; pp < 64; ++pp) { const float cr = sCr[i * 64 + pp], ci = sCi[i * 64 + pp], br = sBr[pp * 16 + j], bi = sBi[pp * 16 + j];
                            const float wr_ = wfr[l * 64 + pp], wi_ = wfi[l * 64 + pp]; val += (cr * wr_ - ci * wi_) * br - (cr * wi_ + ci * wr_) * bi; } }
                    const bf16_t bv = (bf16_t)(cvtpk(val, 0.f) & 0xffffu);
                    for (int t = 0; t < 16; ++t) { const int s = t - l; if (s >= 0 && s < 16) TW[((size_t)g * 256 + t * 16 + i) * 384 + s * 16 + j] = bv; } }
            } else if (r < 47) {
                const int s = r - 31, e = 15 - s;
                for (int q4 = tid; q4 < 2048; q4 += 512) { const int q = q4 >> 4, j = q4 & 15, pp = q >> 1, im = q & 1; const float br = sBr[pp * 16 + j], bi = sBi[pp * 16 + j]; const float wr_ = wfr[e * 64 + pp], wi_ = wfi[e * 64 + pp];
                    const float val = im ? (wr_ * bi + wi_ * br) : (wr_ * br - wi_ * bi);
                    WB[((size_t)g * 256 + q) * 256 + s * 16 + j] = (bf16_t)(cvtpk(val, 0.f) & 0xffffu); WB[((size_t)g * 256 + 128 + q) * 256 + s * 16 + j] = 0; }
            } else {
                const int t = r - 47, e = t + 1;
                for (int q4 = tid; q4 < 2048; q4 += 512) { const int i = q4 >> 7, q = q4 & 127, pp = q >> 1, im = q & 1; const float cr = sCr[i * 64 + pp], ci = sCi[i * 64 + pp]; const float wr_ = pwr[e * 64 + pp], wi_ = pwi[e * 64 + pp];
                    const float val = im ? -(cr * wi_ + ci * wr_) : (cr * wr_ - ci * wi_);
                    TW[((size_t)g * 256 + t * 16 + i) * 384 + 256 + q] = (bf16_t)(cvtpk(val, 0.f) & 0xffffu); }
            }
        }
    }
    __syncthreads();
}
__device__ __forceinline__ void prologue(const P& p, LAS unsigned char* lds, int wv) {
    const int tid = otid(wv), lane = tid & 63, wave = tid >> 6; const int gw = blockIdx.x * 8 + wave, NGW = gridDim.x * 8;
    float* RS = MK_LO ? (float*)(p.ws + OFF_RS) : p.out;
    if (blockIdx.x & 1) { s5_items(p, (LAS float*)lds, wv); __syncthreads(); }
    if (RSN == 1) for (size_t i = (size_t)blockIdx.x * 512 + tid; i < (size_t)12 * T / 4; i += (size_t)gridDim.x * 512) ((f32x4*)(RS + T))[i] = (f32x4){0.f, 0.f, 0.f, 0.f};
    bf16_t* HB = (bf16_t*)(p.ws + OFF_HB);
    for (int m = gw; m < T; m += NGW) row_to_bf16(p.in[0] + (size_t)m * D, nullptr, RS + (size_t)m * RSN, nullptr, lane);
    bf16_t* MB = (bf16_t*)(p.ws + OFF_MEMB);
    for (int m = gw; m < 1024; m += NGW) row_to_bf16(p.in[1] + (size_t)m * D, MB + (size_t)m * D, RS + ((size_t)13 * T + m) * RSN, nullptr, lane);
    LAS float* scr = (LAS float*)(lds + wave * 16384);
    int total = 0;
    for (int id = 0; id < N_WJOBS; ++id) total += wjob_items(id);
    for (int it = gw; it < total; it += NGW) {
        int r = it, id = 0; for (;; ++id) { const int c = wjob_items(id); if (r < c) break; r -= c; }
        const WJob j = wjob(p, id); const int nblk = j.N / 32, kb = r / nblk, nb = r % nblk, k0 = 64 * kb, n0 = 32 * nb;
        int drow0 = n0; if (j.half) { const int hf = n0 / j.half, f = n0 % j.half; drow0 = (f / 128) * 256 + hf * 128 + (f % 128); }
        transpose_item(j.W, j.N, k0, n0, j.dst, j.K, drow0, j.sk, j.sn, n0 < j.qcols ? j.cst : 1.f, scr, lane);
    }
    { bf16_t* WQP = (bf16_t*)(p.ws + OFF_WQP);
      for (size_t idx = (size_t)blockIdx.x * 512 + tid; idx < (size_t)4 * D * D / 8; idx += (size_t)gridDim.x * 512) { const size_t e0 = idx * 8; const int i = (int)(e0 >> 20), k = (int)(e0 >> 10) & 1023;
          const float sc = p.in[16][i * D + k] * (0.0625f * LOG2E); const f32x4 x0 = *(const f32x4*)(p.in[18] + e0), x1 = *(const f32x4*)(p.in[18] + e0 + 4);
          u32x4 w; w.x = cvtpk(x0[0] * sc, x0[1] * sc); w.y = cvtpk(x0[2] * sc, x0[3] * sc); w.z = cvtpk(x1[0] * sc, x1[1] * sc); w.w = cvtpk(x1[2] * sc, x1[3] * sc); *(u32x4*)(WQP + e0) = w; } }
    __syncthreads();
    if (!(blockIdx.x & 1)) s5_items(p, (LAS float*)lds, wv);
}
__device__ __forceinline__ void ld8(const float* h32, const bf16_t* hi, const bf16_t* lo, size_t off, f32x4& a, f32x4& b) {
    if (h32) { a = *(const f32x4*)(h32 + off); b = *(const f32x4*)(h32 + off + 4); } else load_hilo8(hi, lo, off, a, b); }
__device__ __forceinline__ void pool_prep(const float* h32, const bf16_t* hi, const bf16_t* lo, const float* rsq, bf16_t* ph, int wv) {
    for (size_t idx = (size_t)blockIdx.x * 512 + otid(wv); idx < (size_t)(T / 16) * 128; idx += (size_t)gridDim.x * 512) {
        const int tok0 = (int)(idx >> 7) * 16, c = ((int)idx & 127) * 8; const int win = 2 << (c >> 8); const int tib0 = tok0 & (SEQ - 1);
        f32x4 sa = (f32x4){0.f, 0.f, 0.f, 0.f}, sb = sa;
        for (int k = win - 1; k >= 1; --k) if (tib0 - k >= 0) { const float r = rs_of(rsq, tok0 - k); f32x4 xa, xb; ld8(h32, hi, lo, (size_t)(tok0 - k) * D + c, xa, xb); sa = sa + xa * r; sb = sb + xb * r; }
#pragma unroll
        for (int t = 0; t < 16; ++t) { const int row = tok0 + t; const float r = rs_of(rsq, row); f32x4 xa, xb; ld8(h32, hi, lo, (size_t)row * D + c, xa, xb); xa = xa * r; xb = xb * r; sa = sa + xa; sb = sb + xb;
            const int cnt = min(tib0 + t + 1, win); const float ic = 1.f / (float)cnt; const f32x4 oa = sa * ic - xa, ob = sb * ic - xb;
            u32x4 w; w.x = cvtpk(oa[0], oa[1]); w.y = cvtpk(oa[2], oa[3]); w.z = cvtpk(ob[0], ob[1]); w.w = cvtpk(ob[2], ob[3]);
            *(u32x4*)(ph + (size_t)row * D + c) = w;
            const int ro = tib0 + t - (win - 1);
            if (ro >= 0) { const float r2 = rs_of(rsq, row - (win - 1)); f32x4 ya, yb; ld8(h32, hi, lo, (size_t)(row - (win - 1)) * D + c, ya, yb); sa = sa - ya * r2; sb = sb - yb * r2; } }
    }
}
__device__ __forceinline__ void s5_zfill(const bf16_t* hi, const bf16_t* lo, const float* rsq, const float* gain, bf16_t* Z, int wv) {
    for (size_t idx = (size_t)blockIdx.x * 512 + otid(wv); idx < (size_t)T * 128; idx += (size_t)gridDim.x * 512) {
        const int tok = (int)(idx >> 7), c = ((int)idx & 127) * 8; const float r = rs_of(rsq, tok);
        f32x4 a, b; load_hilo8(hi, lo, (size_t)tok * D + c, a, b); const f32x4 ga = *(const f32x4*)(gain + c), gb = *(const f32x4*)(gain + c + 4);
        u32x4 w; w.x = cvtpk(a[0] * r * ga[0], a[1] * r * ga[1]); w.y = cvtpk(a[2] * r * ga[2], a[3] * r * ga[3]); w.z = cvtpk(b[0] * r * gb[0], b[1] * r * gb[1]); w.w = cvtpk(b[2] * r * gb[2], b[3] * r * gb[3]);
        const int g = c >> 4, n = tok >> 4, t = tok & 15;
        *(u32x4*)(Z + ((size_t)g * 1024 + n) * 384 + t * 16 + (c & 15)) = w;
    }
}
__device__ __forceinline__ void s5_scan(const P& p, const float* Sst, bf16_t* Z, int j5, int wv) {
    const int tid = otid(wv); const int lane = tid & 63, wave = tid >> 6; const int gw = blockIdx.x * 8 + wave, NGW = gridDim.x * 8;
    for (int task = gw; task < 256; task += NGW) {
        const int b = task >> 6, g = task & 63;
        const float lr = p.in[7][j5 * 4096 + g * 64 + lane], li = p.in[8][j5 * 4096 + g * 64 + lane], dt = expf(p.in[9][j5 * 64 + g]);
        const float mg = expf(16.f * lr * dt); float sn, cs; sincosf(16.f * li * dt, &sn, &cs); const float ar = mg * cs, ai = mg * sn;
        float xr = 0.f, xi = 0.f;
        for (int n0 = 0; n0 < 256; n0 += 16) {
            f32x2 sv[16];
#pragma unroll
            for (int k = 0; k < 16; ++k) sv[k] = *(const f32x2*)(Sst + ((size_t)g * 1024 + b * 256 + n0 + k) * 128 + 2 * lane);
#pragma unroll
            for (int k = 0; k < 16; ++k) { *(unsigned*)(Z + ((size_t)g * 1024 + b * 256 + n0 + k) * 384 + 256 + 2 * lane) = cvtpk(xr, xi);
                const float nr = ar * xr - ai * xi + sv[k][0], ni = ar * xi + ai * xr + sv[k][1]; xr = nr; xi = ni; }
        }
    }
}
__device__ __forceinline__ void sync_state(const float* h, bf16_t* HB, float* rsq, int wv) {
    const int tid = otid(wv); const int lane = tid & 63, wave = tid >> 6; const int gw = blockIdx.x * 8 + wave, NGW = gridDim.x * 8;
    for (int m = gw; m < T; m += NGW) row_to_bf16(h + (size_t)m * D, HB + (size_t)m * D, rsq + m, nullptr, lane);
}

#define MFMA32(a, b, c) __builtin_amdgcn_mfma_f32_32x32x16_bf16((a), (b), (c), 0, 0, 0)
__device__ __forceinline__ void sb_attn(const bf16_t* QK, const bf16_t* VT, bf16_t* O, int opitch, int wv) {
    const int tid = otid(wv); const int lane = tid & 63, wave = tid >> 6; const int n = lane & 31, half = lane >> 5;
    const int gw = blockIdx.x * 8 + wave, NGW = gridDim.x * 8;
    for (int task = gw; task < 8192; task += NGW) {
        const int qt = 127 - (task >> 6), bh = task & 63, b = bh >> 4, h = bh & 15;
        const int tok0 = b * SEQ + qt * 32;
        bf16x8 qf[4];
#pragma unroll
        for (int kk = 0; kk < 4; ++kk) qf[kk] = *(const bf16x8*)(QK + (size_t)(tok0 + n) * 2048 + h * 64 + 16 * kk + 8 * half);
        f32x16 o0, o1;
#pragma unroll
        for (int i = 0; i < 16; ++i) { o0[i] = 0.f; o1[i] = 0.f; }
        float R = 0.f;
        for (int kt = qt; kt >= 0; --kt) {
            const int key0 = b * SEQ + kt * 32;
            bf16x8 kf[4];
#pragma unroll
            for (int kk = 0; kk < 4; ++kk) kf[kk] = *(const bf16x8*)(QK + (size_t)(key0 + n) * 2048 + 1024 + h * 64 + 16 * kk + 8 * half);
            u32x2 vlo[2][2], vhi[2][2];
#pragma unroll
            for (int dd = 0; dd < 2; ++dd)
#pragma unroll
                for (int s = 0; s < 2; ++s) { const bf16_t* vp = VT + (size_t)(h * 64 + 32 * dd + n) * T + key0 + 16 * s + 4 * half; vlo[dd][s] = *(const u32x2*)vp; vhi[dd][s] = *(const u32x2*)(vp + 8); }
            f32x16 sa;
#pragma unroll
            for (int i = 0; i < 16; ++i) sa[i] = 0.f;
#pragma unroll
            for (int kk = 0; kk < 4; ++kk) sa = MFMA32(kf[kk], qf[kk], sa);
            const bool diag = (kt == qt);
            float Lv[16], go[4], gp[4];
#pragma unroll
            for (int r = 0; r < 16; ++r) { const float w = sa[r]; const int m = (r & 3) + 8 * (r >> 2) + 4 * half; const bool valid = !diag || (m < n);
                const float sp = fmaxf(w, 0.f) + fast_log2(1.f + fast_exp2(-fabsf(w))); Lv[r] = valid ? -sp : 0.f; sa[r] = valid ? w : -1.0e30f; }
#pragma unroll
            for (int j = 0; j < 4; ++j) { go[j] = (Lv[4 * j] + Lv[4 * j + 1]) + (Lv[4 * j + 2] + Lv[4 * j + 3]); gp[j] = shx(go[j], 32, lane); }
            float G[4]; G[3] = 0.f; G[2] = go[3] + gp[3]; G[1] = G[2] + (go[2] + gp[2]); G[0] = G[1] + (go[1] + gp[1]); const float tot = G[0] + (go[0] + gp[0]);
            float av[16];
#pragma unroll
            for (int j = 0; j < 4; ++j) { const float bs = R + G[j] + (half == 0 ? gp[j] : 0.f);
                const float s3 = 0.f, s2 = Lv[4 * j + 3], s1 = s2 + Lv[4 * j + 2], s0 = s1 + Lv[4 * j + 1];
                av[4 * j + 0] = fast_exp2(sa[4 * j + 0] + Lv[4 * j + 0] + bs + s0); av[4 * j + 1] = fast_exp2(sa[4 * j + 1] + Lv[4 * j + 1] + bs + s1);
                av[4 * j + 2] = fast_exp2(sa[4 * j + 2] + Lv[4 * j + 2] + bs + s2); av[4 * j + 3] = fast_exp2(sa[4 * j + 3] + Lv[4 * j + 3] + bs + s3); }
            R += tot;
#pragma unroll
            for (int s = 0; s < 2; ++s) { u32x4 pk; pk.x = cvtpk(av[8 * s + 0], av[8 * s + 1]); pk.y = cvtpk(av[8 * s + 2], av[8 * s + 3]); pk.z = cvtpk(av[8 * s + 4], av[8 * s + 5]); pk.w = cvtpk(av[8 * s + 6], av[8 * s + 7]);
                const bf16x8 pf = __builtin_bit_cast(bf16x8, pk);
                u32x4 v0; v0.x = vlo[0][s].x; v0.y = vlo[0][s].y; v0.z = vhi[0][s].x; v0.w = vhi[0][s].y; u32x4 v1; v1.x = vlo[1][s].x; v1.y = vlo[1][s].y; v1.z = vhi[1][s].x; v1.w = vhi[1][s].y;
                o0 = MFMA32(__builtin_bit_cast(bf16x8, v0), pf, o0); o1 = MFMA32(__builtin_bit_cast(bf16x8, v1), pf, o1); }
            if (__ballot(R >= -150.f) == 0ull) break;
        }
#pragma unroll
        for (int j = 0; j < 4; ++j) { u32x2 w0, w1; w0.x = cvtpk(o0[4 * j], o0[4 * j + 1]); w0.y = cvtpk(o0[4 * j + 2], o0[4 * j + 3]); w1.x = cvtpk(o1[4 * j], o1[4 * j + 1]); w1.y = cvtpk(o1[4 * j + 2], o1[4 * j + 3]);
            bf16_t* op = O + (size_t)(tok0 + n) * opitch + h * 64 + 8 * j + 4 * half; *(u32x2*)op = w0; *(u32x2*)(op + 32) = w1; }
    }
}

__global__ void __launch_bounds__(512, 2) mega(P p) {
    extern __shared__ __attribute__((aligned(16))) unsigned char lds_raw[];
    LAS unsigned char* lds = (LAS unsigned char*)lds_raw;
    LAS float* xl = (LAS float*)(lds + XLDS_OFF);
    cg::grid_group grid = cg::this_grid();
    const int wv = __builtin_amdgcn_readfirstlane((int)threadIdx.x >> 6);
    unsigned char* ws = p.ws;
    float* RS = MK_LO ? (float*)(ws + OFF_RS) : p.out; const float* MSQ = RS + (size_t)13 * T * RSN;
    bf16_t* Wb = (bf16_t*)(ws + OFF_W); bf16_t* HB = (bf16_t*)(ws + OFF_HB); bf16_t* MB = (bf16_t*)(ws + OFF_MEMB);
    bf16_t* KVm = (bf16_t*)(ws + OFF_KV); bf16_t* MT = (bf16_t*)(ws + OFF_MT); bf16_t* NT = (bf16_t*)(ws + OFF_NT);
    unsigned char* scr = ws + OFF_SCR;
    bf16_t* LO = (bf16_t*)p.out;
    unsigned* CNT = (unsigned*)ws + 8192;
    int ph = 0;
#define PH_BEGIN if (ph >= p.lo && ph < p.hi) {
#ifndef DUP
#define DUP 0
#endif
#if HYBRID
#define GRID_SYNC() grid.sync()
#else
    if (otid(wv) == 0) { ((volatile LAS unsigned*)(lds + XLDS_OFF + 12288))[0] = 0u; ((volatile LAS unsigned*)(lds + XLDS_OFF + 12288))[1] = 0u; }
    __syncthreads();
    (void)xcd_barrier_post((unsigned*)p.ws + 1024, (volatile LAS unsigned*)(lds + XLDS_OFF + 12288));
    if (p.lo < 0) grid.sync();
#define GRID_SYNC() do { XcdBarrier xb_; xb_.bar = (unsigned*)p.ws + 1024; xb_.x = xb_xcc_id(); xb_.st = (volatile LAS unsigned*)(lds + XLDS_OFF + 12288); xcd_barrier(xb_); } while (0)
#endif
#define PH_END_NOSYNC } ++ph;
#define PH_END } ++ph; if (ph > p.lo && ph < p.hi) { GRID_SYNC(); if (DUP == 3) GRID_SYNC(); }

    PH_BEGIN prologue(p, lds, wv); if (DUP == 2) { __syncthreads(); prologue(p, lds, wv); } PH_END
    PH_BEGIN
        Sched S; S.done_cnt = nullptr; S.wait_cnt = nullptr; S.wait_target = 0; S.done_kind = 0; S.wait_kind = 0; S.kind = 2; S.nM = 128; S.nN = 1; S.nwg = 128; S.G = gridDim.x; S.c = blockIdx.x; S.bdiv = 1; S.A = (const char*)MB; S.B = (const char*)(Wb + W_L0 + WL_KV);
        S.a_pm = S.a_pn = S.a_pb = S.b_pm = S.b_pn = 0; S.b_pb = (long)W_LSTRIDE * 2;
        EpiKV E{KVm, MSQ}; gemm_phase(lds, GemmDesc{D, D, D}, S, E, wv); if (DUP == 10) gemm_phase(lds, GemmDesc{D, D, D}, S, E, wv);
    PH_END
    PH_BEGIN
        { Sched S; S.done_cnt = nullptr; S.wait_cnt = nullptr; S.wait_target = 0; S.done_kind = 0; S.wait_kind = 0; S.kind = 3; S.nM = 256; S.nN = 1; S.nwg = 256; S.G = gridDim.x; S.c = blockIdx.x; S.bdiv = 1; S.A = (const char*)KVm; S.B = (const char*)(ws + OFF_WQP);
          S.a_pm = S.a_pn = S.b_pm = S.b_pn = 0; S.a_pb = 1024L * 2048 * 2; S.b_pb = 1024L * 1024 * 2;
          EpiMN<0> E{MT}; gemm_phase(lds, GemmDesc{2048, D, 256}, S, E, wv); }
        { Sched S; S.done_cnt = nullptr; S.wait_cnt = nullptr; S.wait_target = 0; S.done_kind = 0; S.wait_kind = 0; S.kind = 4; S.nM = 256; S.nN = 1; S.nwg = 256; S.G = gridDim.x; S.c = blockIdx.x; S.bdiv = 1; S.A = (const char*)(Wb + W_L0 + WL_O); S.B = (const char*)KVm;
          S.a_pm = S.a_pn = S.b_pm = S.b_pn = 0; S.a_pb = (long)W_LSTRIDE * 2; S.b_pb = 1024L * 2048 * 2;
          EpiMN<1> E{NT}; gemm_phase(lds, GemmDesc{D, 2048, 256}, S, E, wv); }
    PH_END
    for (int i = 0; i < 4; ++i) {
        const int kind = i % 3, j = i / 3; bf16_t* WL = Wb + W_L0 + (size_t)i * W_LSTRIDE;
        float* rs_mix = RS + (size_t)(3 * i) * T * RSN; float* rs_xa = RS + (size_t)(3 * i + 1) * T * RSN; float* rs_ffn = RS + (size_t)(3 * i + 2) * T * RSN; float* rs_next = RS + (size_t)(3 * i + 3) * T * RSN;
        if (kind == 0) {
            bf16_t* PH = (bf16_t*)scr;
            const float* hin = (i == 0) ? p.in[0] : nullptr;
            PH_BEGIN pool_prep(hin, HB, LO, rs_mix, PH, wv); PH_END
            PH_BEGIN
                Sched S = make_sched(64, 4, PH, 256L * D * 2, 256 * 2, Wb + W_PW + (size_t)j * 4 * 65536, 0, 65536L * 2);
                EpiRes<0> E{hin, HB, LO, rs_xa, xl}; gemm_phase(lds, GemmDesc{D, 256, 256}, S, E, wv);
            PH_END
        } else if (kind == 1) {
            bf16_t* QK = (bf16_t*)scr; bf16_t* VT = (bf16_t*)(scr + 64 * MiB);
            PH_BEGIN
                { Sched S = make_sched(64, 8, HB, 256L * D * 2, 0, Wb + W_QKV, 0, 256L * D * 2); EpiBf E{QK, 2048, 256L * 2048, 256, rs_mix, nullptr}; gemm_phase(lds, GemmDesc{D, D, D}, S, E, wv); }
                { Sched S = make_sched(4, 64, Wb + W_QKV + (size_t)2048 * D, 256L * D * 2, 0, HB, 0, 256L * D * 2); EpiBf E{VT, T, 256L * T, 256, nullptr, rs_mix}; gemm_phase(lds, GemmDesc{D, D, D}, S, E, wv); }
            PH_END
            PH_BEGIN sb_attn(QK, VT, QK, 2048, wv); PH_END
            PH_BEGIN
                Sched S = make_sched(64, 4, QK, 256L * 2048 * 2, 0, Wb + W_SO, 0, 256L * D * 2);
                EpiRes<0> E{nullptr, HB, LO, rs_xa, xl}; gemm_phase(lds, GemmDesc{2048, D, D}, S, E, wv);
            PH_END
        } else {
            bf16_t* Z = (bf16_t*)scr; float* Sst = (float*)(scr + 48 * MiB); bf16_t* Y = (bf16_t*)(scr + 48 * MiB);
            bf16_t* WB5 = (bf16_t*)(ws + OFF_S5WB); bf16_t* TW5 = (bf16_t*)(ws + OFF_S5TW);
            PH_BEGIN s5_zfill(HB, LO, rs_mix, p.in[2] + i * D, Z, wv); if (DUP == 9) s5_zfill(HB, LO, rs_mix, p.in[2] + i * D, Z, wv); PH_END
            PH_BEGIN
                Sched S = make_sched(256, 1, Z, 256L * 384 * 2, 0, WB5, 0, 0, 4, 0, 256L * 256 * 2);
                EpiS5S E{Sst}; gemm_phase(lds, GemmDesc{384, 256, 256}, S, E, wv); if (DUP == 9) gemm_phase(lds, GemmDesc{384, 256, 256}, S, E, wv);
            PH_END
            PH_BEGIN s5_scan(p, Sst, Z, j, wv); if (DUP == 7) s5_scan(p, Sst, Z, j, wv); PH_END
            PH_BEGIN
                Sched S = make_sched(256, 1, Z, 256L * 384 * 2, 0, TW5, 0, 0, 4, 0, 256L * 384 * 2);
                EpiS5Y E{Y, Z, p.in[14] + j * D}; gemm_phase(lds, GemmDesc{384, 384, 384}, S, E, wv); if (DUP == 9) gemm_phase(lds, GemmDesc{384, 384, 384}, S, E, wv);
            PH_END
            PH_BEGIN
                Sched S = make_sched(64, 8, Y, 256L * D * 2, 0, Wb + W_GLU, 0, 256L * D * 2);
                EpiRes<1> E{nullptr, HB, LO, rs_xa, xl}; gemm_phase(lds, GemmDesc{D, D, D}, S, E, wv);
            PH_END
        }
        {
            bf16_t* Pm = (bf16_t*)scr;
            PH_BEGIN
                Sched S = make_sched(64, 4, HB, 256L * D * 2, 0, MT + (size_t)i * 4 * 1024 * 1024, 0, 256L * D * 2, 16, 0, 1024L * 1024 * 2);
                if (!HYBRID) S.done_cnt = CNT + (i * 8 + 0) * 128;
                EpiSoftmax E{Pm, xl, rs_xa}; gemm_phase(lds, GemmDesc{D, D, D}, S, E, wv);
            PH_END_NOSYNC
            PH_BEGIN
                Sched S = make_sched(64, 4, Pm, 256L * D * 2, 0, NT + (size_t)i * 4 * 1024 * 1024, 0, 256L * D * 2, 16, 0, 1024L * 1024 * 2);
                if (!HYBRID) { S.wait_cnt = CNT + (i * 8 + 0) * 128; S.wait_target = 4; }
                EpiRes<0> E{nullptr, HB, LO, rs_ffn, xl}; gemm_phase(lds, GemmDesc{D, D, D}, S, E, wv);
            PH_END
        }
        {
            bf16_t* Gb = (bf16_t*)scr;
            PH_BEGIN
                Sched S; S.done_cnt = nullptr; S.wait_cnt = nullptr; S.wait_target = 0; S.done_kind = 0; S.wait_kind = 0; S.kind = 1; S.nM = 68; S.nN = 22; S.nwg = 68 * 22; S.G = gridDim.x; S.c = blockIdx.x; S.bdiv = 1; S.A = (const char*)HB; S.B = (const char*)(WL + WL_UP);
                S.a_pm = D * 2; S.a_pn = S.a_pb = S.b_pm = S.b_pb = 0; S.b_pn = 256L * D * 2;
                EpiConvGlu E{Gb, rs_ffn, p.in[23] + (size_t)i * 3 * 2 * FF, p.in[24] + (size_t)i * 2 * FF, xl}; gemm_phase(lds, GemmDesc{D, D, D}, S, E, wv); if (DUP == 1) gemm_phase(lds, GemmDesc{D, D, D}, S, E, wv);
            PH_END
            PH_BEGIN
                Sched S = make_sched(64, 4, Gb, 256L * FF * 2, 0, WL + WL_DN, 0, 256L * FF * 2);
                EpiRes<0> E{nullptr, HB, LO, rs_next, xl}; gemm_phase(lds, GemmDesc{FF, FF, FF}, S, E, wv);
            PH_END
        }
    }
    PH_BEGIN
        const int tid = otid(wv), lane = tid & 63, wave = tid >> 6; const int gw = blockIdx.x * 8 + wave, NGW = gridDim.x * 8;
        f32x4 fv[8][4]; float fr_[8];
#pragma unroll
        for (int k = 0; k < 8; ++k) { const int m = gw + k * NGW; float s = 0.f;
#pragma unroll
            for (int j = 0; j < 2; ++j) { if (m < T) load_hilo8(HB, LO, (size_t)m * D + 8 * lane + 512 * j, fv[k][2 * j], fv[k][2 * j + 1]); else { fv[k][2 * j] = (f32x4){0.f, 0.f, 0.f, 0.f}; fv[k][2 * j + 1] = fv[k][2 * j]; } }
#pragma unroll
            for (int j = 0; j < 4; ++j) s += (fv[k][j][0] * fv[k][j][0] + fv[k][j][1] * fv[k][j][1]) + (fv[k][j][2] * fv[k][j][2] + fv[k][j][3] * fv[k][j][3]);
            fr_[k] = rsqrtf(wave_sum(s, lane) * (1.f / D) + EPS); }
        if (MK_LO) GRID_SYNC();
#pragma unroll
        for (int k = 0; k < 8; ++k) { const int m = gw + k * NGW;
            if (m < T) {
#pragma unroll
                for (int j = 0; j < 4; ++j) { const int col = 8 * lane + 512 * (j >> 1) + 4 * (j & 1); const f32x4 gg = *(const f32x4*)(p.in[26] + col); *(f32x4*)(p.out + (size_t)m * D + col) = fv[k][j] * fr_[k] * gg; } } }
        for (int m = gw + 8 * NGW; m < T; m += NGW) { }
    PH_END
#undef PH_BEGIN
#undef PH_END
}
__global__ void __launch_bounds__(512) k_sync_state(const float* h, bf16_t* HB, float* rsq) { sync_state(h, HB, rsq, threadIdx.x >> 6); }
}
#ifndef OPT_MASK
#define OPT_MASK 63
#endif
#ifndef HYBRID
#define HYBRID 0
#endif
static void mega_launch(hipStream_t stream, mk::P p, int lo, int hi, int grid) {
    p.lo = lo; p.hi = hi; void* args[] = {&p};
    hipError_t e = hipLaunchCooperativeKernel((const void*)mk::mega, dim3(grid), dim3(512), args, mk::LDS_BYTES, stream);
    if (e != hipSuccess) fprintf(stderr, "cooperative launch failed: %s (grid %d)\n", hipGetErrorString(e), grid);
}
extern "C" void kernel_launch(void* const* d_in, const int* in_sizes, int n_in, void* d_out, int out_size, void* d_ws, size_t ws_size, hipStream_t stream) {
    static int grid = 0;
    if (grid == 0) {
        if (n_in != 27 || ws_size < mk::WS_NEED) { fprintf(stderr, "kernel_launch: unexpected n_in %d / ws %zu\n", n_in, ws_size); grid = -1; return; }
        int dev = 0, cus = 0, per_cu = 0;
        hipGetDevice(&dev); hipDeviceGetAttribute(&cus, hipDeviceAttributeMultiprocessorCount, dev);
        hipFuncSetAttribute((const void*)mk::mega, hipFuncAttributeMaxDynamicSharedMemorySize, mk::LDS_BYTES);
        hipOccupancyMaxActiveBlocksPerMultiprocessor(&per_cu, (const void*)mk::mega, 512, mk::LDS_BYTES);
        if (per_cu < 1) per_cu = 1;
        (void)hipGetLastError();
        grid = cus * per_cu;
    }
    if (grid < 0) return;
    mk::P p{}; for (int i = 0; i < 27; ++i) p.in[i] = (const float*)d_in[i];
    p.out = (float*)d_out; p.ws = (unsigned char*)d_ws;
#if !HYBRID
    hipMemsetAsync(d_ws, 0, 65536, stream);
    mega_launch(stream, p, 0, 1000, grid);
#else
    nv::In in{}; for (int i = 0; i < 27; ++i) in.p[i] = (const float*)d_in[i];
    float* h = (float*)d_out; float* scr = (float*)((unsigned char*)d_ws + mk::OFF_SCR);
    mega_launch(stream, p, 0, 2, grid);
    int ph = 2;
    for (int i = 0; i < 4; ++i) {
        const int kind = i % 3; const int nmix = kind == 0 ? 2 : kind == 1 ? 3 : 5;
        for (int sub = 0; sub < 3; ++sub) {
            const int np = sub == 0 ? nmix : sub == 1 ? 4 : 2; const int bit = sub == 0 ? kind : sub == 1 ? 3 : 4;
            if ((OPT_MASK >> bit) & 1) {
                mk::k_sync_state<<<256, 512, 0, stream>>>(h, (mk::bf16_t*)((unsigned char*)d_ws + mk::OFF_HB), (float*)((unsigned char*)d_ws + mk::OFF_RS) + (size_t)(3 * i + sub) * mk::T);
                mega_launch(stream, p, ph, ph + np, grid);
            } else nv::sublayer(stream, in, h, scr, i, sub);
            ph += np;
        }
    }
    if ((OPT_MASK >> 5) & 1) mega_launch(stream, p, 38, 39, grid); else nv::final_norm(stream, in, h);
#endif
}
```

```cpp
#include <hip/hip_runtime.h>
#include <hip/hip_cooperative_groups.h>
#include <cstdio>
#include <cstdint>
namespace cg = cooperative_groups;
#define HYBRID 0
#define OPT_MASK 63
#define DUP 0
#define SEAMS 1
#define MK_SP2 1
#define MK_BAUX 0
#define MK_AAUX 0
#define MK_LO 0
namespace mk {
#define LAS __attribute__((address_space(3)))
typedef unsigned short bf16_t;
typedef short bf16x8 __attribute__((ext_vector_type(8)));
typedef float f32x4 __attribute__((ext_vector_type(4)));
typedef float f32x16 __attribute__((ext_vector_type(16)));
typedef float f32x2 __attribute__((ext_vector_type(2)));
typedef unsigned u32x4 __attribute__((ext_vector_type(4)));
typedef unsigned u32x2 __attribute__((ext_vector_type(2)));
typedef __bf16 bf16x2_t __attribute__((ext_vector_type(2)));
constexpr int T = 16384, D = 1024, SEQ = 4096, FF = 2816, NB = 4;
constexpr float EPS = 1e-6f, LOG2E = 1.4426950408889634f;
constexpr int BM = 256, BK = 64, HALF = 128, HTB = HALF * BK * 2, STAGE_BYTES = 8 * HTB, NXCD = 8, WGM = 8;
constexpr int XLDS_OFF = STAGE_BYTES;
constexpr int LDS_BYTES = 147456;

__device__ __forceinline__ unsigned cvtpk(float lo, float hi) { f32x2 v = {lo, hi}; bf16x2_t b = __builtin_convertvector(v, bf16x2_t); return __builtin_bit_cast(unsigned, b); }
__device__ __forceinline__ float bf2f(bf16_t b) { return __builtin_bit_cast(float, (unsigned)b << 16); }
__device__ __forceinline__ float fast_exp2(float x) { return __builtin_amdgcn_exp2f(x); }
__device__ __forceinline__ float fast_log2(float x) { return __builtin_amdgcn_logf(x); }
__device__ __forceinline__ float fast_rcp(float x) { return __builtin_amdgcn_rcpf(x); }
__device__ __forceinline__ float sigmoidf_(float x) { return fast_rcp(1.f + fast_exp2(-x * LOG2E)); }
__device__ __forceinline__ int lane_id_v() { int l; asm volatile("v_mbcnt_lo_u32_b32 %0, -1, 0\n\tv_mbcnt_hi_u32_b32 %0, -1, %0" : "=v"(l)); return l; }
__device__ __forceinline__ float shx(float v, int mask, int lane) { return __builtin_bit_cast(float, __builtin_amdgcn_ds_bpermute((lane ^ mask) << 2, __builtin_bit_cast(int, v))); }
__device__ __forceinline__ float wave_sum(float v, int lane) {
#pragma unroll
    for (int o = 1; o < 64; o <<= 1) v += shx(v, o, lane);
    return v;
}
template <int CTRL> __device__ __forceinline__ float dppf(float v) { return __builtin_bit_cast(float, __builtin_amdgcn_update_dpp(0, __builtin_bit_cast(int, v), CTRL, 0xf, 0xf, false)); }

__host__ __device__ __forceinline__ int lds_byte(int r, int c) { const int st = (r >> 4) * 2 + (c >> 5), rr = r & 15, cc = c & 31, ob = rr * 64 + cc * 2; return st * 1024 + (ob ^ (((ob >> 9) & 1) << 5)); }
__host__ __device__ __forceinline__ void stage_rc(int b, int& R, int& C) { const int st = b / 1024, sb = b % 1024, swz = sb ^ (((sb >> 9) & 1) << 5); R = (st >> 1) * 16 + swz / 64; C = (st & 1) * 32 + (swz % 64) / 2; }
__host__ __device__ __forceinline__ int perm_sw(int rho) { const int n = rho >> 4, i = rho & 15, q = i >> 2, j = i & 3; return 16 * n + 8 * (q & 1) + 4 * (q >> 1) + j; }
__host__ __device__ __forceinline__ int perm32(int rho) { const int n = rho >> 4, i = rho & 15; return 8 * (i >> 2) + 4 * n + (i & 3); }

struct Unit { int pm, pn; };
struct GemmDesc { int lda, ldb, K; };

struct Sched {
    int kind, nM, nN, nwg, G, c, bdiv;
    const char* A; const char* B;
    long a_pm, a_pn, a_pb, b_pm, b_pn, b_pb;
    unsigned* done_cnt; unsigned* wait_cnt; int wait_target, done_kind, wait_kind;
    __device__ __forceinline__ void wait_one(unsigned* w) const {
        unsigned sp = 0; while (__builtin_amdgcn_readfirstlane(__hip_atomic_load(w, __ATOMIC_RELAXED, __HIP_MEMORY_SCOPE_AGENT)) < (unsigned)wait_target) { __builtin_amdgcn_s_sleep(2); if (++sp > (1u << 20)) break; }
    }
    __device__ __forceinline__ void a_ready(const Unit& u, int wid) const {
        if (!wait_cnt) return;
        if (wid == 0) {
            if (wait_kind == 0) wait_one(wait_cnt + u.pm);
            __builtin_amdgcn_fence(__ATOMIC_ACQUIRE, "agent"); asm volatile("s_waitcnt vmcnt(0)" ::: "memory");
        }
        __builtin_amdgcn_s_barrier(); asm volatile("" ::: "memory");
    }
    __device__ __forceinline__ void done(const Unit& u, int wid, int lane) const {
        if (!done_cnt) return;
        asm volatile("s_waitcnt vmcnt(0)" ::: "memory"); __builtin_amdgcn_s_barrier(); asm volatile("" ::: "memory");
        if (wid == 0 && lane == 0) { __builtin_amdgcn_fence(__ATOMIC_RELEASE, "agent"); asm volatile("s_waitcnt vmcnt(0)" ::: "memory");
            __hip_atomic_fetch_add(done_cnt + u.pm, 1u, __ATOMIC_RELAXED, __HIP_MEMORY_SCOPE_AGENT); }
    }
    __device__ __forceinline__ bool next(int i, Unit& u) const {
        const long L = (long)i * G + c; if (L >= nwg) return false;
        int wgid = (int)L;
        if (kind >= 2) { u.pm = wgid; u.pn = 0; return true; }
        { const int q = nwg / NXCD, r = nwg % NXCD, xcd = wgid % NXCD, off = wgid / NXCD; wgid = (xcd < r ? xcd * (q + 1) : r * (q + 1) + (xcd - r) * q) + off; }
        const int nig = WGM * nN, gid = wgid / nig, fm = gid * WGM, gsz = (nM - fm) < WGM ? (nM - fm) : WGM;
        u.pm = fm + ((wgid % nig) % gsz); u.pn = (wgid % nig) / gsz; return true;
    }
    __device__ __forceinline__ void base(const Unit& u, const char*& a, const char*& b) const {
        if (kind == 0) { const int pb = u.pm / bdiv; a = A + u.pm * a_pm + u.pn * a_pn + pb * a_pb; b = B + u.pm * b_pm + u.pn * b_pn + pb * b_pb; }
        else if (kind == 1) { const int bt = u.pm / 17, j = u.pm % 17; int o0 = 254 * j; if (o0 > 3842) o0 = 3842; const long start = (long)bt * SEQ + o0 - 2; a = A + start * a_pm; b = B + u.pn * b_pn; }
        else if (kind == 2) { const int L = u.pm, layer = L >> 5, r = L & 31, tm = r >> 3, tn = r & 7;
            a = A + (long)tm * 256 * 2048; b = B + (long)layer * b_pb + (long)tn * 256 * 2048; }
        else if (kind == 3) { const int L = u.pm, layer = L >> 6, r = L & 63, bt = r >> 4, hh = (r >> 2) & 3, kt = r & 3;
            a = A + (long)layer * a_pb + (long)bt * 256 * 4096 + hh * 512; b = B + (long)layer * b_pb + (long)kt * 256 * 2048 + hh * 512; }
        else { const int L = u.pm, layer = L >> 6, r = L & 63, bt = r >> 4, hh = (r >> 2) & 3, nt = r & 3;
            a = A + (long)layer * a_pb + (long)nt * 256 * 2048 + hh * 512; b = B + (long)layer * b_pb + (long)bt * 256 * 4096 + (1024 + hh * 256) * 2; }
    }
};
__device__ __forceinline__ Sched make_sched(int nM, int nN, const void* A, long a_pm, long a_pn, const void* B, long b_pm, long b_pn, int bdiv = 1 << 30, long a_pb = 0, long b_pb = 0) {
    Sched s; s.done_cnt = nullptr; s.wait_cnt = nullptr; s.wait_target = 0; s.done_kind = 0; s.wait_kind = 0; s.kind = 0; s.nM = nM; s.nN = nN; s.nwg = nM * nN; s.G = gridDim.x; s.c = blockIdx.x; s.bdiv = bdiv; s.A = (const char*)A; s.B = (const char*)B;
    s.a_pm = a_pm; s.a_pn = a_pn; s.a_pb = a_pb; s.b_pm = b_pm; s.b_pn = b_pn; s.b_pb = b_pb; return s;
}

template <class Epi>
__device__ __forceinline__ void gemm_phase(LAS unsigned char* lds, const GemmDesc g, const Sched& S, const Epi& E, int wv) {
    int tid_ = wv * 64 + lane_id_v();
    const int tid = tid_, wid = __builtin_amdgcn_readfirstlane(tid >> 6), lane = tid & 63, wr = wid >> 2, wc = wid & 3, fr = lane & 15, fq = lane >> 4;
    const int K = g.K, nt = K / BK;
    unsigned voffA[2], voffB[2];
#pragma unroll
    for (int i = 0; i < 2; ++i) { int R, C; stage_rc(tid * 16 + i * 8192, R, C); const int Rb = (int)Epi::PERM == 2 ? ((R & ~31) + perm_sw(R & 31)) : (int)Epi::PERM == 1 ? ((R & ~31) + perm32(R & 31)) : R;
        voffA[i] = (unsigned)(R * g.lda + C) * 2u; voffB[i] = (unsigned)(Rb * g.ldb + C) * 2u; }
    const size_t kstep = (size_t)(BK * 2);
    const size_t hstepA = (size_t)HALF * g.lda * 2, hstepB = (size_t)HALF * g.ldb * 2;
    const unsigned ldsw = (unsigned)wid * 1024u;
    const int aoff = lds_byte(wr * 64 + fr, fq * 8), boff = lds_byte(wc * 32 + fr, fq * 8);
#define PG8_SA(b, h) (((b) * 2 + (h)) * HTB)
#define PG8_SB(b, h) ((4 + (b) * 2 + (h)) * HTB)
#define PG8_STAGE(bufoff, gbase, voff) do { _Pragma("unroll") for (int _i = 0; _i < 2; ++_i) \
        __builtin_amdgcn_global_load_lds((const unsigned*)((const char*)(gbase) + (voff)[_i]), (LAS unsigned*)(lds + (bufoff) + ldsw + _i * 8192), 16, 0, 0); } while (0)
#define PG8_LDA(dst, b, h) do { _Pragma("unroll") for (int m = 0; m < 4; ++m) _Pragma("unroll") for (int k = 0; k < 2; ++k) dst[m][k] = *(const LAS bf16x8*)(lds + PG8_SA(b, h) + aoff + m * 2048 + k * 1024); } while (0)
#define PG8_LDB(dst, b, h) do { _Pragma("unroll") for (int n = 0; n < 2; ++n) _Pragma("unroll") for (int k = 0; k < 2; ++k) dst[n][k] = *(const LAS bf16x8*)(lds + PG8_SB(b, h) + boff + n * 2048 + k * 1024); } while (0)
#define PG8_MMA(ai, bj, At, Bt) do { __builtin_amdgcn_s_setprio(1); _Pragma("unroll") for (int m = 0; m < 4; ++m) _Pragma("unroll") for (int n = 0; n < 2; ++n) _Pragma("unroll") for (int k = 0; k < 2; ++k) \
        acc[ai][bj][m][n] = __builtin_amdgcn_mfma_f32_16x16x32_bf16(Bt[n][k], At[m][k], acc[ai][bj][m][n], 0, 0, 0); __builtin_amdgcn_s_setprio(0); } while (0)
#define PG8_WAIT_V(n) asm volatile("s_waitcnt vmcnt(" #n ")" ::: "memory")
#define PG8_WAIT_L(n) asm volatile("s_waitcnt lgkmcnt(" #n ")" ::: "memory")
#define PG8_BAR __builtin_amdgcn_s_barrier()
#define PG8_SCHED __builtin_amdgcn_sched_barrier(0)
    Unit cur, nxt; int ui = 0;
    if (!S.next(0, cur)) return;
    f32x4 acc[2][2][4][2];
#pragma unroll
    for (int a = 0; a < 2; ++a)
#pragma unroll
        for (int b = 0; b < 2; ++b)
#pragma unroll
            for (int m = 0; m < 4; ++m)
#pragma unroll
                for (int n = 0; n < 2; ++n) acc[a][b][m][n] = (f32x4){0.f, 0.f, 0.f, 0.f};
    bf16x8 At[4][2], B0[2][2], B1[2][2];
    const char* cA; const char* cB; S.base(cur, cA, cB);
    S.a_ready(cur, wid);
    PG8_STAGE(PG8_SB(0, 0), cB, voffB); PG8_STAGE(PG8_SB(0, 1), cB + hstepB, voffB); PG8_STAGE(PG8_SA(0, 0), cA, voffA); PG8_STAGE(PG8_SA(0, 1), cA + hstepA, voffA);
    if (wr == 1) PG8_BAR;
    PG8_WAIT_V(2); PG8_BAR;
    PG8_STAGE(PG8_SB(1, 0), cB + kstep, voffB); PG8_STAGE(PG8_SA(1, 0), cA + kstep, voffA); PG8_STAGE(PG8_SB(1, 1), cB + hstepB + kstep, voffB);
    PG8_WAIT_V(6); PG8_BAR;
    for (;;) {
        const bool has_next = S.next(ui + 1, nxt);
        const char* nA = cA; const char* nB = cB; if (has_next) S.base(nxt, nA, nB);
        for (int t = 0; t < nt; t += 2) {
            const bool last = (t == nt - 2);
            if (last && has_next) S.a_ready(nxt, wid);
            const char* a1 = cA + (size_t)(t + 1) * kstep;
            const char* a2 = last ? nA : cA + (size_t)(t + 2) * kstep; const char* b2 = last ? nB : cB + (size_t)(t + 2) * kstep;
            const char* a3 = a2 + kstep; const char* b3 = b2 + kstep;
            PG8_LDB(B0, 0, 0); PG8_LDB(B1, 0, 1); PG8_SCHED; PG8_LDA(At, 0, 0); PG8_STAGE(PG8_SA(1, 1), a1 + hstepA, voffA);
            PG8_WAIT_V(8); PG8_WAIT_L(0); PG8_BAR; PG8_MMA(0, 0, At, B0); PG8_MMA(0, 1, At, B1); PG8_BAR; PG8_SCHED;
            PG8_LDA(At, 0, 1); PG8_STAGE(PG8_SB(0, 0), b2, voffB); PG8_STAGE(PG8_SB(0, 1), b2 + hstepB, voffB); PG8_STAGE(PG8_SA(0, 0), a2, voffA);
            PG8_WAIT_V(8); PG8_WAIT_L(0); PG8_BAR; PG8_MMA(1, 0, At, B0); PG8_MMA(1, 1, At, B1); PG8_BAR; PG8_SCHED;
            PG8_LDB(B0, 1, 0); PG8_LDB(B1, 1, 1); PG8_SCHED; PG8_LDA(At, 1, 0); PG8_STAGE(PG8_SA(0, 1), a2 + hstepA, voffA);
            PG8_WAIT_V(8); PG8_WAIT_L(0); PG8_BAR; PG8_MMA(0, 0, At, B0); PG8_MMA(0, 1, At, B1); PG8_BAR; PG8_SCHED;
            PG8_LDA(At, 1, 1); PG8_STAGE(PG8_SB(1, 0), b3, voffB); PG8_STAGE(PG8_SB(1, 1), b3 + hstepB, voffB); PG8_STAGE(PG8_SA(1, 0), a3, voffA);
            PG8_WAIT_V(8); PG8_WAIT_L(0); PG8_BAR; PG8_MMA(1, 0, At, B0); PG8_MMA(1, 1, At, B1); PG8_BAR; PG8_SCHED;
        }
        if (wr == 0) PG8_BAR;
        { int fr_e = fr, fq_e = fq; asm volatile("" : "+v"(fr_e), "+v"(fq_e)); E(acc, cur, wr, wc, fr_e, fq_e); }
        S.done(cur, wid, lane);
        if (!has_next) break;
#pragma unroll
        for (int a = 0; a < 2; ++a)
#pragma unroll
            for (int b = 0; b < 2; ++b)
#pragma unroll
                for (int m = 0; m < 4; ++m)
#pragma unroll
                    for (int n = 0; n < 2; ++n) acc[a][b][m][n] = (f32x4){0.f, 0.f, 0.f, 0.f};
        cur = nxt; cA = nA; cB = nB; ++ui;
        if (wr == 1) PG8_BAR;
    }
    PG8_WAIT_V(0);
    PG8_BAR;
#undef PG8_SA
#undef PG8_SB
#undef PG8_STAGE
#undef PG8_LDA
#undef PG8_LDB
#undef PG8_MMA
#undef PG8_WAIT_V
#undef PG8_WAIT_L
#undef PG8_SCHED
}
#define MK_BAR() do { asm volatile("s_waitcnt vmcnt(0) lgkmcnt(0)" ::: "memory"); __builtin_amdgcn_s_barrier(); asm volatile("" ::: "memory"); } while (0)
#define MK_LBAR() do { asm volatile("s_waitcnt lgkmcnt(0)" ::: "memory"); __builtin_amdgcn_s_barrier(); asm volatile("" ::: "memory"); } while (0)

typedef f32x4 AccT[2][2][4][2];
#ifndef MK_LO
#define MK_LO 1
#endif
__device__ __forceinline__ f32x4 unpack_bf4(u32x2 w) { f32x4 r; r[0] = __builtin_bit_cast(float, w.x << 16); r[1] = __builtin_bit_cast(float, w.x & 0xffff0000u); r[2] = __builtin_bit_cast(float, w.y << 16); r[3] = __builtin_bit_cast(float, w.y & 0xffff0000u); return r; }
__device__ __forceinline__ f32x4 load_hilo4(const bf16_t* hi, const bf16_t* lo, size_t off) { return unpack_bf4(*(const u32x2*)(hi + off)) + unpack_bf4(*(const u32x2*)(lo + off)); }
__device__ __forceinline__ void load_hilo8(const bf16_t* hi, const bf16_t* lo, size_t off, f32x4& a, f32x4& b) { const u32x4 h4 = *(const u32x4*)(hi + off); u32x4 l4 = (u32x4){0u, 0u, 0u, 0u}; if (MK_LO) l4 = *(const u32x4*)(lo + off);
    u32x2 ha, hb_, la, lb; ha.x = h4.x; ha.y = h4.y; hb_.x = h4.z; hb_.y = h4.w; la.x = l4.x; la.y = l4.y; lb.x = l4.z; lb.y = l4.w; a = unpack_bf4(ha) + unpack_bf4(la); b = unpack_bf4(hb_) + unpack_bf4(lb); }
__device__ __forceinline__ void store_hilo4(bf16_t* hi, bf16_t* lo, size_t off, f32x4 v) { u32x2 w; w.x = cvtpk(v[0], v[1]); w.y = cvtpk(v[2], v[3]); const f32x4 d = v - unpack_bf4(w); u32x2 l; l.x = cvtpk(d[0], d[1]); l.y = cvtpk(d[2], d[3]);
    *(u32x2*)(hi + off) = w; *(u32x2*)(lo + off) = l; }
constexpr int RSN = MK_LO ? 1 : 8;
__device__ __forceinline__ float rs_of(const float* rsq, int row) {
    if (RSN == 1) return rsqrtf(rsq[row] * (1.f / D) + EPS);
    const f32x4 x = *(const f32x4*)(rsq + (size_t)row * 8), y = *(const f32x4*)(rsq + (size_t)row * 8 + 4);
    return rsqrtf((((x[0] + x[1]) + (x[2] + x[3])) + ((y[0] + y[1]) + (y[2] + y[3]))) * (1.f / D) + EPS); }

struct EpiBf {
    static constexpr bool PERM = true;
    bf16_t* O; int ldc; long o_pm, o_pn; const float* rsq; const float* csq;
    __device__ __forceinline__ void operator()(const AccT& acc, const Unit& u, int wr, int wc, int fr, int fq) const {
        bf16_t* base = O + u.pm * o_pm + u.pn * o_pn;
        float cs[2][8];
#pragma unroll
        for (int bj = 0; bj < 2; ++bj)
#pragma unroll
            for (int e = 0; e < 8; ++e) cs[bj][e] = csq ? rs_of(csq, u.pn * 256 + bj * HALF + wc * 32 + 8 * fq + e) : 1.f;
#pragma unroll
        for (int ai = 0; ai < 2; ++ai)
#pragma unroll
            for (int m = 0; m < 4; ++m) { const int row = ai * HALF + wr * 64 + m * 16 + fr; const float r = rsq ? rs_of(rsq, u.pm * 256 + row) : 1.f;
#pragma unroll
                for (int bj = 0; bj < 2; ++bj) { const f32x4 v0 = acc[ai][bj][m][0], v1 = acc[ai][bj][m][1]; u32x4 w;
                    w.x = cvtpk(v0[0] * r * cs[bj][0], v0[1] * r * cs[bj][1]); w.y = cvtpk(v0[2] * r * cs[bj][2], v0[3] * r * cs[bj][3]);
                    w.z = cvtpk(v1[0] * r * cs[bj][4], v1[1] * r * cs[bj][5]); w.w = cvtpk(v1[2] * r * cs[bj][6], v1[3] * r * cs[bj][7]);
                    *(u32x4*)(base + (size_t)row * ldc + bj * HALF + wc * 32 + 8 * fq) = w; } }
    }
};
struct EpiKV {
    static constexpr bool PERM = true;
    bf16_t* KV; const float* msq;
    __device__ __forceinline__ void operator()(const AccT& acc, const Unit& u, int wr, int wc, int fr, int fq) const {
        const int L = u.pm, layer = L >> 5, r = L & 31, tm = r >> 3, tn = r & 7;
        EpiBf e; e.ldc = 2048; e.o_pm = 256 * 2048; e.o_pn = 256; e.O = KV + (size_t)layer * 1024 * 2048; e.rsq = msq; e.csq = nullptr; Unit v; v.pm = tm; v.pn = tn;
        e(acc, v, wr, wc, fr, fq);
    }
};
template <int ISN> struct EpiMN {
    static constexpr bool PERM = true;
    bf16_t* O;
    __device__ __forceinline__ void operator()(const AccT& acc, const Unit& u, int wr, int wc, int fr, int fq) const {
        const int L = u.pm, layer = L >> 6, r = L & 63, bt = r >> 4, hh = (r >> 2) & 3, t4 = r & 3;
        EpiBf e; e.ldc = 1024; e.o_pm = 256 * 1024; e.o_pn = 256; e.O = O + ((size_t)layer * 4 + bt) * 1024 * 1024; e.rsq = nullptr; e.csq = nullptr; Unit v;
        if (!ISN) { v.pm = hh; v.pn = t4; } else { v.pm = t4; v.pn = hh; }
        e(acc, v, wr, wc, fr, fq);
    }
};
template <int GLU> struct EpiRes {
    static constexpr bool PERM = true;
    const float* base32; bf16_t* hi; bf16_t* lo; float* rsq; LAS float* xl;
    __device__ __forceinline__ void operator()(const AccT& acc, const Unit& u, int wr, int wc, int fr, int fq) const {
        constexpr int NBJ = GLU ? 1 : 2;
#pragma unroll
        for (int q = 0; q < 4; ++q) { const int ai = q >> 1, m0 = (q & 1) * 2;
            f32x4 bv[2][NBJ][2];
#pragma unroll
            for (int mm = 0; mm < 2; ++mm) { const int row = u.pm * 256 + ai * HALF + wr * 64 + (m0 + mm) * 16 + fr;
#pragma unroll
                for (int bj = 0; bj < NBJ; ++bj) { const int col = GLU ? (u.pn * 128 + wc * 32 + 8 * fq) : (u.pn * 256 + bj * HALF + wc * 32 + 8 * fq); const size_t off = (size_t)row * D + col;
                    if (base32) { bv[mm][bj][0] = *(const f32x4*)(base32 + off); bv[mm][bj][1] = *(const f32x4*)(base32 + off + 4); }
                    else { const u32x4 h4 = *(const u32x4*)(hi + off); u32x4 l4 = (u32x4){0u, 0u, 0u, 0u}; if (MK_LO) l4 = *(const u32x4*)(lo + off); u32x2 ha, hb_, la, lb; ha.x = h4.x; ha.y = h4.y; hb_.x = h4.z; hb_.y = h4.w; la.x = l4.x; la.y = l4.y; lb.x = l4.z; lb.y = l4.w;
                        bv[mm][bj][0] = unpack_bf4(ha) + unpack_bf4(la); bv[mm][bj][1] = unpack_bf4(hb_) + unpack_bf4(lb); } } }
#pragma unroll
            for (int mm = 0; mm < 2; ++mm) { const int m = m0 + mm; const int row = u.pm * 256 + ai * HALF + wr * 64 + m * 16 + fr; float ss = 0.f;
#pragma unroll
                for (int bj = 0; bj < NBJ; ++bj) { const int col = GLU ? (u.pn * 128 + wc * 32 + 8 * fq) : (u.pn * 256 + bj * HALF + wc * 32 + 8 * fq); const size_t off = (size_t)row * D + col;
                    f32x4 v[2];
#pragma unroll
                    for (int n = 0; n < 2; ++n) { f32x4 t = acc[ai][bj][m][n];
                        if (GLU) { const f32x4 gt = acc[ai][1][m][n]; t[0] *= sigmoidf_(gt[0]); t[1] *= sigmoidf_(gt[1]); t[2] *= sigmoidf_(gt[2]); t[3] *= sigmoidf_(gt[3]); }
                        t = t + bv[mm][bj][n]; v[n] = t; ss += (t[0] * t[0] + t[1] * t[1]) + (t[2] * t[2] + t[3] * t[3]); }
                    u32x4 h4; h4.x = cvtpk(v[0][0], v[0][1]); h4.y = cvtpk(v[0][2], v[0][3]); h4.z = cvtpk(v[1][0], v[1][1]); h4.w = cvtpk(v[1][2], v[1][3]);
                    u32x2 ha, hb_; ha.x = h4.x; ha.y = h4.y; hb_.x = h4.z; hb_.y = h4.w; const f32x4 d0 = v[0] - unpack_bf4(ha), d1 = v[1] - unpack_bf4(hb_);
                    u32x4 l4; l4.x = cvtpk(d0[0], d0[1]); l4.y = cvtpk(d0[2], d0[3]); l4.z = cvtpk(d1[0], d1[1]); l4.w = cvtpk(d1[2], d1[3]);
                    *(u32x4*)(hi + off) = h4; if (MK_LO) *(u32x4*)(lo + off) = l4; }
                ss += shx(ss, 16, fq * 16 + fr); ss += shx(ss, 32, fq * 16 + fr);
                if (fq == 0) xl[wc * 256 + ai * HALF + wr * 64 + m * 16 + fr] = ss; }
        }
        MK_LBAR();
        { const int t = (wr * 4 + wc) * 64 + fq * 16 + fr; if (t < 256) { const float s = (xl[t] + xl[256 + t]) + (xl[512 + t] + xl[768 + t]); if (RSN == 1) __hip_atomic_fetch_add(rsq + u.pm * 256 + t, s, __ATOMIC_RELAXED, __HIP_MEMORY_SCOPE_AGENT);
                else { float* rp = rsq + (size_t)(u.pm * 256 + t) * 8; rp[u.pn] = s; if (!GLU) rp[4 + u.pn] = 0.f; } } }
    }
};
struct EpiSoftmax {
    static constexpr bool PERM = true;
    bf16_t* P; LAS float* xl; const float* rsq;
    __device__ __forceinline__ void operator()(AccT& acc, const Unit& u, int wr, int wc, int fr, int fq) const {
        LAS float* mx = xl; LAS float* sm = xl + 1024;
#pragma unroll
        for (int ai = 0; ai < 2; ++ai)
#pragma unroll
            for (int m = 0; m < 4; ++m) { float mm = -3.0e38f; const float rr = rs_of(rsq, u.pm * 256 + ai * HALF + wr * 64 + m * 16 + fr);
#pragma unroll
                for (int bj = 0; bj < 2; ++bj)
#pragma unroll
                    for (int n = 0; n < 2; ++n) { const f32x4 v = acc[ai][bj][m][n] * rr; acc[ai][bj][m][n] = v; mm = fmaxf(mm, fmaxf(fmaxf(v[0], v[1]), fmaxf(v[2], v[3]))); }
                mm = fmaxf(mm, shx(mm, 16, fq * 16 + fr)); mm = fmaxf(mm, shx(mm, 32, fq * 16 + fr));
                if (fq == 0) mx[wc * 256 + ai * HALF + wr * 64 + m * 16 + fr] = mm; }
        MK_LBAR();
#pragma unroll
        for (int ai = 0; ai < 2; ++ai)
#pragma unroll
            for (int m = 0; m < 4; ++m) { const int row = ai * HALF + wr * 64 + m * 16 + fr;
                const float mm = fmaxf(fmaxf(mx[row], mx[256 + row]), fmaxf(mx[512 + row], mx[768 + row])); float s = 0.f;
#pragma unroll
                for (int bj = 0; bj < 2; ++bj)
#pragma unroll
                    for (int n = 0; n < 2; ++n)
#pragma unroll
                        for (int j = 0; j < 4; ++j) { const float e = fast_exp2(acc[ai][bj][m][n][j] - mm); acc[ai][bj][m][n][j] = e; s += e; }
                s += shx(s, 16, fq * 16 + fr); s += shx(s, 32, fq * 16 + fr);
                if (fq == 0) sm[wc * 256 + row] = s; }
        MK_LBAR();
#pragma unroll
        for (int ai = 0; ai < 2; ++ai)
#pragma unroll
            for (int m = 0; m < 4; ++m) { int zo = 0; asm volatile("" : "+v"(zo)); const int row = ai * HALF + wr * 64 + m * 16 + fr + zo;
                const float inv = fast_rcp((sm[row] + sm[256 + row]) + (sm[512 + row] + sm[768 + row]));
#pragma unroll
                for (int bj = 0; bj < 2; ++bj) { const f32x4 v0 = acc[ai][bj][m][0], v1 = acc[ai][bj][m][1]; u32x4 w;
                    w.x = cvtpk(v0[0] * inv, v0[1] * inv); w.y = cvtpk(v0[2] * inv, v0[3] * inv);
                    w.z = cvtpk(v1[0] * inv, v1[1] * inv); w.w = cvtpk(v1[2] * inv, v1[3] * inv);
                    *(u32x4*)(P + (size_t)(u.pm * 256 + row) * D + u.pn * 256 + bj * HALF + wc * 32 + 8 * fq) = w; } }
    }
};
struct EpiConvGlu {
    static constexpr int PERM = 2;
    bf16_t* Gb; const float* rsq; const float* cw; const float* cb; LAS float* xl;
    __device__ __forceinline__ void operator()(AccT& acc, const Unit& u, int wr, int wc, int fr, int fq) const {
        const int bt = u.pm / 17, jt = u.pm % 17; int o0 = 254 * jt; if (o0 > 3842) o0 = 3842;
        const int tib0 = o0 - 2; const long tok0 = (long)bt * SEQ + tib0;
#pragma unroll
        for (int ai = 0; ai < 2; ++ai)
#pragma unroll
            for (int m = 0; m < 4; ++m) { const int R = ai * HALF + wr * 64 + m * 16 + fr; const bool ok = (tib0 + R) >= 0; const float r = ok ? rs_of(rsq, (int)(tok0 + R)) : 0.f;
#pragma unroll
                for (int bj = 0; bj < 2; ++bj)
#pragma unroll
                    for (int n = 0; n < 2; ++n) acc[ai][bj][m][n] = acc[ai][bj][m][n] * r; }
        if (fr >= 14) {
#pragma unroll
            for (int ai = 0; ai < 2; ++ai) { LAS float* hp = xl + ((((ai * 2 + wr) * 4 + wc) * 2 + (fr - 14)) * 4 + fq) * 16;
#pragma unroll
                for (int bj = 0; bj < 2; ++bj)
#pragma unroll
                    for (int n = 0; n < 2; ++n) *(LAS f32x4*)(hp + (bj * 2 + n) * 4) = acc[ai][bj][3][n]; }
        }
        MK_LBAR();
        const int f0 = u.pn * 128 + wc * 32 + 8 * (fq & 1) + 4 * (fq >> 1);
        unsigned dep = 0u;
#pragma unroll
        for (int n = 0; n < 2; ++n) {
            int zo = 0; asm volatile("" : "+v"(zo) : "v"(dep));
            const float* cwp = cw + f0 + 16 * n + zo; const float* cbp = cb + f0 + 16 * n + zo;
            f32x4 w0[2], w1[2], w2[2], bb[2];
#pragma unroll
            for (int bj = 0; bj < 2; ++bj) { w0[bj] = *(const f32x4*)(cwp + bj * FF); w1[bj] = *(const f32x4*)(cwp + 2 * FF + bj * FF); w2[bj] = *(const f32x4*)(cwp + 4 * FF + bj * FF); bb[bj] = *(const f32x4*)(cbp + bj * FF); }
#pragma unroll
            for (int ai = 0; ai < 2; ++ai) { const int grp = ai * 2 + wr;
                f32x4 pv[2]; u32x2 wprev; wprev.x = 0u; wprev.y = 0u;
#pragma unroll
                for (int bj = 0; bj < 2; ++bj) { f32x4 hv = (f32x4){0.f, 0.f, 0.f, 0.f};
                    if (grp > 0 && fr >= 14) hv = *(const LAS f32x4*)(xl + (((((grp - 1) * 4 + wc) * 2 + (fr - 14)) * 4 + fq) * 16) + (bj * 2 + n) * 4);
                    pv[bj] = hv; }
#pragma unroll
                for (int m = 0; m < 4; ++m) { const int R = ai * HALF + wr * 64 + m * 16 + fr;
                    f32x4 res[2];
#pragma unroll
                    for (int bj = 0; bj < 2; ++bj) { const f32x4 cur = acc[ai][bj][m][n]; f32x4 x1, x2;
#pragma unroll
                        for (int j = 0; j < 4; ++j) {
                            const float c1 = fr == 15 ? pv[bj][j] : cur[j], c2 = fr >= 14 ? pv[bj][j] : cur[j];
                            x1[j] = dppf<0x121>(c1); x2[j] = dppf<0x122>(c2); }
                        res[bj] = w2[bj] * cur + w1[bj] * x1 + w0[bj] * x2 + bb[bj]; pv[bj] = cur; }
                    f32x4 e4;
#pragma unroll
                    for (int j = 0; j < 4; ++j) e4[j] = fast_exp2(res[1][j] * -LOG2E);
                    e4 = e4 + 1.f;
#pragma unroll
                    for (int j = 0; j < 4; ++j) e4[j] = fast_rcp(e4[j]);
                    const f32x4 a = res[1] * e4 * res[0];
                    u32x2 w; w.x = cvtpk(a[0], a[1]); w.y = cvtpk(a[2], a[3]); dep = w.y;
                    if (!(m & 1)) wprev = w;
                    else {
                        const auto r0 = __builtin_amdgcn_permlane32_swap(wprev.x, w.x, false, false); const auto r1 = __builtin_amdgcn_permlane32_swap(wprev.y, w.y, false, false);
                        u32x4 w4; w4.x = r0[0]; w4.y = r1[0]; w4.z = r0[1]; w4.w = r1[1];
                        const int Rs = (fq < 2) ? R - 16 : R;
                        if (Rs >= 2) *(u32x4*)(Gb + (size_t)(tok0 + Rs) * FF + u.pn * 128 + wc * 32 + 16 * n + 8 * (fq & 1)) = w4; } } }
        }
        MK_LBAR();
    }
};
struct EpiS5S {
    static constexpr bool PERM = false;
    float* Sst;
    __device__ __forceinline__ void operator()(const AccT& acc, const Unit& u, int wr, int wc, int fr, int fq) const {
#pragma unroll
        for (int ai = 0; ai < 2; ++ai)
#pragma unroll
            for (int m = 0; m < 4; ++m) { const int row = u.pm * 256 + ai * HALF + wr * 64 + m * 16 + fr;
#pragma unroll
                for (int n = 0; n < 2; ++n) *(f32x4*)(Sst + (size_t)row * 128 + wc * 32 + n * 16 + fq * 4) = acc[ai][0][m][n]; }
    }
};
__device__ __forceinline__ float gelu_tanh(float x) { const float uu = 0.7978845608028654f * (x + 0.044715f * x * x * x); const float e = fast_exp2(2.f * LOG2E * uu); return x * (1.f - fast_rcp(1.f + e)); }
struct EpiS5Y {
    static constexpr bool PERM = false;
    bf16_t* Y; const bf16_t* Z; const float* dvec;
    __device__ __forceinline__ void operator()(const AccT& acc, const Unit& u, int wr, int wc, int fr, int fq) const {
        const int g = u.pm >> 2, mt = u.pm & 3;
#pragma unroll
        for (int ai = 0; ai < 2; ++ai)
#pragma unroll
            for (int m = 0; m < 4; ++m) { const int nrow = mt * 256 + ai * HALF + wr * 64 + m * 16 + fr;
#pragma unroll
                for (int bj = 0; bj < 2; ++bj)
#pragma unroll
                    for (int n = 0; n < 2; ++n) { const int col = bj * HALF + wc * 32 + n * 16 + fq * 4; const int t = col >> 4, i0 = col & 15;
                        const u32x2 uz = *(const u32x2*)(Z + ((size_t)g * 1024 + nrow) * 384 + col);
                        const float u0 = __builtin_bit_cast(float, uz.x << 16), u1 = __builtin_bit_cast(float, uz.x & 0xffff0000u), u2 = __builtin_bit_cast(float, uz.y << 16), u3 = __builtin_bit_cast(float, uz.y & 0xffff0000u);
                        const f32x4 dv = *(const f32x4*)(dvec + g * 16 + i0); const f32x4 a = acc[ai][bj][m][n];
                        u32x2 w; w.x = cvtpk(gelu_tanh(a[0] + dv[0] * u0), gelu_tanh(a[1] + dv[1] * u1)); w.y = cvtpk(gelu_tanh(a[2] + dv[2] * u2), gelu_tanh(a[3] + dv[3] * u3));
                        *(u32x2*)(Y + (size_t)(nrow * 16 + t) * D + g * 16 + i0) = w; } }
    }
};
}
namespace mk {
#define RLX_AGENT __ATOMIC_RELAXED, __HIP_MEMORY_SCOPE_AGENT
#define XB_TMO      128
#define XB_XCNT(j)  (256  + 64 * (j))
#define XB_XSUB(j)  (1280 + 64 * (j))
#define XB_XGEN(j)  (2304 + 64 * (j))
#define XB_TOP      3328
#define XB_TOPGEN   3392
#define XCD_BAR_WORDS 3456
#define XB_SPIN_CAP (1u << 18)

__device__ __forceinline__ unsigned xb_ld(unsigned* p)              { return __hip_atomic_load(p, __ATOMIC_RELAXED, __HIP_MEMORY_SCOPE_AGENT); }
__device__ __forceinline__ unsigned xb_add(unsigned* p, unsigned v) { return __hip_atomic_fetch_add(p, v, __ATOMIC_RELAXED, __HIP_MEMORY_SCOPE_AGENT); }
__device__ __forceinline__ unsigned xb_xcc_id() { return (unsigned)__builtin_amdgcn_s_getreg((3 << 11) | 20) & 0xFu; }
#define XB_SPIN(cond, bar) do { unsigned _sp = 0; while (cond) { __builtin_amdgcn_s_sleep(1); \
    if ((++_sp & 255u) == 0u) { if (xb_ld(&(bar)[XB_TMO])) break; if (_sp > XB_SPIN_CAP) { atomicAdd(&(bar)[XB_TMO], 1u); break; } } } } while (0)

struct XcdBarrier {
    unsigned* bar; unsigned x;
    volatile LAS unsigned* st;
};

__device__ __forceinline__ XcdBarrier xcd_barrier_post(unsigned* bar, volatile LAS unsigned* st) {
    XcdBarrier b; b.bar = bar; b.x = xb_xcc_id(); b.st = st;
    if (threadIdx.x == 0) (void)xb_add(&bar[XB_XCNT(b.x)], 1u);
    return b;
}
__device__ __forceinline__ void xcd_barrier_complete(unsigned* bar, unsigned x, unsigned& nloc, unsigned& nx) {
    const unsigned G = gridDim.x * gridDim.y * gridDim.z;
    unsigned sum, cnt, mine, sp = 0u;
    for (;;) {
        sum = 0u; cnt = 0u; mine = 0u;
#pragma unroll
        for (unsigned j = 0; j < 16; ++j) { const unsigned c = xb_ld(&bar[XB_XCNT(j)]); sum += c; cnt += (c > 0u) ? 1u : 0u; mine = (j == x) ? c : mine; }
        if (sum == G) break;
        __builtin_amdgcn_s_sleep(1);
        if ((++sp & 255u) == 0u) { if (xb_ld(&bar[XB_TMO])) break; if (sp > XB_SPIN_CAP) { atomicAdd(&bar[XB_TMO], 1u); break; } }
    }
    nloc = mine > 0u ? mine : 1u; nx = cnt > 0u ? cnt : 1u;
}

__device__ __forceinline__ void xcd_barrier(const XcdBarrier& b) {
    asm volatile("s_waitcnt vmcnt(0)" ::: "memory");
    __syncthreads();
    if (threadIdx.x == 0) {
        unsigned* bar = b.bar;
        __builtin_amdgcn_s_waitcnt(0);
        unsigned nloc = b.st[0], nx = b.st[1];
        if (nloc == 0u) { xcd_barrier_complete(bar, b.x, nloc, nx); b.st[0] = nloc; b.st[1] = nx; }
        const unsigned old = xb_add(&bar[XB_XSUB(b.x)], 1u);
        const unsigned gen = old / nloc;
        if (old + 1u == (gen + 1u) * nloc) {
            __builtin_amdgcn_fence(__ATOMIC_RELEASE, "agent");
            asm volatile("s_waitcnt vmcnt(0)" ::: "memory");
            const unsigned og = xb_add(&bar[XB_TOP], 1u);
            const unsigned tg = og / nx;
            __builtin_amdgcn_fence(__ATOMIC_ACQUIRE, "agent");
            if (og + 1u == (tg + 1u) * nx) xb_add(&bar[XB_TOPGEN], 1u);
            else XB_SPIN(xb_ld(&bar[XB_TOPGEN]) == tg, bar);
            xb_add(&bar[XB_XGEN(b.x)], 1u);
            asm volatile("s_waitcnt vmcnt(0)" ::: "memory");
        } else {
            __builtin_amdgcn_fence(__ATOMIC_ACQUIRE, "agent");
            XB_SPIN(xb_ld(&bar[XB_XGEN(b.x)]) == gen, bar);
            asm volatile("s_waitcnt vmcnt(0)" ::: "memory");
        }
    }
    __syncthreads();
}
}
namespace mk {
constexpr size_t MiB = 1u << 20;
constexpr size_t OFF_RS = 1 * MiB;
constexpr size_t OFF_W = 2 * MiB;
constexpr size_t OFF_WQP = 113 * MiB;
constexpr size_t OFF_HB = 122 * MiB;
constexpr size_t OFF_MEMB = 154 * MiB;
constexpr size_t OFF_KV = 156 * MiB;
constexpr size_t OFF_S5WB = 172 * MiB;
constexpr size_t OFF_S5TW = 180 * MiB;
constexpr size_t OFF_MT = 192 * MiB;
constexpr size_t OFF_NT = 224 * MiB;
constexpr size_t OFF_SCR = 256 * MiB;
constexpr size_t WS_NEED = 352 * MiB;
constexpr size_t W_PW = 0, W_QKV = 524288, W_SO = 3670016, W_GLU = 4718592, W_L0 = 6815744, W_LSTRIDE = 12845056;
constexpr size_t WL_Q = 0, WL_KV = 1048576, WL_O = 3145728, WL_UP = 4194304, WL_DN = 9961472;

struct P { const float* in[27]; float* out; unsigned char* ws; int lo, hi; };
__device__ __forceinline__ int otid(int wv) { return wv * 64 + lane_id_v(); }

__device__ __forceinline__ void transpose_item(const float* W, int ldw, int k0, int n0, bf16_t* WT, int ldk, int drow0, const float* sk, const float* sn, float cst, LAS float* scr, int lane) {
    float v[32];
#pragma unroll
    for (int i = 0; i < 32; ++i) { const int kk = 2 * i + (lane >> 5); v[i] = W[(size_t)(k0 + kk) * ldw + n0 + (lane & 31)]; }
#pragma unroll
    for (int i = 0; i < 32; ++i) { const int kk = 2 * i + (lane >> 5); scr[kk * 33 + (lane & 31)] = v[i]; }
    asm volatile("s_waitcnt lgkmcnt(0)" ::: "memory");
    const int c = lane & 7;
    f32x4 ka = (f32x4){1.f, 1.f, 1.f, 1.f}, kb = ka; if (sk) { ka = *(const f32x4*)(sk + k0 + 8 * c); kb = *(const f32x4*)(sk + k0 + 8 * c + 4); }
#pragma unroll
    for (int j = 0; j < 4; ++j) { const int n = (lane >> 3) + 8 * j; const LAS float* s = scr + (8 * c) * 33 + n; const float sc = cst * (sn ? sn[n0 + n] : 1.f);
        u32x4 o; o.x = cvtpk(s[0 * 33] * sc * ka[0], s[1 * 33] * sc * ka[1]); o.y = cvtpk(s[2 * 33] * sc * ka[2], s[3 * 33] * sc * ka[3]); o.z = cvtpk(s[4 * 33] * sc * kb[0], s[5 * 33] * sc * kb[1]); o.w = cvtpk(s[6 * 33] * sc * kb[2], s[7 * 33] * sc * kb[3]);
        *(u32x4*)(WT + (size_t)(drow0 + n) * ldk + k0 + 8 * c) = o; }
    asm volatile("s_waitcnt lgkmcnt(0)" ::: "memory");
}
struct WJob { const float* W; int K, N; bf16_t* dst; const float* sk; const float* sn; int half; float cst; int qcols; };
__device__ __forceinline__ WJob wjob(const P& p, int id) {
    bf16_t* Wb = (bf16_t*)(p.ws + OFF_W); WJob j; j.sk = nullptr; j.sn = nullptr; j.half = 0; j.cst = 1.f; j.qcols = 1 << 30;
    if (id < 8) { const int jj = id >> 2, g = id & 3; j.W = p.in[3] + (size_t)id * 65536; j.K = 256; j.N = 256; j.dst = Wb + W_PW + (size_t)id * 65536; j.sk = p.in[2] + (jj * 3) * D + g * 256; j.sn = p.in[4] + jj * D + g * 256; }
    else if (id == 8) { j.W = p.in[5]; j.K = D; j.N = 3 * D; j.dst = Wb + W_QKV; j.sk = p.in[2] + 1 * D; j.cst = 0.125f * LOG2E; j.qcols = D; }
    else if (id == 9) { j.W = p.in[6]; j.K = D; j.N = D; j.dst = Wb + W_SO; }
    else if (id == 10) { j.W = p.in[15]; j.K = D; j.N = 2 * D; j.dst = Wb + W_GLU; j.half = D; }
    else { const int i = (id - 11) / 5, w = (id - 11) % 5; bf16_t* L = Wb + W_L0 + (size_t)i * W_LSTRIDE;
        if (w == 0) { j.W = p.in[18] + (size_t)i * D * D; j.K = D; j.N = D; j.dst = L + WL_Q; j.sk = p.in[16] + i * D; j.cst = 0.0625f * LOG2E; }
        else if (w == 1) { j.W = p.in[19] + (size_t)i * D * 2 * D; j.K = D; j.N = 2 * D; j.dst = L + WL_KV; j.sk = p.in[17] + i * D; }
        else if (w == 2) { j.W = p.in[20] + (size_t)i * D * D; j.K = D; j.N = D; j.dst = L + WL_O; }
        else if (w == 3) { j.W = p.in[22] + (size_t)i * D * 2 * FF; j.K = D; j.N = 2 * FF; j.dst = L + WL_UP; j.sk = p.in[21] + i * D; j.half = FF; }
        else { j.W = p.in[25] + (size_t)i * FF * D; j.K = FF; j.N = D; j.dst = L + WL_DN; } }
    return j;
}
constexpr int N_WJOBS = 31;
__device__ __forceinline__ int wjob_items(int id) {
    if (id < 8) return 4 * 8; if (id == 8) return 16 * 96; if (id == 9) return 16 * 32; if (id == 10) return 16 * 64;
    const int w = (id - 11) % 5; return w == 0 ? 0   : w == 1 ? 16 * 64 : w == 2 ? 16 * 32 : w == 3 ? 16 * 176 : 44 * 32;
}
__device__ __forceinline__ void row_to_bf16(const float* xrow, bf16_t* orow, float* sq, float* copy, int lane) {
    const f32x4* xr = (const f32x4*)xrow + lane; f32x4 v[4]; float s = 0.f;
#pragma unroll
    for (int j = 0; j < 4; ++j) { v[j] = xr[64 * j]; s += (v[j][0] * v[j][0] + v[j][1] * v[j][1]) + (v[j][2] * v[j][2] + v[j][3] * v[j][3]); }
    s = wave_sum(s, lane); if (lane < RSN) sq[lane] = lane == 0 ? s : 0.f;
#pragma unroll
    for (int j = 0; j < 4; ++j) { if (orow) { u32x2 w; w.x = cvtpk(v[j][0], v[j][1]); w.y = cvtpk(v[j][2], v[j][3]); *((u32x2*)orow + lane + 64 * j) = w; } if (copy) *((f32x4*)copy + lane + 64 * j) = v[j]; }
}
__device__ __forceinline__ void s5_items(const P& p, LAS float* sl, int wv) {
    const int tid = otid(wv); bf16_t* WB = (bf16_t*)(p.ws + OFF_S5WB); bf16_t* TW = (bf16_t*)(p.ws + OFF_S5TW);
    const float* a_re = p.in[7]; const float* a_im = p.in[8]; const float* ldt = p.in[9]; const float* b_re = p.in[10]; const float* b_im = p.in[11]; const float* c_re = p.in[12]; const float* c_im = p.in[13];
    LAS float* sCr = sl; LAS float* sCi = sl + 1024; LAS float* sBr = sl + 2048; LAS float* sBi = sl + 3072;
    LAS float* pwr = sl + 4096; LAS float* pwi = pwr + 17 * 64; LAS float* wfr = pwi + 17 * 64; LAS float* wfi = wfr + 17 * 64;
    for (int task = blockIdx.x; task < 256; task += gridDim.x) {
        const int g = task >> 2, part = task & 3;
        __syncthreads();
        for (int q = tid; q < 1024; q += 512) { sCr[q] = c_re[g * 1024 + q]; sCi[q] = c_im[g * 1024 + q]; sBr[q] = b_re[g * 1024 + q]; sBi[q] = b_im[g * 1024 + q]; }
        if (tid < 64) { const int pp = tid; const float lr = a_re[g * 64 + pp], li = a_im[g * 64 + pp], dt = expf(ldt[g]); const float xr = lr * dt, xi = li * dt;
            float s1, c1; sincosf(xi, &s1, &c1); const float ex = expf(xr); const float ar = ex * c1, ai = ex * s1;
            const float sh = sinf(0.5f * xi); const float nr = expm1f(xr) * c1 - 2.f * sh * sh, ni = ex * s1; const float den = lr * lr + li * li;
            const float fr_ = (nr * lr + ni * li) / den, fi_ = (ni * lr - nr * li) / den;
            float cr = 1.f, ci = 0.f;
            for (int e = 0; e <= 16; ++e) { pwr[e * 64 + pp] = cr; pwi[e * 64 + pp] = ci; wfr[e * 64 + pp] = cr * fr_ - ci * fi_; wfi[e * 64 + pp] = cr * fi_ + ci * fr_;
                const float tr = cr * ar - ci * ai, ti = cr * ai + ci * ar; cr = tr; ci = ti; } }
        __syncthreads();
        const int r0 = part * 16, r1 = (part == 3) ? 63 : r0 + 16;
        for (int r = r0; r < r1; ++r) {
            if (r < 31) {
                const int l = r - 15;
                if (tid < 256) { const int i = tid >> 4, j = tid & 15; float val = 0.f;
                    if (l >= 0) { for (int pp = 0; pp < 64; ++pp) { const float cr = sCr[i * 64 + pp], ci = sCi[i * 64 + pp], br = sBr[pp * 16 + j], bi = sBi[pp * 16 + j];
                            const float wr_ = wfr[l * 64 + pp], wi_ = wfi[l * 64 + pp]; val += (cr * wr_ - ci * wi_) * br - (cr * wi_ + ci * wr_) * bi; } }
                    const bf16_t bv = (bf16_t)(cvtpk(val, 0.f) & 0xffffu);
                    for (int t = 0; t < 16; ++t) { const int s = t - l; if (s >= 0 && s < 16) TW[((size_t)g * 256 + t * 16 + i) * 384 + s * 16 + j] = bv; } }
            } else if (r < 47) {
                const int s = r - 31, e = 15 - s;
                for (int q4 = tid; q4 < 2048; q4 += 512) { const int q = q4 >> 4, j = q4 & 15, pp = q >> 1, im = q & 1; const float br = sBr[pp * 16 + j], bi = sBi[pp * 16 + j]; const float wr_ = wfr[e * 64 + pp], wi_ = wfi[e * 64 + pp];
                    const float val = im ? (wr_ * bi + wi_ * br) : (wr_ * br - wi_ * bi);
                    WB[((size_t)g * 256 + q) * 256 + s * 16 + j] = (bf16_t)(cvtpk(val, 0.f) & 0xffffu); WB[((size_t)g * 256 + 128 + q) * 256 + s * 16 + j] = 0; }
            } else {
                const int t = r - 47, e = t + 1;
                for (int q4 = tid; q4 < 2048; q4 += 512) { const int i = q4 >> 7, q = q4 & 127, pp = q >> 1, im = q & 1; const float cr = sCr[i * 64 + pp], ci = sCi[i * 64 + pp]; const float wr_ = pwr[e * 64 + pp], wi_ = pwi[e * 64 + pp];
                    const float val = im ? -(cr * wi_ + ci * wr_) : (cr * wr_ - ci * wi_);
                    TW[((size_t)g * 256 + t * 16 + i) * 384 + 256 + q] = (bf16_t)(cvtpk(val, 0.f) & 0xffffu); }
            }
        }
    }
    __syncthreads();
}
__device__ __forceinline__ void prologue(const P& p, LAS unsigned char* lds, int wv) {
    const int tid = otid(wv), lane = tid & 63, wave = tid >> 6; const int gw = blockIdx.x * 8 + wave, NGW = gridDim.x * 8;
    float* RS = MK_LO ? (float*)(p.ws + OFF_RS) : p.out;
    if (blockIdx.x & 1) { s5_items(p, (LAS float*)lds, wv); __syncthreads(); }
    if (RSN == 1) for (size_t i = (size_t)blockIdx.x * 512 + tid; i < (size_t)12 * T / 4; i += (size_t)gridDim.x * 512) ((f32x4*)(RS + T))[i] = (f32x4){0.f, 0.f, 0.f, 0.f};
    bf16_t* HB = (bf16_t*)(p.ws + OFF_HB);
    for (int m = gw; m < T; m += NGW) row_to_bf16(p.in[0] + (size_t)m * D, nullptr, RS + (size_t)m * RSN, nullptr, lane);
    bf16_t* MB = (bf16_t*)(p.ws + OFF_MEMB);
    for (int m = gw; m < 1024; m += NGW) row_to_bf16(p.in[1] + (size_t)m * D, MB + (size_t)m * D, RS + ((size_t)13 * T + m) * RSN, nullptr, lane);
    LAS float* scr = (LAS float*)(lds + wave * 16384);
    int total = 0;
    for (int id = 0; id < N_WJOBS; ++id) total += wjob_items(id);
    for (int it = gw; it < total; it += NGW) {
        int r = it, id = 0; for (;; ++id) { const int c = wjob_items(id); if (r < c) break; r -= c; }
        const WJob j = wjob(p, id); const int nblk = j.N / 32, kb = r / nblk, nb = r % nblk, k0 = 64 * kb, n0 = 32 * nb;
        int drow0 = n0; if (j.half) { const int hf = n0 / j.half, f = n0 % j.half; drow0 = (f / 128) * 256 + hf * 128 + (f % 128); }
        transpose_item(j.W, j.N, k0, n0, j.dst, j.K, drow0, j.sk, j.sn, n0 < j.qcols ? j.cst : 1.f, scr, lane);
    }
    { bf16_t* WQP = (bf16_t*)(p.ws + OFF_WQP);
      for (size_t idx = (size_t)blockIdx.x * 512 + tid; idx < (size_t)4 * D * D / 8; idx += (size_t)gridDim.x * 512) { const size_t e0 = idx * 8; const int i = (int)(e0 >> 20), k = (int)(e0 >> 10) & 1023;
          const float sc = p.in[16][i * D + k] * (0.0625f * LOG2E); const f32x4 x0 = *(const f32x4*)(p.in[18] + e0), x1 = *(const f32x4*)(p.in[18] + e0 + 4);
          u32x4 w; w.x = cvtpk(x0[0] * sc, x0[1] * sc); w.y = cvtpk(x0[2] * sc, x0[3] * sc); w.z = cvtpk(x1[0] * sc, x1[1] * sc); w.w = cvtpk(x1[2] * sc, x1[3] * sc); *(u32x4*)(WQP + e0) = w; } }
    __syncthreads();
    if (!(blockIdx.x & 1)) s5_items(p, (LAS float*)lds, wv);
}
__device__ __forceinline__ void ld8(const float* h32, const bf16_t* hi, const bf16_t* lo, size_t off, f32x4& a, f32x4& b) {
    if (h32) { a = *(const f32x4*)(h32 + off); b = *(const f32x4*)(h32 + off + 4); } else load_hilo8(hi, lo, off, a, b); }
__device__ __forceinline__ void pool_prep(const float* h32, const bf16_t* hi, const bf16_t* lo, const float* rsq, bf16_t* ph, int wv) {
    for (size_t idx = (size_t)blockIdx.x * 512 + otid(wv); idx < (size_t)(T / 16) * 128; idx += (size_t)gridDim.x * 512) {
        const int tok0 = (int)(idx >> 7) * 16, c = ((int)idx & 127) * 8; const int win = 2 << (c >> 8); const int tib0 = tok0 & (SEQ - 1);
        f32x4 sa = (f32x4){0.f, 0.f, 0.f, 0.f}, sb = sa;
        for (int k = win - 1; k >= 1; --k) if (tib0 - k >= 0) { const float r = rs_of(rsq, tok0 - k); f32x4 xa, xb; ld8(h32, hi, lo, (size_t)(tok0 - k) * D + c, xa, xb); sa = sa + xa * r; sb = sb + xb * r; }
#pragma unroll
        for (int t = 0; t < 16; ++t) { const int row = tok0 + t; const float r = rs_of(rsq, row); f32x4 xa, xb; ld8(h32, hi, lo, (size_t)row * D + c, xa, xb); xa = xa * r; xb = xb * r; sa = sa + xa; sb = sb + xb;
            const int cnt = min(tib0 + t + 1, win); const float ic = 1.f / (float)cnt; const f32x4 oa = sa * ic - xa, ob = sb * ic - xb;
            u32x4 w; w.x = cvtpk(oa[0], oa[1]); w.y = cvtpk(oa[2], oa[3]); w.z = cvtpk(ob[0], ob[1]); w.w = cvtpk(ob[2], ob[3]);
            *(u32x4*)(ph + (size_t)row * D + c) = w;
            const int ro = tib0 + t - (win - 1);
            if (ro >= 0) { const float r2 = rs_of(rsq, row - (win - 1)); f32x4 ya, yb; ld8(h32, hi, lo, (size_t)(row - (win - 1)) * D + c, ya, yb); sa = sa - ya * r2; sb = sb - yb * r2; } }
    }
}
__device__ __forceinline__ void s5_zfill(const bf16_t* hi, const bf16_t* lo, const float* rsq, const float* gain, bf16_t* Z, int wv) {
    for (size_t idx = (size_t)blockIdx.x * 512 + otid(wv); idx < (size_t)T * 128; idx += (size_t)gridDim.x * 512) {
        const int tok = (int)(idx >> 7), c = ((int)idx & 127) * 8; const float r = rs_of(rsq, tok);
        f32x4 a, b; load_hilo8(hi, lo, (size_t)tok * D + c, a, b); const f32x4 ga = *(const f32x4*)(gain + c), gb = *(const f32x4*)(gain + c + 4);
        u32x4 w; w.x = cvtpk(a[0] * r * ga[0], a[1] * r * ga[1]); w.y = cvtpk(a[2] * r * ga[2], a[3] * r * ga[3]); w.z = cvtpk(b[0] * r * gb[0], b[1] * r * gb[1]); w.w = cvtpk(b[2] * r * gb[2], b[3] * r * gb[3]);
        const int g = c >> 4, n = tok >> 4, t = tok & 15;
        *(u32x4*)(Z + ((size_t)g * 1024 + n) * 384 + t * 16 + (c & 15)) = w;
    }
}
__device__ __forceinline__ void s5_scan(const P& p, const float* Sst, bf16_t* Z, int j5, int wv) {
    const int tid = otid(wv); const int lane = tid & 63, wave = tid >> 6; const int gw = blockIdx.x * 8 + wave, NGW = gridDim.x * 8;
    for (int task = gw; task < 256; task += NGW) {
        const int b = task >> 6, g = task & 63;
        const float lr = p.in[7][j5 * 4096 + g * 64 + lane], li = p.in[8][j5 * 4096 + g * 64 + lane], dt = expf(p.in[9][j5 * 64 + g]);
        const float mg = expf(16.f * lr * dt); float sn, cs; sincosf(16.f * li * dt, &sn, &cs); const float ar = mg * cs, ai = mg * sn;
        float xr = 0.f, xi = 0.f;
        for (int n0 = 0; n0 < 256; n0 += 16) {
            f32x2 sv[16];
#pragma unroll
            for (int k = 0; k < 16; ++k) sv[k] = *(const f32x2*)(Sst + ((size_t)g * 1024 + b * 256 + n0 + k) * 128 + 2 * lane);
#pragma unroll
            for (int k = 0; k < 16; ++k) { *(unsigned*)(Z + ((size_t)g * 1024 + b * 256 + n0 + k) * 384 + 256 + 2 * lane) = cvtpk(xr, xi);
                const float nr = ar * xr - ai * xi + sv[k][0], ni = ar * xi + ai * xr + sv[k][1]; xr = nr; xi = ni; }
        }
    }
}
__device__ __forceinline__ void sync_state(const float* h, bf16_t* HB, float* rsq, int wv) {
    const int tid = otid(wv); const int lane = tid & 63, wave = tid >> 6; const int gw = blockIdx.x * 8 + wave, NGW = gridDim.x * 8;
    for (int m = gw; m < T; m += NGW) row_to_bf16(h + (size_t)m * D, HB + (size_t)m * D, rsq + m, nullptr, lane);
}

#define MFMA32(a, b, c) __builtin_amdgcn_mfma_f32_32x32x16_bf16((a), (b), (c), 0, 0, 0)
__device__ __forceinline__ void sb_attn(const bf16_t* QK, const bf16_t* VT, bf16_t* O, int opitch, int wv) {
    const int tid = otid(wv); const int lane = tid & 63, wave = tid >> 6; const int n = lane & 31, half = lane >> 5;
    const int gw = blockIdx.x * 8 + wave, NGW = gridDim.x * 8;
    for (int task = gw; task < 8192; task += NGW) {
        const int qt = 127 - (task >> 6), bh = task & 63, b = bh >> 4, h = bh & 15;
        const int tok0 = b * SEQ + qt * 32;
        bf16x8 qf[4];
#pragma unroll
        for (int kk = 0; kk < 4; ++kk) qf[kk] = *(const bf16x8*)(QK + (size_t)(tok0 + n) * 2048 + h * 64 + 16 * kk + 8 * half);
        f32x16 o0, o1;
#pragma unroll
        for (int i = 0; i < 16; ++i) { o0[i] = 0.f; o1[i] = 0.f; }
        float R = 0.f;
        for (int kt = qt; kt >= 0; --kt) {
            const int key0 = b * SEQ + kt * 32;
            bf16x8 kf[4];
#pragma unroll
            for (int kk = 0; kk < 4; ++kk) kf[kk] = *(const bf16x8*)(QK + (size_t)(key0 + n) * 2048 + 1024 + h * 64 + 16 * kk + 8 * half);
            u32x2 vlo[2][2], vhi[2][2];
#pragma unroll
            for (int dd = 0; dd < 2; ++dd)
#pragma unroll
                for (int s = 0; s < 2; ++s) { const bf16_t* vp = VT + (size_t)(h * 64 + 32 * dd + n) * T + key0 + 16 * s + 4 * half; vlo[dd][s] = *(const u32x2*)vp; vhi[dd][s] = *(const u32x2*)(vp + 8); }
            f32x16 sa;
#pragma unroll
            for (int i = 0; i < 16; ++i) sa[i] = 0.f;
#pragma unroll
            for (int kk = 0; kk < 4; ++kk) sa = MFMA32(kf[kk], qf[kk], sa);
            const bool diag = (kt == qt);
            float Lv[16], go[4], gp[4];
#pragma unroll
            for (int r = 0; r < 16; ++r) { const float w = sa[r]; const int m = (r & 3) + 8 * (r >> 2) + 4 * half; const bool valid = !diag || (m < n);
                const float sp = fmaxf(w, 0.f) + fast_log2(1.f + fast_exp2(-fabsf(w))); Lv[r] = valid ? -sp : 0.f; sa[r] = valid ? w : -1.0e30f; }
#pragma unroll
            for (int j = 0; j < 4; ++j) { go[j] = (Lv[4 * j] + Lv[4 * j + 1]) + (Lv[4 * j + 2] + Lv[4 * j + 3]); gp[j] = shx(go[j], 32, lane); }
            float G[4]; G[3] = 0.f; G[2] = go[3] + gp[3]; G[1] = G[2] + (go[2] + gp[2]); G[0] = G[1] + (go[1] + gp[1]); const float tot = G[0] + (go[0] + gp[0]);
            float av[16];
#pragma unroll
            for (int j = 0; j < 4; ++j) { const float bs = R + G[j] + (half == 0 ? gp[j] : 0.f);
                const float s3 = 0.f, s2 = Lv[4 * j + 3], s1 = s2 + Lv[4 * j + 2], s0 = s1 + Lv[4 * j + 1];
                av[4 * j + 0] = fast_exp2(sa[4 * j + 0] + Lv[4 * j + 0] + bs + s0); av[4 * j + 1] = fast_exp2(sa[4 * j + 1] + Lv[4 * j + 1] + bs + s1);
                av[4 * j + 2] = fast_exp2(sa[4 * j + 2] + Lv[4 * j + 2] + bs + s2); av[4 * j + 3] = fast_exp2(sa[4 * j + 3] + Lv[4 * j + 3] + bs + s3); }
            R += tot;
#pragma unroll
            for (int s = 0; s < 2; ++s) { u32x4 pk; pk.x = cvtpk(av[8 * s + 0], av[8 * s + 1]); pk.y = cvtpk(av[8 * s + 2], av[8 * s + 3]); pk.z = cvtpk(av[8 * s + 4], av[8 * s + 5]); pk.w = cvtpk(av[8 * s + 6], av[8 * s + 7]);
                const bf16x8 pf = __builtin_bit_cast(bf16x8, pk);
                u32x4 v0; v0.x = vlo[0][s].x; v0.y = vlo[0][s].y; v0.z = vhi[0][s].x; v0.w = vhi[0][s].y; u32x4 v1; v1.x = vlo[1][s].x; v1.y = vlo[1][s].y; v1.z = vhi[1][s].x; v1.w = vhi[1][s].y;
                o0 = MFMA32(__builtin_bit_cast(bf16x8, v0), pf, o0); o1 = MFMA32(__builtin_bit_cast(bf16x8, v1), pf, o1); }
            if (__ballot(R >= -150.f) == 0ull) break;
        }
#pragma unroll
        for (int j = 0; j < 4; ++j) { u32x2 w0, w1; w0.x = cvtpk(o0[4 * j], o0[4 * j + 1]); w0.y = cvtpk(o0[4 * j + 2], o0[4 * j + 3]); w1.x = cvtpk(o1[4 * j], o1[4 * j + 1]); w1.y = cvtpk(o1[4 * j + 2], o1[4 * j + 3]);
            bf16_t* op = O + (size_t)(tok0 + n) * opitch + h * 64 + 8 * j + 4 * half; *(u32x2*)op = w0; *(u32x2*)(op + 32) = w1; }
    }
}

__global__ void __launch_bounds__(512, 2) mega(P p) {
    extern __shared__ __attribute__((aligned(16))) unsigned char lds_raw[];
    LAS unsigned char* lds = (LAS unsigned char*)lds_raw;
    LAS float* xl = (LAS float*)(lds + XLDS_OFF);
    cg::grid_group grid = cg::this_grid();
    const int wv = __builtin_amdgcn_readfirstlane((int)threadIdx.x >> 6);
    unsigned char* ws = p.ws;
    float* RS = MK_LO ? (float*)(ws + OFF_RS) : p.out; const float* MSQ = RS + (size_t)13 * T * RSN;
    bf16_t* Wb = (bf16_t*)(ws + OFF_W); bf16_t* HB = (bf16_t*)(ws + OFF_HB); bf16_t* MB = (bf16_t*)(ws + OFF_MEMB);
    bf16_t* KVm = (bf16_t*)(ws + OFF_KV); bf16_t* MT = (bf16_t*)(ws + OFF_MT); bf16_t* NT = (bf16_t*)(ws + OFF_NT);
    unsigned char* scr = ws + OFF_SCR;
    bf16_t* LO = (bf16_t*)p.out;
    unsigned* CNT = (unsigned*)ws + 8192;
    int ph = 0;
#define PH_BEGIN if (ph >= p.lo && ph < p.hi) {
#ifndef DUP
#define DUP 0
#endif
#if HYBRID
#define GRID_SYNC() grid.sync()
#else
    if (otid(wv) == 0) { ((volatile LAS unsigned*)(lds + XLDS_OFF + 12288))[0] = 0u; ((volatile LAS unsigned*)(lds + XLDS_OFF + 12288))[1] = 0u; }
    __syncthreads();
    (void)xcd_barrier_post((unsigned*)p.ws + 1024, (volatile LAS unsigned*)(lds + XLDS_OFF + 12288));
    if (p.lo < 0) grid.sync();
#define GRID_SYNC() do { XcdBarrier xb_; xb_.bar = (unsigned*)p.ws + 1024; xb_.x = xb_xcc_id(); xb_.st = (volatile LAS unsigned*)(lds + XLDS_OFF + 12288); xcd_barrier(xb_); } while (0)
#endif
#define PH_END_NOSYNC } ++ph;
#define PH_END } ++ph; if (ph > p.lo && ph < p.hi) { GRID_SYNC(); if (DUP == 3) GRID_SYNC(); }

    PH_BEGIN prologue(p, lds, wv); if (DUP == 2) { __syncthreads(); prologue(p, lds, wv); } PH_END
    PH_BEGIN
        Sched S; S.done_cnt = nullptr; S.wait_cnt = nullptr; S.wait_target = 0; S.done_kind = 0; S.wait_kind = 0; S.kind = 2; S.nM = 128; S.nN = 1; S.nwg = 128; S.G = gridDim.x; S.c = blockIdx.x; S.bdiv = 1; S.A = (const char*)MB; S.B = (const char*)(Wb + W_L0 + WL_KV);
        S.a_pm = S.a_pn = S.a_pb = S.b_pm = S.b_pn = 0; S.b_pb = (long)W_LSTRIDE * 2;
        EpiKV E{KVm, MSQ}; gemm_phase(lds, GemmDesc{D, D, D}, S, E, wv);
        pool_prep(p.in[0], HB, LO, RS, (bf16_t*)scr, wv);
    PH_END
    PH_BEGIN
        { Sched S; S.done_cnt = nullptr; S.wait_cnt = nullptr; S.wait_target = 0; S.done_kind = 0; S.wait_kind = 0; S.kind = 3; S.nM = 256; S.nN = 1; S.nwg = 256; S.G = gridDim.x; S.c = blockIdx.x; S.bdiv = 1; S.A = (const char*)KVm; S.B = (const char*)(ws + OFF_WQP);
          S.a_pm = S.a_pn = S.b_pm = S.b_pn = 0; S.a_pb = 1024L * 2048 * 2; S.b_pb = 1024L * 1024 * 2;
          EpiMN<0> E{MT}; gemm_phase(lds, GemmDesc{2048, D, 256}, S, E, wv); }
        { Sched S; S.done_cnt = nullptr; S.wait_cnt = nullptr; S.wait_target = 0; S.done_kind = 0; S.wait_kind = 0; S.kind = 4; S.nM = 256; S.nN = 1; S.nwg = 256; S.G = gridDim.x; S.c = blockIdx.x; S.bdiv = 1; S.A = (const char*)(Wb + W_L0 + WL_O); S.B = (const char*)KVm;
          S.a_pm = S.a_pn = S.b_pm = S.b_pn = 0; S.a_pb = (long)W_LSTRIDE * 2; S.b_pb = 1024L * 2048 * 2;
          EpiMN<1> E{NT}; gemm_phase(lds, GemmDesc{D, 2048, 256}, S, E, wv); }
        { Sched S = make_sched(64, 4, (bf16_t*)scr, 256L * D * 2, 256 * 2, Wb + W_PW, 0, 65536L * 2);
          EpiRes<0> E{p.in[0], HB, LO, RS + (size_t)1 * T * RSN, xl}; gemm_phase(lds, GemmDesc{D, 256, 256}, S, E, wv); }
    PH_END
    for (int i = 0; i < 4; ++i) {
        const int kind = i % 3, j = i / 3; bf16_t* WL = Wb + W_L0 + (size_t)i * W_LSTRIDE;
        float* rs_mix = RS + (size_t)(3 * i) * T * RSN; float* rs_xa = RS + (size_t)(3 * i + 1) * T * RSN; float* rs_ffn = RS + (size_t)(3 * i + 2) * T * RSN; float* rs_next = RS + (size_t)(3 * i + 3) * T * RSN;
        if (kind == 0) {
            bf16_t* PH = (bf16_t*)scr;
            const float* hin = (i == 0) ? p.in[0] : nullptr;
            if (i != 0) {
            PH_BEGIN pool_prep(hin, HB, LO, rs_mix, PH, wv); PH_END
            PH_BEGIN
                Sched S = make_sched(64, 4, PH, 256L * D * 2, 256 * 2, Wb + W_PW + (size_t)j * 4 * 65536, 0, 65536L * 2);
                EpiRes<0> E{hin, HB, LO, rs_xa, xl}; gemm_phase(lds, GemmDesc{D, 256, 256}, S, E, wv);
            PH_END
            }
        } else if (kind == 1) {
            bf16_t* QK = (bf16_t*)scr; bf16_t* VT = (bf16_t*)(scr + 64 * MiB);
            PH_BEGIN
                { Sched S = make_sched(64, 8, HB, 256L * D * 2, 0, Wb + W_QKV, 0, 256L * D * 2); EpiBf E{QK, 2048, 256L * 2048, 256, rs_mix, nullptr}; gemm_phase(lds, GemmDesc{D, D, D}, S, E, wv); }
                { Sched S = make_sched(4, 64, Wb + W_QKV + (size_t)2048 * D, 256L * D * 2, 0, HB, 0, 256L * D * 2); EpiBf E{VT, T, 256L * T, 256, nullptr, rs_mix}; gemm_phase(lds, GemmDesc{D, D, D}, S, E, wv); }
            PH_END
            PH_BEGIN sb_attn(QK, VT, QK, 2048, wv); PH_END
            PH_BEGIN
                Sched S = make_sched(64, 4, QK, 256L * 2048 * 2, 0, Wb + W_SO, 0, 256L * D * 2);
                EpiRes<0> E{nullptr, HB, LO, rs_xa, xl}; gemm_phase(lds, GemmDesc{2048, D, D}, S, E, wv);
            PH_END
        } else {
            bf16_t* Z = (bf16_t*)scr; float* Sst = (float*)(scr + 48 * MiB); bf16_t* Y = (bf16_t*)(scr + 48 * MiB);
            bf16_t* WB5 = (bf16_t*)(ws + OFF_S5WB); bf16_t* TW5 = (bf16_t*)(ws + OFF_S5TW);
            PH_BEGIN s5_zfill(HB, LO, rs_mix, p.in[2] + i * D, Z, wv); if (DUP == 9) s5_zfill(HB, LO, rs_mix, p.in[2] + i * D, Z, wv); PH_END
            PH_BEGIN
                Sched S = make_sched(256, 1, Z, 256L * 384 * 2, 0, WB5, 0, 0, 4, 0, 256L * 256 * 2);
                EpiS5S E{Sst}; gemm_phase(lds, GemmDesc{384, 256, 256}, S, E, wv); if (DUP == 9) gemm_phase(lds, GemmDesc{384, 256, 256}, S, E, wv);
            PH_END
            PH_BEGIN s5_scan(p, Sst, Z, j, wv); if (DUP == 7) s5_scan(p, Sst, Z, j, wv); PH_END
            PH_BEGIN
                Sched S = make_sched(256, 1, Z, 256L * 384 * 2, 0, TW5, 0, 0, 4, 0, 256L * 384 * 2);
                EpiS5Y E{Y, Z, p.in[14] + j * D}; gemm_phase(lds, GemmDesc{384, 384, 384}, S, E, wv); if (DUP == 9) gemm_phase(lds, GemmDesc{384, 384, 384}, S, E, wv);
            PH_END
            PH_BEGIN
                Sched S = make_sched(64, 8, Y, 256L * D * 2, 0, Wb + W_GLU, 0, 256L * D * 2);
                EpiRes<1> E{nullptr, HB, LO, rs_xa, xl}; gemm_phase(lds, GemmDesc{D, D, D}, S, E, wv);
            PH_END
        }
        {
            bf16_t* Pm = (bf16_t*)scr;
            PH_BEGIN
                Sched S = make_sched(64, 4, HB, 256L * D * 2, 0, MT + (size_t)i * 4 * 1024 * 1024, 0, 256L * D * 2, 16, 0, 1024L * 1024 * 2);
                if (!HYBRID) S.done_cnt = CNT + (i * 8 + 0) * 128;
                EpiSoftmax E{Pm, xl, rs_xa}; gemm_phase(lds, GemmDesc{D, D, D}, S, E, wv);
            PH_END_NOSYNC
            PH_BEGIN
                Sched S = make_sched(64, 4, Pm, 256L * D * 2, 0, NT + (size_t)i * 4 * 1024 * 1024, 0, 256L * D * 2, 16, 0, 1024L * 1024 * 2);
                if (!HYBRID) { S.wait_cnt = CNT + (i * 8 + 0) * 128; S.wait_target = 4; }
                EpiRes<0> E{nullptr, HB, LO, rs_ffn, xl}; gemm_phase(lds, GemmDesc{D, D, D}, S, E, wv);
            PH_END
        }
        {
            bf16_t* Gb = (bf16_t*)scr;
            PH_BEGIN
                Sched S; S.done_cnt = nullptr; S.wait_cnt = nullptr; S.wait_target = 0; S.done_kind = 0; S.wait_kind = 0; S.kind = 1; S.nM = 68; S.nN = 22; S.nwg = 68 * 22; S.G = gridDim.x; S.c = blockIdx.x; S.bdiv = 1; S.A = (const char*)HB; S.B = (const char*)(WL + WL_UP);
                S.a_pm = D * 2; S.a_pn = S.a_pb = S.b_pm = S.b_pb = 0; S.b_pn = 256L * D * 2;
                EpiConvGlu E{Gb, rs_ffn, p.in[23] + (size_t)i * 3 * 2 * FF, p.in[24] + (size_t)i * 2 * FF, xl}; gemm_phase(lds, GemmDesc{D, D, D}, S, E, wv); if (DUP == 1) gemm_phase(lds, GemmDesc{D, D, D}, S, E, wv);
            PH_END
            PH_BEGIN
                Sched S = make_sched(64, 4, Gb, 256L * FF * 2, 0, WL + WL_DN, 0, 256L * FF * 2);
                EpiRes<0> E{nullptr, HB, LO, rs_next, xl}; gemm_phase(lds, GemmDesc{FF, FF, FF}, S, E, wv);
            PH_END
        }
    }
    PH_BEGIN
        const int tid = otid(wv), lane = tid & 63, wave = tid >> 6; const int gw = blockIdx.x * 8 + wave, NGW = gridDim.x * 8;
        f32x4 fv[8][4]; float fr_[8];
#pragma unroll
        for (int k = 0; k < 8; ++k) { const int m = gw + k * NGW; float s = 0.f;
#pragma unroll
            for (int j = 0; j < 2; ++j) { if (m < T) load_hilo8(HB, LO, (size_t)m * D + 8 * lane + 512 * j, fv[k][2 * j], fv[k][2 * j + 1]); else { fv[k][2 * j] = (f32x4){0.f, 0.f, 0.f, 0.f}; fv[k][2 * j + 1] = fv[k][2 * j]; } }
#pragma unroll
            for (int j = 0; j < 4; ++j) s += (fv[k][j][0] * fv[k][j][0] + fv[k][j][1] * fv[k][j][1]) + (fv[k][j][2] * fv[k][j][2] + fv[k][j][3] * fv[k][j][3]);
            fr_[k] = rsqrtf(wave_sum(s, lane) * (1.f / D) + EPS); }
        if (MK_LO) GRID_SYNC();
#pragma unroll
        for (int k = 0; k < 8; ++k) { const int m = gw + k * NGW;
            if (m < T) {
#pragma unroll
                for (int j = 0; j < 4; ++j) { const int col = 8 * lane + 512 * (j >> 1) + 4 * (j & 1); const f32x4 gg = *(const f32x4*)(p.in[26] + col); *(f32x4*)(p.out + (size_t)m * D + col) = fv[k][j] * fr_[k] * gg; } } }
        for (int m = gw + 8 * NGW; m < T; m += NGW) { }
    PH_END
#undef PH_BEGIN
#undef PH_END
}
__global__ void __launch_bounds__(512) k_sync_state(const float* h, bf16_t* HB, float* rsq) { sync_state(h, HB, rsq, threadIdx.x >> 6); }
}
#ifndef OPT_MASK
#define OPT_MASK 63
#endif
#ifndef HYBRID
#define HYBRID 0
#endif
static void mega_launch(hipStream_t stream, mk::P p, int lo, int hi, int grid) {
    p.lo = lo; p.hi = hi; void* args[] = {&p};
    hipError_t e = hipLaunchCooperativeKernel((const void*)mk::mega, dim3(grid), dim3(512), args, mk::LDS_BYTES, stream);
    if (e != hipSuccess) fprintf(stderr, "cooperative launch failed: %s (grid %d)\n", hipGetErrorString(e), grid);
}
extern "C" void kernel_launch(void* const* d_in, const int* in_sizes, int n_in, void* d_out, int out_size, void* d_ws, size_t ws_size, hipStream_t stream) {
    static int grid = 0;
    if (grid == 0) {
        if (n_in != 27 || ws_size < mk::WS_NEED) { fprintf(stderr, "kernel_launch: unexpected n_in %d / ws %zu\n", n_in, ws_size); grid = -1; return; }
        int dev = 0, cus = 0, per_cu = 0;
        hipGetDevice(&dev); hipDeviceGetAttribute(&cus, hipDeviceAttributeMultiprocessorCount, dev);
        hipFuncSetAttribute((const void*)mk::mega, hipFuncAttributeMaxDynamicSharedMemorySize, mk::LDS_BYTES);
        hipOccupancyMaxActiveBlocksPerMultiprocessor(&per_cu, (const void*)mk::mega, 512, mk::LDS_BYTES);
        if (per_cu < 1) per_cu = 1;
        (void)hipGetLastError();
        grid = cus * per_cu;
    }
    if (grid < 0) return;
    mk::P p{}; for (int i = 0; i < 27; ++i) p.in[i] = (const float*)d_in[i];
    p.out = (float*)d_out; p.ws = (unsigned char*)d_ws;
#if !HYBRID
    hipMemsetAsync(d_ws, 0, 65536, stream);
    mega_launch(stream, p, 0, 1000, grid);
#else
    nv::In in{}; for (int i = 0; i < 27; ++i) in.p[i] = (const float*)d_in[i];
    float* h = (float*)d_out; float* scr = (float*)((unsigned char*)d_ws + mk::OFF_SCR);
    mega_launch(stream, p, 0, 2, grid);
    int ph = 2;
    for (int i = 0; i < 4; ++i) {
        const int kind = i % 3; const int nmix = kind == 0 ? 2 : kind == 1 ? 3 : 5;
        for (int sub = 0; sub < 3; ++sub) {
            const int np = sub == 0 ? nmix : sub == 1 ? 4 : 2; const int bit = sub == 0 ? kind : sub == 1 ? 3 : 4;
            if ((OPT_MASK >> bit) & 1) {
                mk::k_sync_state<<<256, 512, 0, stream>>>(h, (mk::bf16_t*)((unsigned char*)d_ws + mk::OFF_HB), (float*)((unsigned char*)d_ws + mk::OFF_RS) + (size_t)(3 * i + sub) * mk::T);
                mega_launch(stream, p, ph, ph + np, grid);
            } else nv::sublayer(stream, in, h, scr, i, sub);
            ph += np;
        }
    }
    if ((OPT_MASK >> 5) & 1) mega_launch(stream, p, 38, 39, grid); else nv::final_norm(stream, in, h);
#endif
}
```

```cpp
#include <hip/hip_runtime.h>
#include <hip/hip_cooperative_groups.h>
#include <cstdio>
#include <cstdint>
namespace cg = cooperative_groups;
#define HYBRID 0
#define OPT_MASK 63
#define DUP 0
#define SEAMS 1
#define MK_SP2 1
#define MK_BAUX 0
#define MK_AAUX 0
#define MK_LO 0
namespace mk {
#define LAS __attribute__((address_space(3)))
typedef unsigned short bf16_t;
typedef short bf16x8 __attribute__((ext_vector_type(8)));
typedef float f32x4 __attribute__((ext_vector_type(4)));
typedef float f32x16 __attribute__((ext_vector_type(16)));
typedef float f32x2 __attribute__((ext_vector_type(2)));
typedef unsigned u32x4 __attribute__((ext_vector_type(4)));
typedef unsigned u32x2 __attribute__((ext_vector_type(2)));
typedef __bf16 bf16x2_t __attribute__((ext_vector_type(2)));
constexpr int T = 16384, D = 1024, SEQ = 4096, FF = 2816, NB = 4;
constexpr float EPS = 1e-6f, LOG2E = 1.4426950408889634f;
constexpr int BM = 256, BK = 64, HALF = 128, HTB = HALF * BK * 2, STAGE_BYTES = 8 * HTB, NXCD = 8, WGM = 8;
constexpr int XLDS_OFF = STAGE_BYTES;
constexpr int LDS_BYTES = 147456;

__device__ __forceinline__ unsigned cvtpk(float lo, float hi) { f32x2 v = {lo, hi}; bf16x2_t b = __builtin_convertvector(v, bf16x2_t); return __builtin_bit_cast(unsigned, b); }
__device__ __forceinline__ float bf2f(bf16_t b) { return __builtin_bit_cast(float, (unsigned)b << 16); }
__device__ __forceinline__ float fast_exp2(float x) { return __builtin_amdgcn_exp2f(x); }
__device__ __forceinline__ float fast_log2(float x) { return __builtin_amdgcn_logf(x); }
__device__ __forceinline__ float fast_rcp(float x) { return __builtin_amdgcn_rcpf(x); }
__device__ __forceinline__ float sigmoidf_(float x) { return fast_rcp(1.f + fast_exp2(-x * LOG2E)); }
__device__ __forceinline__ int lane_id_v() { int l; asm volatile("v_mbcnt_lo_u32_b32 %0, -1, 0\n\tv_mbcnt_hi_u32_b32 %0, -1, %0" : "=v"(l)); return l; }
__device__ __forceinline__ float shx(float v, int mask, int lane) { return __builtin_bit_cast(float, __builtin_amdgcn_ds_bpermute((lane ^ mask) << 2, __builtin_bit_cast(int, v))); }
__device__ __forceinline__ float wave_sum(float v, int lane) {
#pragma unroll
    for (int o = 1; o < 64; o <<= 1) v += shx(v, o, lane);
    return v;
}
template <int CTRL> __device__ __forceinline__ float dppf(float v) { return __builtin_bit_cast(float, __builtin_amdgcn_update_dpp(0, __builtin_bit_cast(int, v), CTRL, 0xf, 0xf, false)); }

__host__ __device__ __forceinline__ int lds_byte(int r, int c) { const int st = (r >> 4) * 2 + (c >> 5), rr = r & 15, cc = c & 31, ob = rr * 64 + cc * 2; return st * 1024 + (ob ^ (((ob >> 9) & 1) << 5)); }
__host__ __device__ __forceinline__ void stage_rc(int b, int& R, int& C) { const int st = b / 1024, sb = b % 1024, swz = sb ^ (((sb >> 9) & 1) << 5); R = (st >> 1) * 16 + swz / 64; C = (st & 1) * 32 + (swz % 64) / 2; }
__host__ __device__ __forceinline__ int perm_sw(int rho) { const int n = rho >> 4, i = rho & 15, q = i >> 2, j = i & 3; return 16 * n + 8 * (q & 1) + 4 * (q >> 1) + j; }
__host__ __device__ __forceinline__ int perm32(int rho) { const int n = rho >> 4, i = rho & 15; return 8 * (i >> 2) + 4 * n + (i & 3); }

struct Unit { int pm, pn; };
struct GemmDesc { int lda, ldb, K; };

struct Sched {
    int kind, nM, nN, nwg, G, c, bdiv;
    const char* A; const char* B;
    long a_pm, a_pn, a_pb, b_pm, b_pn, b_pb;
    unsigned* done_cnt; unsigned* wait_cnt; int wait_target, done_kind, wait_kind;
    __device__ __forceinline__ void wait_one(unsigned* w) const {
        unsigned sp = 0; while (__builtin_amdgcn_readfirstlane(__hip_atomic_load(w, __ATOMIC_RELAXED, __HIP_MEMORY_SCOPE_AGENT)) < (unsigned)wait_target) { __builtin_amdgcn_s_sleep(2); if (++sp > (1u << 20)) break; }
    }
    __device__ __forceinline__ void a_ready(const Unit& u, int wid) const {
        if (!wait_cnt) return;
        if (wid == 0) {
            if (wait_kind == 0) wait_one(wait_cnt + u.pm);
            __builtin_amdgcn_fence(__ATOMIC_ACQUIRE, "agent"); asm volatile("s_waitcnt vmcnt(0)" ::: "memory");
        }
        __builtin_amdgcn_s_barrier(); asm volatile("" ::: "memory");
    }
    __device__ __forceinline__ void done(const Unit& u, int wid, int lane) const {
        if (!done_cnt) return;
        asm volatile("s_waitcnt vmcnt(0)" ::: "memory"); __builtin_amdgcn_s_barrier(); asm volatile("" ::: "memory");
        if (wid == 0 && lane == 0) { __builtin_amdgcn_fence(__ATOMIC_RELEASE, "agent"); asm volatile("s_waitcnt vmcnt(0)" ::: "memory");
            __hip_atomic_fetch_add(done_cnt + u.pm, 1u, __ATOMIC_RELAXED, __HIP_MEMORY_SCOPE_AGENT); }
    }
    __device__ __forceinline__ bool next(int i, Unit& u) const {
        const long L = (long)i * G + c; if (L >= nwg) return false;
        int wgid = (int)L;
        if (kind >= 2) { u.pm = wgid; u.pn = 0; return true; }
        { const int q = nwg / NXCD, r = nwg % NXCD, xcd = wgid % NXCD, off = wgid / NXCD; wgid = (xcd < r ? xcd * (q + 1) : r * (q + 1) + (xcd - r) * q) + off; }
        const int nig = WGM * nN, gid = wgid / nig, fm = gid * WGM, gsz = (nM - fm) < WGM ? (nM - fm) : WGM;
        u.pm = fm + ((wgid % nig) % gsz); u.pn = (wgid % nig) / gsz; return true;
    }
    __device__ __forceinline__ void base(const Unit& u, const char*& a, const char*& b) const {
        if (kind == 0) { const int pb = u.pm / bdiv; a = A + u.pm * a_pm + u.pn * a_pn + pb * a_pb; b = B + u.pm * b_pm + u.pn * b_pn + pb * b_pb; }
        else if (kind == 1) { const int bt = u.pm / 17, j = u.pm % 17; int o0 = 254 * j; if (o0 > 3842) o0 = 3842; const long start = (long)bt * SEQ + o0 - 2; a = A + start * a_pm; b = B + u.pn * b_pn; }
        else if (kind == 2) { const int L = u.pm, layer = L >> 5, r = L & 31, tm = r >> 3, tn = r & 7;
            a = A + (long)tm * 256 * 2048; b = B + (long)layer * b_pb + (long)tn * 256 * 2048; }
        else if (kind == 3) { const int L = u.pm, layer = L >> 6, r = L & 63, bt = r >> 4, hh = (r >> 2) & 3, kt = r & 3;
            a = A + (long)layer * a_pb + (long)bt * 256 * 4096 + hh * 512; b = B + (long)layer * b_pb + (long)kt * 256 * 2048 + hh * 512; }
        else { const int L = u.pm, layer = L >> 6, r = L & 63, bt = r >> 4, hh = (r >> 2) & 3, nt = r & 3;
            a = A + (long)layer * a_pb + (long)nt * 256 * 2048 + hh * 512; b = B + (long)layer * b_pb + (long)bt * 256 * 4096 + (1024 + hh * 256) * 2; }
    }
};
__device__ __forceinline__ Sched make_sched(int nM, int nN, const void* A, long a_pm, long a_pn, const void* B, long b_pm, long b_pn, int bdiv = 1 << 30, long a_pb = 0, long b_pb = 0) {
    Sched s; s.done_cnt = nullptr; s.wait_cnt = nullptr; s.wait_target = 0; s.done_kind = 0; s.wait_kind = 0; s.kind = 0; s.nM = nM; s.nN = nN; s.nwg = nM * nN; s.G = gridDim.x; s.c = blockIdx.x; s.bdiv = bdiv; s.A = (const char*)A; s.B = (const char*)B;
    s.a_pm = a_pm; s.a_pn = a_pn; s.a_pb = a_pb; s.b_pm = b_pm; s.b_pn = b_pn; s.b_pb = b_pb; return s;
}

template <class Epi>
__device__ __forceinline__ void gemm_phase(LAS unsigned char* lds, const GemmDesc g, const Sched& S, const Epi& E, int wv) {
    int tid_ = wv * 64 + lane_id_v();
    const int tid = tid_, wid = __builtin_amdgcn_readfirstlane(tid >> 6), lane = tid & 63, wr = wid >> 2, wc = wid & 3, fr = lane & 15, fq = lane >> 4;
    const int K = g.K, nt = K / BK;
    unsigned voffA[2], voffB[2];
#pragma unroll
    for (int i = 0; i < 2; ++i) { int R, C; stage_rc(tid * 16 + i * 8192, R, C); const int Rb = (int)Epi::PERM == 2 ? ((R & ~31) + perm_sw(R & 31)) : (int)Epi::PERM == 1 ? ((R & ~31) + perm32(R & 31)) : R;
        voffA[i] = (unsigned)(R * g.lda + C) * 2u; voffB[i] = (unsigned)(Rb * g.ldb + C) * 2u; }
    const size_t kstep = (size_t)(BK * 2);
    const size_t hstepA = (size_t)HALF * g.lda * 2, hstepB = (size_t)HALF * g.ldb * 2;
    const unsigned ldsw = (unsigned)wid * 1024u;
    const int aoff = lds_byte(wr * 64 + fr, fq * 8), boff = lds_byte(wc * 32 + fr, fq * 8);
#define PG8_SA(b, h) (((b) * 2 + (h)) * HTB)
#define PG8_SB(b, h) ((4 + (b) * 2 + (h)) * HTB)
#define PG8_STAGE(bufoff, gbase, voff) do { _Pragma("unroll") for (int _i = 0; _i < 2; ++_i) \
        __builtin_amdgcn_global_load_lds((const unsigned*)((const char*)(gbase) + (voff)[_i]), (LAS unsigned*)(lds + (bufoff) + ldsw + _i * 8192), 16, 0, 0); } while (0)
#define PG8_LDA(dst, b, h) do { _Pragma("unroll") for (int m = 0; m < 4; ++m) _Pragma("unroll") for (int k = 0; k < 2; ++k) dst[m][k] = *(const LAS bf16x8*)(lds + PG8_SA(b, h) + aoff + m * 2048 + k * 1024); } while (0)
#define PG8_LDB(dst, b, h) do { _Pragma("unroll") for (int n = 0; n < 2; ++n) _Pragma("unroll") for (int k = 0; k < 2; ++k) dst[n][k] = *(const LAS bf16x8*)(lds + PG8_SB(b, h) + boff + n * 2048 + k * 1024); } while (0)
#define PG8_MMA(ai, bj, At, Bt) do { __builtin_amdgcn_s_setprio(1); _Pragma("unroll") for (int m = 0; m < 4; ++m) _Pragma("unroll") for (int n = 0; n < 2; ++n) _Pragma("unroll") for (int k = 0; k < 2; ++k) \
        acc[ai][bj][m][n] = __builtin_amdgcn_mfma_f32_16x16x32_bf16(Bt[n][k], At[m][k], acc[ai][bj][m][n], 0, 0, 0); __builtin_amdgcn_s_setprio(0); } while (0)
#define PG8_WAIT_V(n) asm volatile("s_waitcnt vmcnt(" #n ")" ::: "memory")
#define PG8_WAIT_L(n) asm volatile("s_waitcnt lgkmcnt(" #n ")" ::: "memory")
#define PG8_BAR __builtin_amdgcn_s_barrier()
#define PG8_SCHED __builtin_amdgcn_sched_barrier(0)
    Unit cur, nxt; int ui = 0;
    if (!S.next(0, cur)) return;
    f32x4 acc[2][2][4][2];
#pragma unroll
    for (int a = 0; a < 2; ++a)
#pragma unroll
        for (int b = 0; b < 2; ++b)
#pragma unroll
            for (int m = 0; m < 4; ++m)
#pragma unroll
                for (int n = 0; n < 2; ++n) acc[a][b][m][n] = (f32x4){0.f, 0.f, 0.f, 0.f};
    bf16x8 At[4][2], B0[2][2], B1[2][2];
    const char* cA; const char* cB; S.base(cur, cA, cB);
    S.a_ready(cur, wid);
    PG8_STAGE(PG8_SB(0, 0), cB, voffB); PG8_STAGE(PG8_SB(0, 1), cB + hstepB, voffB); PG8_STAGE(PG8_SA(0, 0), cA, voffA); PG8_STAGE(PG8_SA(0, 1), cA + hstepA, voffA);
    if (wr == 1) PG8_BAR;
    PG8_WAIT_V(2); PG8_BAR;
    PG8_STAGE(PG8_SB(1, 0), cB + kstep, voffB); PG8_STAGE(PG8_SA(1, 0), cA + kstep, voffA); PG8_STAGE(PG8_SB(1, 1), cB + hstepB + kstep, voffB);
    PG8_WAIT_V(6); PG8_BAR;
    for (;;) {
        const bool has_next = S.next(ui + 1, nxt);
        const char* nA = cA; const char* nB = cB; if (has_next) S.base(nxt, nA, nB);
        for (int t = 0; t < nt; t += 2) {
            const bool last = (t == nt - 2);
            if (last && has_next) S.a_ready(nxt, wid);
            const char* a1 = cA + (size_t)(t + 1) * kstep;
            const char* a2 = last ? nA : cA + (size_t)(t + 2) * kstep; const char* b2 = last ? nB : cB + (size_t)(t + 2) * kstep;
            const char* a3 = a2 + kstep; const char* b3 = b2 + kstep;
            PG8_LDB(B0, 0, 0); PG8_LDB(B1, 0, 1); PG8_SCHED; PG8_LDA(At, 0, 0); PG8_STAGE(PG8_SA(1, 1), a1 + hstepA, voffA);
            PG8_WAIT_V(8); PG8_WAIT_L(0); PG8_BAR; PG8_MMA(0, 0, At, B0); PG8_MMA(0, 1, At, B1); PG8_BAR; PG8_SCHED;
            PG8_LDA(At, 0, 1); PG8_STAGE(PG8_SB(0, 0), b2, voffB); PG8_STAGE(PG8_SB(0, 1), b2 + hstepB, voffB); PG8_STAGE(PG8_SA(0, 0), a2, voffA);
            PG8_WAIT_V(8); PG8_WAIT_L(0); PG8_BAR; PG8_MMA(1, 0, At, B0); PG8_MMA(1, 1, At, B1); PG8_BAR; PG8_SCHED;
            PG8_LDB(B0, 1, 0); PG8_LDB(B1, 1, 1); PG8_SCHED; PG8_LDA(At, 1, 0); PG8_STAGE(PG8_SA(0, 1), a2 + hstepA, voffA);
            PG8_WAIT_V(8); PG8_WAIT_L(0); PG8_BAR; PG8_MMA(0, 0, At, B0); PG8_MMA(0, 1, At, B1); PG8_BAR; PG8_SCHED;
            PG8_LDA(At, 1, 1); PG8_STAGE(PG8_SB(1, 0), b3, voffB); PG8_STAGE(PG8_SB(1, 1), b3 + hstepB, voffB); PG8_STAGE(PG8_SA(1, 0), a3, voffA);
            PG8_WAIT_V(8); PG8_WAIT_L(0); PG8_BAR; PG8_MMA(1, 0, At, B0); PG8_MMA(1, 1, At, B1); PG8_BAR; PG8_SCHED;
        }
        if (wr == 0) PG8_BAR;
        { int fr_e = fr, fq_e = fq; asm volatile("" : "+v"(fr_e), "+v"(fq_e)); E(acc, cur, wr, wc, fr_e, fq_e); }
        S.done(cur, wid, lane);
        if (!has_next) break;
#pragma unroll
        for (int a = 0; a < 2; ++a)
#pragma unroll
            for (int b = 0; b < 2; ++b)
#pragma unroll
                for (int m = 0; m < 4; ++m)
#pragma unroll
                    for (int n = 0; n < 2; ++n) acc[a][b][m][n] = (f32x4){0.f, 0.f, 0.f, 0.f};
        cur = nxt; cA = nA; cB = nB; ++ui;
        if (wr == 1) PG8_BAR;
    }
    PG8_WAIT_V(0);
    PG8_BAR;
#undef PG8_SA
#undef PG8_SB
#undef PG8_STAGE
#undef PG8_LDA
#undef PG8_LDB
#undef PG8_MMA
#undef PG8_WAIT_V
#undef PG8_WAIT_L
#undef PG8_SCHED
}
#define MK_BAR() do { asm volatile("s_waitcnt vmcnt(0) lgkmcnt(0)" ::: "memory"); __builtin_amdgcn_s_barrier(); asm volatile("" ::: "memory"); } while (0)
#define MK_LBAR() do { asm volatile("s_waitcnt lgkmcnt(0)" ::: "memory"); __builtin_amdgcn_s_barrier(); asm volatile("" ::: "memory"); } while (0)

typedef f32x4 AccT[2][2][4][2];
#ifndef MK_LO
#define MK_LO 1
#endif
__device__ __forceinline__ f32x4 unpack_bf4(u32x2 w) { f32x4 r; r[0] = __builtin_bit_cast(float, w.x << 16); r[1] = __builtin_bit_cast(float, w.x & 0xffff0000u); r[2] = __builtin_bit_cast(float, w.y << 16); r[3] = __builtin_bit_cast(float, w.y & 0xffff0000u); return r; }
__device__ __forceinline__ f32x4 load_hilo4(const bf16_t* hi, const bf16_t* lo, size_t off) { return unpack_bf4(*(const u32x2*)(hi + off)) + unpack_bf4(*(const u32x2*)(lo + off)); }
__device__ __forceinline__ void load_hilo8(const bf16_t* hi, const bf16_t* lo, size_t off, f32x4& a, f32x4& b) { const u32x4 h4 = *(const u32x4*)(hi + off); u32x4 l4 = (u32x4){0u, 0u, 0u, 0u}; if (MK_LO) l4 = *(const u32x4*)(lo + off);
    u32x2 ha, hb_, la, lb; ha.x = h4.x; ha.y = h4.y; hb_.x = h4.z; hb_.y = h4.w; la.x = l4.x; la.y = l4.y; lb.x = l4.z; lb.y = l4.w; a = unpack_bf4(ha) + unpack_bf4(la); b = unpack_bf4(hb_) + unpack_bf4(lb); }
__device__ __forceinline__ void store_hilo4(bf16_t* hi, bf16_t* lo, size_t off, f32x4 v) { u32x2 w; w.x = cvtpk(v[0], v[1]); w.y = cvtpk(v[2], v[3]); const f32x4 d = v - unpack_bf4(w); u32x2 l; l.x = cvtpk(d[0], d[1]); l.y = cvtpk(d[2], d[3]);
    *(u32x2*)(hi + off) = w; *(u32x2*)(lo + off) = l; }
constexpr int RSN = MK_LO ? 1 : 8;
__device__ __forceinline__ float rs_of(const float* rsq, int row) {
    if (RSN == 1) return rsqrtf(rsq[row] * (1.f / D) + EPS);
    const f32x4 x = *(const f32x4*)(rsq + (size_t)row * 8), y = *(const f32x4*)(rsq + (size_t)row * 8 + 4);
    return rsqrtf((((x[0] + x[1]) + (x[2] + x[3])) + ((y[0] + y[1]) + (y[2] + y[3]))) * (1.f / D) + EPS); }

struct EpiBf {
    static constexpr bool PERM = true;
    bf16_t* O; int ldc; long o_pm, o_pn; const float* rsq; const float* csq;
    __device__ __forceinline__ void operator()(const AccT& acc, const Unit& u, int wr, int wc, int fr, int fq) const {
        bf16_t* base = O + u.pm * o_pm + u.pn * o_pn;
        float cs[2][8];
#pragma unroll
        for (int bj = 0; bj < 2; ++bj)
#pragma unroll
            for (int e = 0; e < 8; ++e) cs[bj][e] = csq ? rs_of(csq, u.pn * 256 + bj * HALF + wc * 32 + 8 * fq + e) : 1.f;
#pragma unroll
        for (int ai = 0; ai < 2; ++ai)
#pragma unroll
            for (int m = 0; m < 4; ++m) { const int row = ai * HALF + wr * 64 + m * 16 + fr; const float r = rsq ? rs_of(rsq, u.pm * 256 + row) : 1.f;
#pragma unroll
                for (int bj = 0; bj < 2; ++bj) { const f32x4 v0 = acc[ai][bj][m][0], v1 = acc[ai][bj][m][1]; u32x4 w;
                    w.x = cvtpk(v0[0] * r * cs[bj][0], v0[1] * r * cs[bj][1]); w.y = cvtpk(v0[2] * r * cs[bj][2], v0[3] * r * cs[bj][3]);
                    w.z = cvtpk(v1[0] * r * cs[bj][4], v1[1] * r * cs[bj][5]); w.w = cvtpk(v1[2] * r * cs[bj][6], v1[3] * r * cs[bj][7]);
                    *(u32x4*)(base + (size_t)row * ldc + bj * HALF + wc * 32 + 8 * fq) = w; } }
    }
};
struct EpiKV {
    static constexpr bool PERM = true;
    bf16_t* KV; const float* msq;
    __device__ __forceinline__ void operator()(const AccT& acc, const Unit& u, int wr, int wc, int fr, int fq) const {
        const int L = u.pm, layer = L >> 5, r = L & 31, tm = r >> 3, tn = r & 7;
        EpiBf e; e.ldc = 2048; e.o_pm = 256 * 2048; e.o_pn = 256; e.O = KV + (size_t)layer * 1024 * 2048; e.rsq = msq; e.csq = nullptr; Unit v; v.pm = tm; v.pn = tn;
        e(acc, v, wr, wc, fr, fq);
    }
};
template <int ISN> struct EpiMN {
    static constexpr bool PERM = true;
    bf16_t* O;
    __device__ __forceinline__ void operator()(const AccT& acc, const Unit& u, int wr, int wc, int fr, int fq) const {
        const int L = u.pm, layer = L >> 6, r = L & 63, bt = r >> 4, hh = (r >> 2) & 3, t4 = r & 3;
        EpiBf e; e.ldc = 1024; e.o_pm = 256 * 1024; e.o_pn = 256; e.O = O + ((size_t)layer * 4 + bt) * 1024 * 1024; e.rsq = nullptr; e.csq = nullptr; Unit v;
        if (!ISN) { v.pm = hh; v.pn = t4; } else { v.pm = t4; v.pn = hh; }
        e(acc, v, wr, wc, fr, fq);
    }
};
template <int GLU> struct EpiRes {
    static constexpr bool PERM = true;
    const float* base32; bf16_t* hi; bf16_t* lo; float* rsq; LAS float* xl;
    __device__ __forceinline__ void operator()(const AccT& acc, const Unit& u, int wr, int wc, int fr, int fq) const {
        constexpr int NBJ = GLU ? 1 : 2;
#pragma unroll
        for (int q = 0; q < 4; ++q) { const int ai = q >> 1, m0 = (q & 1) * 2;
            f32x4 bv[2][NBJ][2];
#pragma unroll
            for (int mm = 0; mm < 2; ++mm) { const int row = u.pm * 256 + ai * HALF + wr * 64 + (m0 + mm) * 16 + fr;
#pragma unroll
                for (int bj = 0; bj < NBJ; ++bj) { const int col = GLU ? (u.pn * 128 + wc * 32 + 8 * fq) : (u.pn * 256 + bj * HALF + wc * 32 + 8 * fq); const size_t off = (size_t)row * D + col;
                    if (base32) { bv[mm][bj][0] = *(const f32x4*)(base32 + off); bv[mm][bj][1] = *(const f32x4*)(base32 + off + 4); }
                    else { const u32x4 h4 = *(const u32x4*)(hi + off); u32x4 l4 = (u32x4){0u, 0u, 0u, 0u}; if (MK_LO) l4 = *(const u32x4*)(lo + off); u32x2 ha, hb_, la, lb; ha.x = h4.x; ha.y = h4.y; hb_.x = h4.z; hb_.y = h4.w; la.x = l4.x; la.y = l4.y; lb.x = l4.z; lb.y = l4.w;
                        bv[mm][bj][0] = unpack_bf4(ha) + unpack_bf4(la); bv[mm][bj][1] = unpack_bf4(hb_) + unpack_bf4(lb); } } }
#pragma unroll
            for (int mm = 0; mm < 2; ++mm) { const int m = m0 + mm; const int row = u.pm * 256 + ai * HALF + wr * 64 + m * 16 + fr; float ss = 0.f;
#pragma unroll
                for (int bj = 0; bj < NBJ; ++bj) { const int col = GLU ? (u.pn * 128 + wc * 32 + 8 * fq) : (u.pn * 256 + bj * HALF + wc * 32 + 8 * fq); const size_t off = (size_t)row * D + col;
                    f32x4 v[2];
#pragma unroll
                    for (int n = 0; n < 2; ++n) { f32x4 t = acc[ai][bj][m][n];
                        if (GLU) { const f32x4 gt = acc[ai][1][m][n]; t[0] *= sigmoidf_(gt[0]); t[1] *= sigmoidf_(gt[1]); t[2] *= sigmoidf_(gt[2]); t[3] *= sigmoidf_(gt[3]); }
                        t = t + bv[mm][bj][n]; v[n] = t; ss += (t[0] * t[0] + t[1] * t[1]) + (t[2] * t[2] + t[3] * t[3]); }
                    u32x4 h4; h4.x = cvtpk(v[0][0], v[0][1]); h4.y = cvtpk(v[0][2], v[0][3]); h4.z = cvtpk(v[1][0], v[1][1]); h4.w = cvtpk(v[1][2], v[1][3]);
                    u32x2 ha, hb_; ha.x = h4.x; ha.y = h4.y; hb_.x = h4.z; hb_.y = h4.w; const f32x4 d0 = v[0] - unpack_bf4(ha), d1 = v[1] - unpack_bf4(hb_);
                    u32x4 l4; l4.x = cvtpk(d0[0], d0[1]); l4.y = cvtpk(d0[2], d0[3]); l4.z = cvtpk(d1[0], d1[1]); l4.w = cvtpk(d1[2], d1[3]);
                    *(u32x4*)(hi + off) = h4; if (MK_LO) *(u32x4*)(lo + off) = l4; }
                ss += shx(ss, 16, fq * 16 + fr); ss += shx(ss, 32, fq * 16 + fr);
                if (fq == 0) xl[wc * 256 + ai * HALF + wr * 64 + m * 16 + fr] = ss; }
        }
        MK_LBAR();
        { const int t = (wr * 4 + wc) * 64 + fq * 16 + fr; if (t < 256) { const float s = (xl[t] + xl[256 + t]) + (xl[512 + t] + xl[768 + t]); if (RSN == 1) __hip_atomic_fetch_add(rsq + u.pm * 256 + t, s, __ATOMIC_RELAXED, __HIP_MEMORY_SCOPE_AGENT);
                else { float* rp = rsq + (size_t)(u.pm * 256 + t) * 8; rp[u.pn] = s; if (!GLU) rp[4 + u.pn] = 0.f; } } }
    }
};
struct EpiSoftmax {
    static constexpr bool PERM = true;
    bf16_t* P; LAS float* xl; const float* rsq;
    __device__ __forceinline__ void operator()(AccT& acc, const Unit& u, int wr, int wc, int fr, int fq) const {
        LAS float* mx = xl; LAS float* sm = xl + 1024;
#pragma unroll
        for (int ai = 0; ai < 2; ++ai)
#pragma unroll
            for (int m = 0; m < 4; ++m) { float mm = -3.0e38f; const float rr = rs_of(rsq, u.pm * 256 + ai * HALF + wr * 64 + m * 16 + fr);
#pragma unroll
                for (int bj = 0; bj < 2; ++bj)
#pragma unroll
                    for (int n = 0; n < 2; ++n) { const f32x4 v = acc[ai][bj][m][n] * rr; acc[ai][bj][m][n] = v; mm = fmaxf(mm, fmaxf(fmaxf(v[0], v[1]), fmaxf(v[2], v[3]))); }
                mm = fmaxf(mm, shx(mm, 16, fq * 16 + fr)); mm = fmaxf(mm, shx(mm, 32, fq * 16 + fr));
                if (fq == 0) mx[wc * 256 + ai * HALF + wr * 64 + m * 16 + fr] = mm; }
        MK_LBAR();
#pragma unroll
        for (int ai = 0; ai < 2; ++ai)
#pragma unroll
            for (int m = 0; m < 4; ++m) { const int row = ai * HALF + wr * 64 + m * 16 + fr;
                const float mm = fmaxf(fmaxf(mx[row], mx[256 + row]), fmaxf(mx[512 + row], mx[768 + row])); float s = 0.f;
#pragma unroll
                for (int bj = 0; bj < 2; ++bj)
#pragma unroll
                    for (int n = 0; n < 2; ++n)
#pragma unroll
                        for (int j = 0; j < 4; ++j) { const float e = fast_exp2(acc[ai][bj][m][n][j] - mm); acc[ai][bj][m][n][j] = e; s += e; }
                s += shx(s, 16, fq * 16 + fr); s += shx(s, 32, fq * 16 + fr);
                if (fq == 0) sm[wc * 256 + row] = s; }
        MK_LBAR();
#pragma unroll
        for (int ai = 0; ai < 2; ++ai)
#pragma unroll
            for (int m = 0; m < 4; ++m) { int zo = 0; asm volatile("" : "+v"(zo)); const int row = ai * HALF + wr * 64 + m * 16 + fr + zo;
                const float inv = fast_rcp((sm[row] + sm[256 + row]) + (sm[512 + row] + sm[768 + row]));
#pragma unroll
                for (int bj = 0; bj < 2; ++bj) { const f32x4 v0 = acc[ai][bj][m][0], v1 = acc[ai][bj][m][1]; u32x4 w;
                    w.x = cvtpk(v0[0] * inv, v0[1] * inv); w.y = cvtpk(v0[2] * inv, v0[3] * inv);
                    w.z = cvtpk(v1[0] * inv, v1[1] * inv); w.w = cvtpk(v1[2] * inv, v1[3] * inv);
                    *(u32x4*)(P + (size_t)(u.pm * 256 + row) * D + u.pn * 256 + bj * HALF + wc * 32 + 8 * fq) = w; } }
    }
};
struct EpiConvGlu {
    static constexpr int PERM = 2;
    bf16_t* Gb; const float* rsq; const float* cw; const float* cb; LAS float* xl;
    __device__ __forceinline__ void operator()(AccT& acc, const Unit& u, int wr, int wc, int fr, int fq) const {
        const int bt = u.pm / 17, jt = u.pm % 17; int o0 = 254 * jt; if (o0 > 3842) o0 = 3842;
        const int tib0 = o0 - 2; const long tok0 = (long)bt * SEQ + tib0;
#pragma unroll
        for (int ai = 0; ai < 2; ++ai)
#pragma unroll
            for (int m = 0; m < 4; ++m) { const int R = ai * HALF + wr * 64 + m * 16 + fr; const bool ok = (tib0 + R) >= 0; const float r = ok ? rs_of(rsq, (int)(tok0 + R)) : 0.f;
#pragma unroll
                for (int bj = 0; bj < 2; ++bj)
#pragma unroll
                    for (int n = 0; n < 2; ++n) acc[ai][bj][m][n] = acc[ai][bj][m][n] * r; }
        if (fr >= 14) {
#pragma unroll
            for (int ai = 0; ai < 2; ++ai) { LAS float* hp = xl + ((((ai * 2 + wr) * 4 + wc) * 2 + (fr - 14)) * 4 + fq) * 16;
#pragma unroll
                for (int bj = 0; bj < 2; ++bj)
#pragma unroll
                    for (int n = 0; n < 2; ++n) *(LAS f32x4*)(hp + (bj * 2 + n) * 4) = acc[ai][bj][3][n]; }
        }
        MK_LBAR();
        const int f0 = u.pn * 128 + wc * 32 + 8 * (fq & 1) + 4 * (fq >> 1);
        unsigned dep = 0u;
#pragma unroll
        for (int n = 0; n < 2; ++n) {
            int zo = 0; asm volatile("" : "+v"(zo) : "v"(dep));
            const float* cwp = cw + f0 + 16 * n + zo; const float* cbp = cb + f0 + 16 * n + zo;
            f32x4 w0[2], w1[2], w2[2], bb[2];
#pragma unroll
            for (int bj = 0; bj < 2; ++bj) { w0[bj] = *(const f32x4*)(cwp + bj * FF); w1[bj] = *(const f32x4*)(cwp + 2 * FF + bj * FF); w2[bj] = *(const f32x4*)(cwp + 4 * FF + bj * FF); bb[bj] = *(const f32x4*)(cbp + bj * FF); }
#pragma unroll
            for (int ai = 0; ai < 2; ++ai) { const int grp = ai * 2 + wr;
                f32x4 pv[2]; u32x2 wprev; wprev.x = 0u; wprev.y = 0u;
#pragma unroll
                for (int bj = 0; bj < 2; ++bj) { f32x4 hv = (f32x4){0.f, 0.f, 0.f, 0.f};
                    if (grp > 0 && fr >= 14) hv = *(const LAS f32x4*)(xl + (((((grp - 1) * 4 + wc) * 2 + (fr - 14)) * 4 + fq) * 16) + (bj * 2 + n) * 4);
                    pv[bj] = hv; }
#pragma unroll
                for (int m = 0; m < 4; ++m) { const int R = ai * HALF + wr * 64 + m * 16 + fr;
                    f32x4 res[2];
#pragma unroll
                    for (int bj = 0; bj < 2; ++bj) { const f32x4 cur = acc[ai][bj][m][n]; f32x4 x1, x2;
#pragma unroll
                        for (int j = 0; j < 4; ++j) {
                            const float c1 = fr == 15 ? pv[bj][j] : cur[j], c2 = fr >= 14 ? pv[bj][j] : cur[j];
                            x1[j] = dppf<0x121>(c1); x2[j] = dppf<0x122>(c2); }
                        res[bj] = w2[bj] * cur + w1[bj] * x1 + w0[bj] * x2 + bb[bj]; pv[bj] = cur; }
                    f32x4 e4;
#pragma unroll
                    for (int j = 0; j < 4; ++j) e4[j] = fast_exp2(res[1][j] * -LOG2E);
                    e4 = e4 + 1.f;
#pragma unroll
                    for (int j = 0; j < 4; ++j) e4[j] = fast_rcp(e4[j]);
                    const f32x4 a = res[1] * e4 * res[0];
                    u32x2 w; w.x = cvtpk(a[0], a[1]); w.y = cvtpk(a[2], a[3]); dep = w.y;
                    if (!(m & 1)) wprev = w;
                    else {
                        const auto r0 = __builtin_amdgcn_permlane32_swap(wprev.x, w.x, false, false); const auto r1 = __builtin_amdgcn_permlane32_swap(wprev.y, w.y, false, false);
                        u32x4 w4; w4.x = r0[0]; w4.y = r1[0]; w4.z = r0[1]; w4.w = r1[1];
                        const int Rs = (fq < 2) ? R - 16 : R;
                        if (Rs >= 2) *(u32x4*)(Gb + (size_t)(tok0 + Rs) * FF + u.pn * 128 + wc * 32 + 16 * n + 8 * (fq & 1)) = w4; } } }
        }
        MK_LBAR();
    }
};
struct EpiS5S {
    static constexpr bool PERM = false;
    float* Sst;
    __device__ __forceinline__ void operator()(const AccT& acc, const Unit& u, int wr, int wc, int fr, int fq) const {
#pragma unroll
        for (int ai = 0; ai < 2; ++ai)
#pragma unroll
            for (int m = 0; m < 4; ++m) { const int row = u.pm * 256 + ai * HALF + wr * 64 + m * 16 + fr;
#pragma unroll
                for (int n = 0; n < 2; ++n) *(f32x4*)(Sst + (size_t)row * 128 + wc * 32 + n * 16 + fq * 4) = acc[ai][0][m][n]; }
    }
};
__device__ __forceinline__ float gelu_tanh(float x) { const float uu = 0.7978845608028654f * (x + 0.044715f * x * x * x); const float e = fast_exp2(2.f * LOG2E * uu); return x * (1.f - fast_rcp(1.f + e)); }
struct EpiS5Y {
    static constexpr bool PERM = false;
    bf16_t* Y; const bf16_t* Z; const float* dvec;
    __device__ __forceinline__ void operator()(const AccT& acc, const Unit& u, int wr, int wc, int fr, int fq) const {
        const int g = u.pm >> 2, mt = u.pm & 3;
#pragma unroll
        for (int ai = 0; ai < 2; ++ai)
#pragma unroll
            for (int m = 0; m < 4; ++m) { const int nrow = mt * 256 + ai * HALF + wr * 64 + m * 16 + fr;
#pragma unroll
                for (int bj = 0; bj < 2; ++bj)
#pragma unroll
                    for (int n = 0; n < 2; ++n) { const int col = bj * HALF + wc * 32 + n * 16 + fq * 4; const int t = col >> 4, i0 = col & 15;
                        const u32x2 uz = *(const u32x2*)(Z + ((size_t)g * 1024 + nrow) * 384 + col);
                        const float u0 = __builtin_bit_cast(float, uz.x << 16), u1 = __builtin_bit_cast(float, uz.x & 0xffff0000u), u2 = __builtin_bit_cast(float, uz.y << 16), u3 = __builtin_bit_cast(float, uz.y & 0xffff0000u);
                        const f32x4 dv = *(const f32x4*)(dvec + g * 16 + i0); const f32x4 a = acc[ai][bj][m][n];
                        u32x2 w; w.x = cvtpk(gelu_tanh(a[0] + dv[0] * u0), gelu_tanh(a[1] + dv[1] * u1)); w.y = cvtpk(gelu_tanh(a[2] + dv[2] * u2), gelu_tanh(a[3] + dv[3] * u3));
                        *(u32x2*)(Y + (size_t)(nrow * 16 + t) * D + g * 16 + i0) = w; } }
    }
};
}
namespace mk {
#define RLX_AGENT __ATOMIC_RELAXED, __HIP_MEMORY_SCOPE_AGENT
#define XB_TMO      128
#define XB_XCNT(j)  (256  + 64 * (j))
#define XB_XSUB(j)  (1280 + 64 * (j))
#define XB_XGEN(j)  (2304 + 64 * (j))
#define XB_TOP      3328
#define XB_TOPGEN   3392
#define XCD_BAR_WORDS 3456
#define XB_SPIN_CAP (1u << 18)

__device__ __forceinline__ unsigned xb_ld(unsigned* p)              { return __hip_atomic_load(p, __ATOMIC_RELAXED, __HIP_MEMORY_SCOPE_AGENT); }
__device__ __forceinline__ unsigned xb_add(unsigned* p, unsigned v) { return __hip_atomic_fetch_add(p, v, __ATOMIC_RELAXED, __HIP_MEMORY_SCOPE_AGENT); }
__device__ __forceinline__ unsigned xb_xcc_id() { return (unsigned)__builtin_amdgcn_s_getreg((3 << 11) | 20) & 0xFu; }
#define XB_SPIN(cond, bar) do { unsigned _sp = 0; while (cond) { __builtin_amdgcn_s_sleep(1); \
    if ((++_sp & 255u) == 0u) { if (xb_ld(&(bar)[XB_TMO])) break; if (_sp > XB_SPIN_CAP) { atomicAdd(&(bar)[XB_TMO], 1u); break; } } } } while (0)

struct XcdBarrier {
    unsigned* bar; unsigned x;
    volatile LAS unsigned* st;
};

__device__ __forceinline__ XcdBarrier xcd_barrier_post(unsigned* bar, volatile LAS unsigned* st) {
    XcdBarrier b; b.bar = bar; b.x = xb_xcc_id(); b.st = st;
    if (threadIdx.x == 0) (void)xb_add(&bar[XB_XCNT(b.x)], 1u);
    return b;
}
__device__ __forceinline__ void xcd_barrier_complete(unsigned* bar, unsigned x, unsigned& nloc, unsigned& nx) {
    const unsigned G = gridDim.x * gridDim.y * gridDim.z;
    unsigned sum, cnt, mine, sp = 0u;
    for (;;) {
        sum = 0u; cnt = 0u; mine = 0u;
#pragma unroll
        for (unsigned j = 0; j < 16; ++j) { const unsigned c = xb_ld(&bar[XB_XCNT(j)]); sum += c; cnt += (c > 0u) ? 1u : 0u; mine = (j == x) ? c : mine; }
        if (sum == G) break;
        __builtin_amdgcn_s_sleep(1);
        if ((++sp & 255u) == 0u) { if (xb_ld(&bar[XB_TMO])) break; if (sp > XB_SPIN_CAP) { atomicAdd(&bar[XB_TMO], 1u); break; } }
    }
    nloc = mine > 0u ? mine : 1u; nx = cnt > 0u ? cnt : 1u;
}

__device__ __forceinline__ void xcd_barrier(const XcdBarrier& b) {
    asm volatile("s_waitcnt vmcnt(0)" ::: "memory");
    __syncthreads();
    if (threadIdx.x == 0) {
        unsigned* bar = b.bar;
        __builtin_amdgcn_s_waitcnt(0);
        unsigned nloc = b.st[0], nx = b.st[1];
        if (nloc == 0u) { xcd_barrier_complete(bar, b.x, nloc, nx); b.st[0] = nloc; b.st[1] = nx; }
        const unsigned old = xb_add(&bar[XB_XSUB(b.x)], 1u);
        const unsigned gen = old / nloc;
        if (old + 1u == (gen + 1u) * nloc) {
            __builtin_amdgcn_fence(__ATOMIC_RELEASE, "agent");
            asm volatile("s_waitcnt vmcnt(0)" ::: "memory");
            const unsigned og = xb_add(&bar[XB_TOP], 1u);
            const unsigned tg = og / nx;
            __builtin_amdgcn_fence(__ATOMIC_ACQUIRE, "agent");
            if (og + 1u == (tg + 1u) * nx) xb_add(&bar[XB_TOPGEN], 1u);
            else XB_SPIN(xb_ld(&bar[XB_TOPGEN]) == tg, bar);
            xb_add(&bar[XB_XGEN(b.x)], 1u);
            asm volatile("s_waitcnt vmcnt(0)" ::: "memory");
        } else {
            __builtin_amdgcn_fence(__ATOMIC_ACQUIRE, "agent");
            XB_SPIN(xb_ld(&bar[XB_XGEN(b.x)]) == gen, bar);
            asm volatile("s_waitcnt vmcnt(0)" ::: "memory");
        }
    }
    __syncthreads();
}
}
namespace mk {
constexpr size_t MiB = 1u << 20;
constexpr size_t OFF_RS = 1 * MiB;
constexpr size_t OFF_W = 2 * MiB;
constexpr size_t OFF_WQP = 113 * MiB;
constexpr size_t OFF_HB = 122 * MiB;
constexpr size_t OFF_MEMB = 154 * MiB;
constexpr size_t OFF_KV = 156 * MiB;
constexpr size_t OFF_S5WB = 172 * MiB;
constexpr size_t OFF_S5TW = 180 * MiB;
constexpr size_t OFF_MT = 192 * MiB;
constexpr size_t OFF_NT = 224 * MiB;
constexpr size_t OFF_SCR = 256 * MiB;
constexpr size_t WS_NEED = 352 * MiB;
constexpr size_t W_PW = 0, W_QKV = 524288, W_SO = 3670016, W_GLU = 4718592, W_L0 = 6815744, W_LSTRIDE = 12845056;
constexpr size_t WL_Q = 0, WL_KV = 1048576, WL_O = 3145728, WL_UP = 4194304, WL_DN = 9961472;

struct P { const float* in[27]; float* out; unsigned char* ws; int lo, hi; };
__device__ __forceinline__ int otid(int wv) { return wv * 64 + lane_id_v(); }

__device__ __forceinline__ void transpose_item(const float* W, int ldw, int k0, int n0, bf16_t* WT, int ldk, int drow0, const float* sk, const float* sn, float cst, LAS float* scr, int lane) {
    float v[32];
#pragma unroll
    for (int i = 0; i < 32; ++i) { const int kk = 2 * i + (lane >> 5); v[i] = W[(size_t)(k0 + kk) * ldw + n0 + (lane & 31)]; }
#pragma unroll
    for (int i = 0; i < 32; ++i) { const int kk = 2 * i + (lane >> 5); scr[kk * 33 + (lane & 31)] = v[i]; }
    asm volatile("s_waitcnt lgkmcnt(0)" ::: "memory");
    const int c = lane & 7;
    f32x4 ka = (f32x4){1.f, 1.f, 1.f, 1.f}, kb = ka; if (sk) { ka = *(const f32x4*)(sk + k0 + 8 * c); kb = *(const f32x4*)(sk + k0 + 8 * c + 4); }
#pragma unroll
    for (int j = 0; j < 4; ++j) { const int n = (lane >> 3) + 8 * j; const LAS float* s = scr + (8 * c) * 33 + n; const float sc = cst * (sn ? sn[n0 + n] : 1.f);
        u32x4 o; o.x = cvtpk(s[0 * 33] * sc * ka[0], s[1 * 33] * sc * ka[1]); o.y = cvtpk(s[2 * 33] * sc * ka[2], s[3 * 33] * sc * ka[3]); o.z = cvtpk(s[4 * 33] * sc * kb[0], s[5 * 33] * sc * kb[1]); o.w = cvtpk(s[6 * 33] * sc * kb[2], s[7 * 33] * sc * kb[3]);
        *(u32x4*)(WT + (size_t)(drow0 + n) * ldk + k0 + 8 * c) = o; }
    asm volatile("s_waitcnt lgkmcnt(0)" ::: "memory");
}
struct WJob { const float* W; int K, N; bf16_t* dst; const float* sk; const float* sn; int half; float cst; int qcols; };
__device__ __forceinline__ WJob wjob(const P& p, int id) {
    bf16_t* Wb = (bf16_t*)(p.ws + OFF_W); WJob j; j.sk = nullptr; j.sn = nullptr; j.half = 0; j.cst = 1.f; j.qcols = 1 << 30;
    if (id < 8) { const int jj = id >> 2, g = id & 3; j.W = p.in[3] + (size_t)id * 65536; j.K = 256; j.N = 256; j.dst = Wb + W_PW + (size_t)id * 65536; j.sk = p.in[2] + (jj * 3) * D + g * 256; j.sn = p.in[4] + jj * D + g * 256; }
    else if (id == 8) { j.W = p.in[5]; j.K = D; j.N = 3 * D; j.dst = Wb + W_QKV; j.sk = p.in[2] + 1 * D; j.cst = 0.125f * LOG2E; j.qcols = D; }
    else if (id == 9) { j.W = p.in[6]; j.K = D; j.N = D; j.dst = Wb + W_SO; }
    else if (id == 10) { j.W = p.in[15]; j.K = D; j.N = 2 * D; j.dst = Wb + W_GLU; j.half = D; }
    else { const int i = (id - 11) / 5, w = (id - 11) % 5; bf16_t* L = Wb + W_L0 + (size_t)i * W_LSTRIDE;
        if (w == 0) { j.W = p.in[18] + (size_t)i * D * D; j.K = D; j.N = D; j.dst = L + WL_Q; j.sk = p.in[16] + i * D; j.cst = 0.0625f * LOG2E; }
        else if (w == 1) { j.W = p.in[19] + (size_t)i * D * 2 * D; j.K = D; j.N = 2 * D; j.dst = L + WL_KV; j.sk = p.in[17] + i * D; }
        else if (w == 2) { j.W = p.in[20] + (size_t)i * D * D; j.K = D; j.N = D; j.dst = L + WL_O; }
        else if (w == 3) { j.W = p.in[22] + (size_t)i * D * 2 * FF; j.K = D; j.N = 2 * FF; j.dst = L + WL_UP; j.sk = p.in[21] + i * D; j.half = FF; }
        else { j.W = p.in[25] + (size_t)i * FF * D; j.K = FF; j.N = D; j.dst = L + WL_DN; } }
    return j;
}
constexpr int N_WJOBS = 31;
__device__ __forceinline__ int wjob_items(int id) {
    if (id < 8) return 4 * 8; if (id == 8) return 16 * 96; if (id == 9) return 16 * 32; if (id == 10) return 16 * 64;
    const int w = (id - 11) % 5; return w == 0 ? 0   : w == 1 ? 16 * 64 : w == 2 ? 16 * 32 : w == 3 ? 16 * 176 : 44 * 32;
}
__device__ __forceinline__ void row_to_bf16(const float* xrow, bf16_t* orow, float* sq, float* copy, int lane) {
    const f32x4* xr = (const f32x4*)xrow + lane; f32x4 v[4]; float s = 0.f;
#pragma unroll
    for (int j = 0; j < 4; ++j) { v[j] = xr[64 * j]; s += (v[j][0] * v[j][0] + v[j][1] * v[j][1]) + (v[j][2] * v[j][2] + v[j][3] * v[j][3]); }
    s = wave_sum(s, lane); if (lane < RSN) sq[lane] = lane == 0 ? s : 0.f;
#pragma unroll
    for (int j = 0; j < 4; ++j) { if (orow) { u32x2 w; w.x = cvtpk(v[j][0], v[j][1]); w.y = cvtpk(v[j][2], v[j][3]); *((u32x2*)orow + lane + 64 * j) = w; } if (copy) *((f32x4*)copy + lane + 64 * j) = v[j]; }
}
__device__ __forceinline__ void s5_items(const P& p, LAS float* sl, int wv) {
    const int tid = otid(wv); bf16_t* WB = (bf16_t*)(p.ws + OFF_S5WB); bf16_t* TW = (bf16_t*)(p.ws + OFF_S5TW);
    const float* a_re = p.in[7]; const float* a_im = p.in[8]; const float* ldt = p.in[9]; const float* b_re = p.in[10]; const float* b_im = p.in[11]; const float* c_re = p.in[12]; const float* c_im = p.in[13];
    LAS float* sCr = sl; LAS float* sCi = sl + 1024; LAS float* sBr = sl + 2048; LAS float* sBi = sl + 3072;
    LAS float* pwr = sl + 4096; LAS float* pwi = pwr + 17 * 64; LAS float* wfr = pwi + 17 * 64; LAS float* wfi = wfr + 17 * 64;
    for (int task = blockIdx.x; task < 256; task += gridDim.x) {
        const int g = task >> 2, part = task & 3;
        __syncthreads();
        for (int q = tid; q < 1024; q += 512) { sCr[q] = c_re[g * 1024 + q]; sCi[q] = c_im[g * 1024 + q]; sBr[q] = b_re[g * 1024 + q]; sBi[q] = b_im[g * 1024 + q]; }
        if (tid < 64) { const int pp = tid; const float lr = a_re[g * 64 + pp], li = a_im[g * 64 + pp], dt = expf(ldt[g]); const float xr = lr * dt, xi = li * dt;
            float s1, c1; sincosf(xi, &s1, &c1); const float ex = expf(xr); const float ar = ex * c1, ai = ex * s1;
            const float sh = sinf(0.5f * xi); const float nr = expm1f(xr) * c1 - 2.f * sh * sh, ni = ex * s1; const float den = lr * lr + li * li;
            const float fr_ = (nr * lr + ni * li) / den, fi_ = (ni * lr - nr * li) / den;
            float cr = 1.f, ci = 0.f;
            for (int e = 0; e <= 16; ++e) { pwr[e * 64 + pp] = cr; pwi[e * 64 + pp] = ci; wfr[e * 64 + pp] = cr * fr_ - ci * fi_; wfi[e * 64 + pp] = cr * fi_ + ci * fr_;
                const float tr = cr * ar - ci * ai, ti = cr * ai + ci * ar; cr = tr; ci = ti; } }
        __syncthreads();
        const int r0 = part * 16, r1 = (part == 3) ? 63 : r0 + 16;
        for (int r = r0; r < r1; ++r) {
            if (r < 31) {
                const int l = r - 15;
                if (tid < 256) { const int i = tid >> 4, j = tid & 15; float val = 0.f;
                    if (l >= 0) { for (int pp = 0; pp < 64; ++pp) { const float cr = sCr[i * 64 + pp], ci = sCi[i * 64 + pp], br = sBr[pp * 16 + j], bi = sBi[pp * 16 + j];
                            const float wr_ = wfr[l * 64 + pp], wi_ = wfi[l * 64 + pp]; val += (cr * wr_ - ci * wi_) * br - (cr * wi_ + ci * wr_) * bi; } }
                    const bf16_t bv = (bf16_t)(cvtpk(val, 0.f) & 0xffffu);
                    for (int t = 0; t < 16; ++t) { const int s = t - l; if (s >= 0 && s < 16) TW[((size_t)g * 256 + t * 16 + i) * 384 + s * 16 + j] = bv; } }
            } else if (r < 47) {
                const int s = r - 31, e = 15 - s;
                for (int q4 = tid; q4 < 2048; q4 += 512) { const int q = q4 >> 4, j = q4 & 15, pp = q >> 1, im = q & 1; const float br = sBr[pp * 16 + j], bi = sBi[pp * 16 + j]; const float wr_ = wfr[e * 64 + pp], wi_ = wfi[e * 64 + pp];
                    const float val = im ? (wr_ * bi + wi_ * br) : (wr_ * br - wi_ * bi);
                    WB[((size_t)g * 256 + q) * 256 + s * 16 + j] = (bf16_t)(cvtpk(val, 0.f) & 0xffffu); WB[((size_t)g * 256 + 128 + q) * 256 + s * 16 + j] = 0; }
            } else {
                const int t = r - 47, e = t + 1;
                for (int q4 = tid; q4 < 2048; q4 += 512) { const int i = q4 >> 7, q = q4 & 127, pp = q >> 1, im = q & 1; const float cr = sCr[i * 64 + pp], ci = sCi[i * 64 + pp]; const float wr_ = pwr[e * 64 + pp], wi_ = pwi[e * 64 + pp];
                    const float val = im ? -(cr * wi_ + ci * wr_) : (cr * wr_ - ci * wi_);
                    TW[((size_t)g * 256 + t * 16 + i) * 384 + 256 + q] = (bf16_t)(cvtpk(val, 0.f) & 0xffffu); }
            }
        }
    }
    __syncthreads();
}
__device__ __forceinline__ void prologue(const P& p, LAS unsigned char* lds, int wv) {
    const int tid = otid(wv), lane = tid & 63, wave = tid >> 6; const int gw = blockIdx.x * 8 + wave, NGW = gridDim.x * 8;
    float* RS = MK_LO ? (float*)(p.ws + OFF_RS) : p.out;
    if (blockIdx.x & 1) { s5_items(p, (LAS float*)lds, wv); __syncthreads(); }
    if (RSN == 1) for (size_t i = (size_t)blockIdx.x * 512 + tid; i < (size_t)12 * T / 4; i += (size_t)gridDim.x * 512) ((f32x4*)(RS + T))[i] = (f32x4){0.f, 0.f, 0.f, 0.f};
    bf16_t* HB = (bf16_t*)(p.ws + OFF_HB);
    for (int m = gw; m < T; m += NGW) row_to_bf16(p.in[0] + (size_t)m * D, MK_LO ? nullptr : HB + (size_t)m * D, RS + (size_t)m * RSN, nullptr, lane);
    bf16_t* MB = (bf16_t*)(p.ws + OFF_MEMB);
    for (int m = gw; m < 1024; m += NGW) row_to_bf16(p.in[1] + (size_t)m * D, MB + (size_t)m * D, RS + ((size_t)13 * T + m) * RSN, nullptr, lane);
    LAS float* scr = (LAS float*)(lds + wave * 16384);
    int total = 0;
    for (int id = 0; id < N_WJOBS; ++id) total += wjob_items(id);
    for (int it = gw; it < total; it += NGW) {
        int r = it, id = 0; for (;; ++id) { const int c = wjob_items(id); if (r < c) break; r -= c; }
        const WJob j = wjob(p, id); const int nblk = j.N / 32, kb = r / nblk, nb = r % nblk, k0 = 64 * kb, n0 = 32 * nb;
        int drow0 = n0; if (j.half) { const int hf = n0 / j.half, f = n0 % j.half; drow0 = (f / 128) * 256 + hf * 128 + (f % 128); }
        transpose_item(j.W, j.N, k0, n0, j.dst, j.K, drow0, j.sk, j.sn, n0 < j.qcols ? j.cst : 1.f, scr, lane);
    }
    { bf16_t* WQP = (bf16_t*)(p.ws + OFF_WQP);
      for (size_t idx = (size_t)blockIdx.x * 512 + tid; idx < (size_t)4 * D * D / 8; idx += (size_t)gridDim.x * 512) { const size_t e0 = idx * 8; const int i = (int)(e0 >> 20), k = (int)(e0 >> 10) & 1023;
          const float sc = p.in[16][i * D + k] * (0.0625f * LOG2E); const f32x4 x0 = *(const f32x4*)(p.in[18] + e0), x1 = *(const f32x4*)(p.in[18] + e0 + 4);
          u32x4 w; w.x = cvtpk(x0[0] * sc, x0[1] * sc); w.y = cvtpk(x0[2] * sc, x0[3] * sc); w.z = cvtpk(x1[0] * sc, x1[1] * sc); w.w = cvtpk(x1[2] * sc, x1[3] * sc); *(u32x4*)(WQP + e0) = w; } }
    __syncthreads();
    if (!(blockIdx.x & 1)) s5_items(p, (LAS float*)lds, wv);
}
__device__ __forceinline__ void ld8(const float* h32, const bf16_t* hi, const bf16_t* lo, size_t off, f32x4& a, f32x4& b) {
    if (h32) { a = *(const f32x4*)(h32 + off); b = *(const f32x4*)(h32 + off + 4); } else load_hilo8(hi, lo, off, a, b); }
__device__ __forceinline__ void pool_prep(const float* h32, const bf16_t* hi, const bf16_t* lo, const float* rsq, bf16_t* ph, int wv) {
    for (size_t idx = (size_t)blockIdx.x * 512 + otid(wv); idx < (size_t)(T / 16) * 128; idx += (size_t)gridDim.x * 512) {
        const int tok0 = (int)(idx >> 7) * 16, c = ((int)idx & 127) * 8; const int win = 2 << (c >> 8); const int tib0 = tok0 & (SEQ - 1);
        f32x4 sa = (f32x4){0.f, 0.f, 0.f, 0.f}, sb = sa;
        for (int k = win - 1; k >= 1; --k) if (tib0 - k >= 0) { const float r = rs_of(rsq, tok0 - k); f32x4 xa, xb; ld8(h32, hi, lo, (size_t)(tok0 - k) * D + c, xa, xb); sa = sa + xa * r; sb = sb + xb * r; }
#pragma unroll
        for (int t = 0; t < 16; ++t) { const int row = tok0 + t; const float r = rs_of(rsq, row); f32x4 xa, xb; ld8(h32, hi, lo, (size_t)row * D + c, xa, xb); xa = xa * r; xb = xb * r; sa = sa + xa; sb = sb + xb;
            const int cnt = min(tib0 + t + 1, win); const float ic = 1.f / (float)cnt; const f32x4 oa = sa * ic - xa, ob = sb * ic - xb;
            u32x4 w; w.x = cvtpk(oa[0], oa[1]); w.y = cvtpk(oa[2], oa[3]); w.z = cvtpk(ob[0], ob[1]); w.w = cvtpk(ob[2], ob[3]);
            *(u32x4*)(ph + (size_t)row * D + c) = w;
            const int ro = tib0 + t - (win - 1);
            if (ro >= 0) { const float r2 = rs_of(rsq, row - (win - 1)); f32x4 ya, yb; ld8(h32, hi, lo, (size_t)(row - (win - 1)) * D + c, ya, yb); sa = sa - ya * r2; sb = sb - yb * r2; } }
    }
}
__device__ __forceinline__ void s5_zfill(const bf16_t* hi, const bf16_t* lo, const float* rsq, const float* gain, bf16_t* Z, int wv) {
    for (size_t idx = (size_t)blockIdx.x * 512 + otid(wv); idx < (size_t)T * 128; idx += (size_t)gridDim.x * 512) {
        const int tok = (int)(idx >> 7), c = ((int)idx & 127) * 8; const float r = rs_of(rsq, tok);
        f32x4 a, b; load_hilo8(hi, lo, (size_t)tok * D + c, a, b); const f32x4 ga = *(const f32x4*)(gain + c), gb = *(const f32x4*)(gain + c + 4);
        u32x4 w; w.x = cvtpk(a[0] * r * ga[0], a[1] * r * ga[1]); w.y = cvtpk(a[2] * r * ga[2], a[3] * r * ga[3]); w.z = cvtpk(b[0] * r * gb[0], b[1] * r * gb[1]); w.w = cvtpk(b[2] * r * gb[2], b[3] * r * gb[3]);
        const int g = c >> 4, n = tok >> 4, t = tok & 15;
        *(u32x4*)(Z + ((size_t)g * 1024 + n) * 384 + t * 16 + (c & 15)) = w;
    }
}
__device__ __forceinline__ void s5_scan(const P& p, const float* Sst, bf16_t* Z, int j5, int wv) {
    const int tid = otid(wv); const int lane = tid & 63, wave = tid >> 6; const int gw = blockIdx.x * 8 + wave, NGW = gridDim.x * 8;
    for (int task = gw; task < 256; task += NGW) {
        const int b = task >> 6, g = task & 63;
        const float lr = p.in[7][j5 * 4096 + g * 64 + lane], li = p.in[8][j5 * 4096 + g * 64 + lane], dt = expf(p.in[9][j5 * 64 + g]);
        const float mg = expf(16.f * lr * dt); float sn, cs; sincosf(16.f * li * dt, &sn, &cs); const float ar = mg * cs, ai = mg * sn;
        float xr = 0.f, xi = 0.f;
        for (int n0 = 0; n0 < 256; n0 += 16) {
            f32x2 sv[16];
#pragma unroll
            for (int k = 0; k < 16; ++k) sv[k] = *(const f32x2*)(Sst + ((size_t)g * 1024 + b * 256 + n0 + k) * 128 + 2 * lane);
#pragma unroll
            for (int k = 0; k < 16; ++k) { *(unsigned*)(Z + ((size_t)g * 1024 + b * 256 + n0 + k) * 384 + 256 + 2 * lane) = cvtpk(xr, xi);
                const float nr = ar * xr - ai * xi + sv[k][0], ni = ar * xi + ai * xr + sv[k][1]; xr = nr; xi = ni; }
        }
    }
}
__device__ __forceinline__ void sync_state(const float* h, bf16_t* HB, float* rsq, int wv) {
    const int tid = otid(wv); const int lane = tid & 63, wave = tid >> 6; const int gw = blockIdx.x * 8 + wave, NGW = gridDim.x * 8;
    for (int m = gw; m < T; m += NGW) row_to_bf16(h + (size_t)m * D, HB + (size_t)m * D, rsq + m, nullptr, lane);
}

#define MFMA32(a, b, c) __builtin_amdgcn_mfma_f32_32x32x16_bf16((a), (b), (c), 0, 0, 0)
__device__ __forceinline__ void sb_attn(const bf16_t* QK, const bf16_t* VT, bf16_t* O, int opitch, int wv) {
    const int tid = otid(wv); const int lane = tid & 63, wave = tid >> 6; const int n = lane & 31, half = lane >> 5;
    const int gw = blockIdx.x * 8 + wave, NGW = gridDim.x * 8;
    for (int task = gw; task < 8192; task += NGW) {
        const int qt = 127 - (task >> 6), bh = task & 63, b = bh >> 4, h = bh & 15;
        const int tok0 = b * SEQ + qt * 32;
        bf16x8 qf[4];
#pragma unroll
        for (int kk = 0; kk < 4; ++kk) qf[kk] = *(const bf16x8*)(QK + (size_t)(tok0 + n) * 2048 + h * 64 + 16 * kk + 8 * half);
        f32x16 o0, o1;
#pragma unroll
        for (int i = 0; i < 16; ++i) { o0[i] = 0.f; o1[i] = 0.f; }
        float R = 0.f;
        for (int kt = qt; kt >= 0; --kt) {
            const int key0 = b * SEQ + kt * 32;
            bf16x8 kf[4];
#pragma unroll
            for (int kk = 0; kk < 4; ++kk) kf[kk] = *(const bf16x8*)(QK + (size_t)(key0 + n) * 2048 + 1024 + h * 64 + 16 * kk + 8 * half);
            u32x2 vlo[2][2], vhi[2][2];
#pragma unroll
            for (int dd = 0; dd < 2; ++dd)
#pragma unroll
                for (int s = 0; s < 2; ++s) { const bf16_t* vp = VT + (size_t)(h * 64 + 32 * dd + n) * T + key0 + 16 * s + 4 * half; vlo[dd][s] = *(const u32x2*)vp; vhi[dd][s] = *(const u32x2*)(vp + 8); }
            f32x16 sa;
#pragma unroll
            for (int i = 0; i < 16; ++i) sa[i] = 0.f;
#pragma unroll
            for (int kk = 0; kk < 4; ++kk) sa = MFMA32(kf[kk], qf[kk], sa);
            const bool diag = (kt == qt);
            float Lv[16], go[4], gp[4];
#pragma unroll
            for (int r = 0; r < 16; ++r) { const float w = sa[r]; const int m = (r & 3) + 8 * (r >> 2) + 4 * half; const bool valid = !diag || (m < n);
                const float sp = fmaxf(w, 0.f) + fast_log2(1.f + fast_exp2(-fabsf(w))); Lv[r] = valid ? -sp : 0.f; sa[r] = valid ? w : -1.0e30f; }
#pragma unroll
            for (int j = 0; j < 4; ++j) { go[j] = (Lv[4 * j] + Lv[4 * j + 1]) + (Lv[4 * j + 2] + Lv[4 * j + 3]); gp[j] = shx(go[j], 32, lane); }
            float G[4]; G[3] = 0.f; G[2] = go[3] + gp[3]; G[1] = G[2] + (go[2] + gp[2]); G[0] = G[1] + (go[1] + gp[1]); const float tot = G[0] + (go[0] + gp[0]);
            float av[16];
#pragma unroll
            for (int j = 0; j < 4; ++j) { const float bs = R + G[j] + (half == 0 ? gp[j] : 0.f);
                const float s3 = 0.f, s2 = Lv[4 * j + 3], s1 = s2 + Lv[4 * j + 2], s0 = s1 + Lv[4 * j + 1];
                av[4 * j + 0] = fast_exp2(sa[4 * j + 0] + Lv[4 * j + 0] + bs + s0); av[4 * j + 1] = fast_exp2(sa[4 * j + 1] + Lv[4 * j + 1] + bs + s1);
                av[4 * j + 2] = fast_exp2(sa[4 * j + 2] + Lv[4 * j + 2] + bs + s2); av[4 * j + 3] = fast_exp2(sa[4 * j + 3] + Lv[4 * j + 3] + bs + s3); }
            R += tot;
#pragma unroll
            for (int s = 0; s < 2; ++s) { u32x4 pk; pk.x = cvtpk(av[8 * s + 0], av[8 * s + 1]); pk.y = cvtpk(av[8 * s + 2], av[8 * s + 3]); pk.z = cvtpk(av[8 * s + 4], av[8 * s + 5]); pk.w = cvtpk(av[8 * s + 6], av[8 * s + 7]);
                const bf16x8 pf = __builtin_bit_cast(bf16x8, pk);
                u32x4 v0; v0.x = vlo[0][s].x; v0.y = vlo[0][s].y; v0.z = vhi[0][s].x; v0.w = vhi[0][s].y; u32x4 v1; v1.x = vlo[1][s].x; v1.y = vlo[1][s].y; v1.z = vhi[1][s].x; v1.w = vhi[1][s].y;
                o0 = MFMA32(__builtin_bit_cast(bf16x8, v0), pf, o0); o1 = MFMA32(__builtin_bit_cast(bf16x8, v1), pf, o1); }
            if (__ballot(R >= -150.f) == 0ull) break;
        }
#pragma unroll
        for (int j = 0; j < 4; ++j) { u32x2 w0, w1; w0.x = cvtpk(o0[4 * j], o0[4 * j + 1]); w0.y = cvtpk(o0[4 * j + 2], o0[4 * j + 3]); w1.x = cvtpk(o1[4 * j], o1[4 * j + 1]); w1.y = cvtpk(o1[4 * j + 2], o1[4 * j + 3]);
            bf16_t* op = O + (size_t)(tok0 + n) * opitch + h * 64 + 8 * j + 4 * half; *(u32x2*)op = w0; *(u32x2*)(op + 32) = w1; }
    }
}

__global__ void __launch_bounds__(512, 2) mega(P p) {
    extern __shared__ __attribute__((aligned(16))) unsigned char lds_raw[];
    LAS unsigned char* lds = (LAS unsigned char*)lds_raw;
    LAS float* xl = (LAS float*)(lds + XLDS_OFF);
    cg::grid_group grid = cg::this_grid();
    const int wv = __builtin_amdgcn_readfirstlane((int)threadIdx.x >> 6);
    unsigned char* ws = p.ws;
    float* RS = MK_LO ? (float*)(ws + OFF_RS) : p.out; const float* MSQ = RS + (size_t)13 * T * RSN;
    bf16_t* Wb = (bf16_t*)(ws + OFF_W); bf16_t* HB = (bf16_t*)(ws + OFF_HB); bf16_t* MB = (bf16_t*)(ws + OFF_MEMB);
    bf16_t* KVm = (bf16_t*)(ws + OFF_KV); bf16_t* MT = (bf16_t*)(ws + OFF_MT); bf16_t* NT = (bf16_t*)(ws + OFF_NT);
    unsigned char* scr = ws + OFF_SCR;
    bf16_t* LO = (bf16_t*)p.out;
    unsigned* CNT = (unsigned*)ws + 8192;
    int ph = 0;
#define PH_BEGIN if (ph >= p.lo && ph < p.hi) {
#ifndef DUP
#define DUP 0
#endif
#if HYBRID
#define GRID_SYNC() grid.sync()
#else
    if (otid(wv) == 0) { ((volatile LAS unsigned*)(lds + XLDS_OFF + 12288))[0] = 0u; ((volatile LAS unsigned*)(lds + XLDS_OFF + 12288))[1] = 0u; }
    __syncthreads();
    (void)xcd_barrier_post((unsigned*)p.ws + 1024, (volatile LAS unsigned*)(lds + XLDS_OFF + 12288));
    if (p.lo < 0) grid.sync();
#define GRID_SYNC() do { XcdBarrier xb_; xb_.bar = (unsigned*)p.ws + 1024; xb_.x = xb_xcc_id(); xb_.st = (volatile LAS unsigned*)(lds + XLDS_OFF + 12288); xcd_barrier(xb_); } while (0)
#endif
#define PH_END_NOSYNC } ++ph;
#define PH_END } ++ph; if (ph > p.lo && ph < p.hi) { GRID_SYNC(); if (DUP == 3) GRID_SYNC(); }

    PH_BEGIN prologue(p, lds, wv); if (DUP == 2) { __syncthreads(); prologue(p, lds, wv); } PH_END
    PH_BEGIN
        Sched S; S.done_cnt = nullptr; S.wait_cnt = nullptr; S.wait_target = 0; S.done_kind = 0; S.wait_kind = 0; S.kind = 2; S.nM = 128; S.nN = 1; S.nwg = 128; S.G = gridDim.x; S.c = blockIdx.x; S.bdiv = 1; S.A = (const char*)MB; S.B = (const char*)(Wb + W_L0 + WL_KV);
        S.a_pm = S.a_pn = S.a_pb = S.b_pm = S.b_pn = 0; S.b_pb = (long)W_LSTRIDE * 2;
        EpiKV E{KVm, MSQ}; gemm_phase(lds, GemmDesc{D, D, D}, S, E, wv);
        pool_prep(MK_LO ? p.in[0] : nullptr, HB, LO, RS, (bf16_t*)scr, wv);
    PH_END
    PH_BEGIN
        { Sched S; S.done_cnt = nullptr; S.wait_cnt = nullptr; S.wait_target = 0; S.done_kind = 0; S.wait_kind = 0; S.kind = 3; S.nM = 256; S.nN = 1; S.nwg = 256; S.G = gridDim.x; S.c = blockIdx.x; S.bdiv = 1; S.A = (const char*)KVm; S.B = (const char*)(ws + OFF_WQP);
          S.a_pm = S.a_pn = S.b_pm = S.b_pn = 0; S.a_pb = 1024L * 2048 * 2; S.b_pb = 1024L * 1024 * 2;
          EpiMN<0> E{MT}; gemm_phase(lds, GemmDesc{2048, D, 256}, S, E, wv); }
        { Sched S; S.done_cnt = nullptr; S.wait_cnt = nullptr; S.wait_target = 0; S.done_kind = 0; S.wait_kind = 0; S.kind = 4; S.nM = 256; S.nN = 1; S.nwg = 256; S.G = gridDim.x; S.c = blockIdx.x; S.bdiv = 1; S.A = (const char*)(Wb + W_L0 + WL_O); S.B = (const char*)KVm;
          S.a_pm = S.a_pn = S.b_pm = S.b_pn = 0; S.a_pb = (long)W_LSTRIDE * 2; S.b_pb = 1024L * 2048 * 2;
          EpiMN<1> E{NT}; gemm_phase(lds, GemmDesc{D, 2048, 256}, S, E, wv); }
        { Sched S = make_sched(64, 4, (bf16_t*)scr, 256L * D * 2, 256 * 2, Wb + W_PW, 0, 65536L * 2);
          EpiRes<0> E{MK_LO ? p.in[0] : nullptr, HB, LO, RS + (size_t)1 * T * RSN, xl}; gemm_phase(lds, GemmDesc{D, 256, 256}, S, E, wv); }
    PH_END
    for (int i = 0; i < 4; ++i) {
        const int kind = i % 3, j = i / 3; bf16_t* WL = Wb + W_L0 + (size_t)i * W_LSTRIDE;
        float* rs_mix = RS + (size_t)(3 * i) * T * RSN; float* rs_xa = RS + (size_t)(3 * i + 1) * T * RSN; float* rs_ffn = RS + (size_t)(3 * i + 2) * T * RSN; float* rs_next = RS + (size_t)(3 * i + 3) * T * RSN;
        if (kind == 0) {
            bf16_t* PH = (bf16_t*)scr;
            const float* hin = (i == 0) ? p.in[0] : nullptr;
            if (i != 0) {
            PH_BEGIN pool_prep(hin, HB, LO, rs_mix, PH, wv); PH_END
            PH_BEGIN
                Sched S = make_sched(64, 4, PH, 256L * D * 2, 256 * 2, Wb + W_PW + (size_t)j * 4 * 65536, 0, 65536L * 2);
                EpiRes<0> E{hin, HB, LO, rs_xa, xl}; gemm_phase(lds, GemmDesc{D, 256, 256}, S, E, wv);
            PH_END
            }
        } else if (kind == 1) {
            bf16_t* QK = (bf16_t*)scr; bf16_t* VT = (bf16_t*)(scr + 64 * MiB);
            PH_BEGIN
                { Sched S = make_sched(64, 8, HB, 256L * D * 2, 0, Wb + W_QKV, 0, 256L * D * 2); EpiBf E{QK, 2048, 256L * 2048, 256, rs_mix, nullptr}; gemm_phase(lds, GemmDesc{D, D, D}, S, E, wv); }
                { Sched S = make_sched(4, 64, Wb + W_QKV + (size_t)2048 * D, 256L * D * 2, 0, HB, 0, 256L * D * 2); EpiBf E{VT, T, 256L * T, 256, nullptr, rs_mix}; gemm_phase(lds, GemmDesc{D, D, D}, S, E, wv); }
            PH_END
            PH_BEGIN sb_attn(QK, VT, QK, 2048, wv); PH_END
            PH_BEGIN
                Sched S = make_sched(64, 4, QK, 256L * 2048 * 2, 0, Wb + W_SO, 0, 256L * D * 2);
                EpiRes<0> E{nullptr, HB, LO, rs_xa, xl}; gemm_phase(lds, GemmDesc{2048, D, D}, S, E, wv);
            PH_END
        } else {
            bf16_t* Z = (bf16_t*)scr; float* Sst = (float*)(scr + 48 * MiB); bf16_t* Y = (bf16_t*)(scr + 48 * MiB);
            bf16_t* WB5 = (bf16_t*)(ws + OFF_S5WB); bf16_t* TW5 = (bf16_t*)(ws + OFF_S5TW);
            PH_BEGIN s5_zfill(HB, LO, rs_mix, p.in[2] + i * D, Z, wv); if (DUP == 9) s5_zfill(HB, LO, rs_mix, p.in[2] + i * D, Z, wv); PH_END
            PH_BEGIN
                Sched S = make_sched(256, 1, Z, 256L * 384 * 2, 0, WB5, 0, 0, 4, 0, 256L * 256 * 2);
                EpiS5S E{Sst}; gemm_phase(lds, GemmDesc{384, 256, 256}, S, E, wv); if (DUP == 9) gemm_phase(lds, GemmDesc{384, 256, 256}, S, E, wv);
            PH_END
            PH_BEGIN s5_scan(p, Sst, Z, j, wv); if (DUP == 7) s5_scan(p, Sst, Z, j, wv); PH_END
            PH_BEGIN
                Sched S = make_sched(256, 1, Z, 256L * 384 * 2, 0, TW5, 0, 0, 4, 0, 256L * 384 * 2);
                EpiS5Y E{Y, Z, p.in[14] + j * D}; gemm_phase(lds, GemmDesc{384, 384, 384}, S, E, wv); if (DUP == 9) gemm_phase(lds, GemmDesc{384, 384, 384}, S, E, wv);
            PH_END
            PH_BEGIN
                Sched S = make_sched(64, 8, Y, 256L * D * 2, 0, Wb + W_GLU, 0, 256L * D * 2);
                EpiRes<1> E{nullptr, HB, LO, rs_xa, xl}; gemm_phase(lds, GemmDesc{D, D, D}, S, E, wv);
            PH_END
        }
        {
            bf16_t* Pm = (bf16_t*)scr;
            PH_BEGIN
                Sched S = make_sched(64, 4, HB, 256L * D * 2, 0, MT + (size_t)i * 4 * 1024 * 1024, 0, 256L * D * 2, 16, 0, 1024L * 1024 * 2);
                if (!HYBRID) S.done_cnt = CNT + (i * 8 + 0) * 128;
                EpiSoftmax E{Pm, xl, rs_xa}; gemm_phase(lds, GemmDesc{D, D, D}, S, E, wv);
            PH_END_NOSYNC
            PH_BEGIN
                Sched S = make_sched(64, 4, Pm, 256L * D * 2, 0, NT + (size_t)i * 4 * 1024 * 1024, 0, 256L * D * 2, 16, 0, 1024L * 1024 * 2);
                if (!HYBRID) { S.wait_cnt = CNT + (i * 8 + 0) * 128; S.wait_target = 4; }
                EpiRes<0> E{nullptr, HB, LO, rs_ffn, xl}; gemm_phase(lds, GemmDesc{D, D, D}, S, E, wv);
            PH_END
        }
        {
            bf16_t* Gb = (bf16_t*)scr;
            PH_BEGIN
                Sched S; S.done_cnt = nullptr; S.wait_cnt = nullptr; S.wait_target = 0; S.done_kind = 0; S.wait_kind = 0; S.kind = 1; S.nM = 68; S.nN = 22; S.nwg = 68 * 22; S.G = gridDim.x; S.c = blockIdx.x; S.bdiv = 1; S.A = (const char*)HB; S.B = (const char*)(WL + WL_UP);
                S.a_pm = D * 2; S.a_pn = S.a_pb = S.b_pm = S.b_pb = 0; S.b_pn = 256L * D * 2;
                EpiConvGlu E{Gb, rs_ffn, p.in[23] + (size_t)i * 3 * 2 * FF, p.in[24] + (size_t)i * 2 * FF, xl}; gemm_phase(lds, GemmDesc{D, D, D}, S, E, wv); if (DUP == 1) gemm_phase(lds, GemmDesc{D, D, D}, S, E, wv);
            PH_END
            PH_BEGIN
                Sched S = make_sched(64, 4, Gb, 256L * FF * 2, 0, WL + WL_DN, 0, 256L * FF * 2);
                EpiRes<0> E{nullptr, HB, LO, rs_next, xl}; gemm_phase(lds, GemmDesc{FF, FF, FF}, S, E, wv);
            PH_END
        }
    }
    PH_BEGIN
        const int tid = otid(wv), lane = tid & 63, wave = tid >> 6; const int gw = blockIdx.x * 8 + wave, NGW = gridDim.x * 8;
        f32x4 fv[8][4]; float fr_[8];
#pragma unroll
        for (int k = 0; k < 8; ++k) { const int m = gw + k * NGW; float s = 0.f;
#pragma unroll
            for (int j = 0; j < 2; ++j) { if (m < T) load_hilo8(HB, LO, (size_t)m * D + 8 * lane + 512 * j, fv[k][2 * j], fv[k][2 * j + 1]); else { fv[k][2 * j] = (f32x4){0.f, 0.f, 0.f, 0.f}; fv[k][2 * j + 1] = fv[k][2 * j]; } }
#pragma unroll
            for (int j = 0; j < 4; ++j) s += (fv[k][j][0] * fv[k][j][0] + fv[k][j][1] * fv[k][j][1]) + (fv[k][j][2] * fv[k][j][2] + fv[k][j][3] * fv[k][j][3]);
            fr_[k] = rsqrtf(wave_sum(s, lane) * (1.f / D) + EPS); }
        if (MK_LO) GRID_SYNC();
#pragma unroll
        for (int k = 0; k < 8; ++k) { const int m = gw + k * NGW;
            if (m < T) {
#pragma unroll
                for (int j = 0; j < 4; ++j) { const int col = 8 * lane + 512 * (j >> 1) + 4 * (j & 1); const f32x4 gg = *(const f32x4*)(p.in[26] + col); *(f32x4*)(p.out + (size_t)m * D + col) = fv[k][j] * fr_[k] * gg; } } }
        for (int m = gw + 8 * NGW; m < T; m += NGW) { }
    PH_END
#undef PH_BEGIN
#undef PH_END
}
__global__ void __launch_bounds__(512) k_sync_state(const float* h, bf16_t* HB, float* rsq) { sync_state(h, HB, rsq, threadIdx.x >> 6); }
}
#ifndef OPT_MASK
#define OPT_MASK 63
#endif
#ifndef HYBRID
#define HYBRID 0
#endif
static void mega_launch(hipStream_t stream, mk::P p, int lo, int hi, int grid) {
    p.lo = lo; p.hi = hi; void* args[] = {&p};
    hipError_t e = hipLaunchCooperativeKernel((const void*)mk::mega, dim3(grid), dim3(512), args, mk::LDS_BYTES, stream);
    if (e != hipSuccess) fprintf(stderr, "cooperative launch failed: %s (grid %d)\n", hipGetErrorString(e), grid);
}
extern "C" void kernel_launch(void* const* d_in, const int* in_sizes, int n_in, void* d_out, int out_size, void* d_ws, size_t ws_size, hipStream_t stream) {
    static int grid = 0;
    if (grid == 0) {
        if (n_in != 27 || ws_size < mk::WS_NEED) { fprintf(stderr, "kernel_launch: unexpected n_in %d / ws %zu\n", n_in, ws_size); grid = -1; return; }
        int dev = 0, cus = 0, per_cu = 0;
        hipGetDevice(&dev); hipDeviceGetAttribute(&cus, hipDeviceAttributeMultiprocessorCount, dev);
        hipFuncSetAttribute((const void*)mk::mega, hipFuncAttributeMaxDynamicSharedMemorySize, mk::LDS_BYTES);
        hipOccupancyMaxActiveBlocksPerMultiprocessor(&per_cu, (const void*)mk::mega, 512, mk::LDS_BYTES);
        if (per_cu < 1) per_cu = 1;
        (void)hipGetLastError();
        grid = cus * per_cu;
    }
    if (grid < 0) return;
    mk::P p{}; for (int i = 0; i < 27; ++i) p.in[i] = (const float*)d_in[i];
    p.out = (float*)d_out; p.ws = (unsigned char*)d_ws;
#if !HYBRID
    hipMemsetAsync(d_ws, 0, 65536, stream);
    mega_launch(stream, p, 0, 1000, grid);
#else
    nv::In in{}; for (int i = 0; i < 27; ++i) in.p[i] = (const float*)d_in[i];
    float* h = (float*)d_out; float* scr = (float*)((unsigned char*)d_ws + mk::OFF_SCR);
    mega_launch(stream, p, 0, 2, grid);
    int ph = 2;
    for (int i = 0; i < 4; ++i) {
        const int kind = i % 3; const int nmix = kind == 0 ? 2 : kind == 1 ? 3 : 5;
        for (int sub = 0; sub < 3; ++sub) {
            const int np = sub == 0 ? nmix : sub == 1 ? 4 : 2; const int bit = sub == 0 ? kind : sub == 1 ? 3 : 4;
            if ((OPT_MASK >> bit) & 1) {
                mk::k_sync_state<<<256, 512, 0, stream>>>(h, (mk::bf16_t*)((unsigned char*)d_ws + mk::OFF_HB), (float*)((unsigned char*)d_ws + mk::OFF_RS) + (size_t)(3 * i + sub) * mk::T);
                mega_launch(stream, p, ph, ph + np, grid);
            } else nv::sublayer(stream, in, h, scr, i, sub);
            ph += np;
        }
    }
    if ((OPT_MASK >> 5) & 1) mega_launch(stream, p, 38, 39, grid); else nv::final_norm(stream, in, h);
#endif
}
```

```cpp
#include <hip/hip_runtime.h>
#include <hip/hip_cooperative_groups.h>
#include <cstdio>
#include <cstdint>
namespace cg = cooperative_groups;
#define HYBRID 0
#define OPT_MASK 63
#define DUP 0
#define SEAMS 1
#define MK_SP2 1
#define MK_BAUX 0
#define MK_AAUX 0
#define MK_LO 0
namespace mk {
#define LAS __attribute__((address_space(3)))
typedef unsigned short bf16_t;
typedef short bf16x8 __attribute__((ext_vector_type(8)));
typedef float f32x4 __attribute__((ext_vector_type(4)));
typedef float f32x16 __attribute__((ext_vector_type(16)));
typedef float f32x2 __attribute__((ext_vector_type(2)));
typedef unsigned u32x4 __attribute__((ext_vector_type(4)));
typedef unsigned u32x2 __attribute__((ext_vector_type(2)));
typedef __bf16 bf16x2_t __attribute__((ext_vector_type(2)));
constexpr int T = 16384, D = 1024, SEQ = 4096, FF = 2816, NB = 4;
constexpr float EPS = 1e-6f, LOG2E = 1.4426950408889634f;
constexpr int BM = 256, BK = 64, HALF = 128, HTB = HALF * BK * 2, STAGE_BYTES = 8 * HTB, NXCD = 8, WGM = 8;
constexpr int XLDS_OFF = STAGE_BYTES;
constexpr int LDS_BYTES = 147456;

__device__ __forceinline__ unsigned cvtpk(float lo, float hi) { f32x2 v = {lo, hi}; bf16x2_t b = __builtin_convertvector(v, bf16x2_t); return __builtin_bit_cast(unsigned, b); }
__device__ __forceinline__ float bf2f(bf16_t b) { return __builtin_bit_cast(float, (unsigned)b << 16); }
__device__ __forceinline__ float fast_exp2(float x) { return __builtin_amdgcn_exp2f(x); }
__device__ __forceinline__ float fast_log2(float x) { return __builtin_amdgcn_logf(x); }
__device__ __forceinline__ float fast_rcp(float x) { return __builtin_amdgcn_rcpf(x); }
__device__ __forceinline__ float sigmoidf_(float x) { return fast_rcp(1.f + fast_exp2(-x * LOG2E)); }
__device__ __forceinline__ int lane_id_v() { int l; asm volatile("v_mbcnt_lo_u32_b32 %0, -1, 0\n\tv_mbcnt_hi_u32_b32 %0, -1, %0" : "=v"(l)); return l; }
__device__ __forceinline__ float shx(float v, int mask, int lane) { return __builtin_bit_cast(float, __builtin_amdgcn_ds_bpermute((lane ^ mask) << 2, __builtin_bit_cast(int, v))); }
__device__ __forceinline__ float wave_sum(float v, int lane) {
#pragma unroll
    for (int o = 1; o < 64; o <<= 1) v += shx(v, o, lane);
    return v;
}
template <int CTRL> __device__ __forceinline__ float dppf(float v) { return __builtin_bit_cast(float, __builtin_amdgcn_update_dpp(0, __builtin_bit_cast(int, v), CTRL, 0xf, 0xf, false)); }

__host__ __device__ __forceinline__ int lds_byte(int r, int c) { const int st = (r >> 4) * 2 + (c >> 5), rr = r & 15, cc = c & 31, ob = rr * 64 + cc * 2; return st * 1024 + (ob ^ (((ob >> 9) & 1) << 5)); }
__host__ __device__ __forceinline__ void stage_rc(int b, int& R, int& C) { const int st = b / 1024, sb = b % 1024, swz = sb ^ (((sb >> 9) & 1) << 5); R = (st >> 1) * 16 + swz / 64; C = (st & 1) * 32 + (swz % 64) / 2; }
__host__ __device__ __forceinline__ int perm_sw(int rho) { const int n = rho >> 4, i = rho & 15, q = i >> 2, j = i & 3; return 16 * n + 8 * (q & 1) + 4 * (q >> 1) + j; }
__host__ __device__ __forceinline__ int perm32(int rho) { const int n = rho >> 4, i = rho & 15; return 8 * (i >> 2) + 4 * n + (i & 3); }

struct Unit { int pm, pn; };
struct GemmDesc { int lda, ldb, K; };

struct Sched {
    int kind, nM, nN, nwg, G, c, bdiv;
    const char* A; const char* B;
    long a_pm, a_pn, a_pb, b_pm, b_pn, b_pb;
    unsigned* done_cnt; unsigned* wait_cnt; int wait_target, done_kind, wait_kind;
    __device__ __forceinline__ void wait_one(unsigned* w) const {
        unsigned sp = 0; while (__builtin_amdgcn_readfirstlane(__hip_atomic_load(w, __ATOMIC_RELAXED, __HIP_MEMORY_SCOPE_AGENT)) < (unsigned)wait_target) { __builtin_amdgcn_s_sleep(2); if (++sp > (1u << 20)) break; }
    }
    __device__ __forceinline__ void a_ready(const Unit& u, int wid) const {
        if (!wait_cnt) return;
        if (wid == 0) {
            if (wait_kind == 0) wait_one(wait_cnt + u.pm);
            __builtin_amdgcn_fence(__ATOMIC_ACQUIRE, "agent"); asm volatile("s_waitcnt vmcnt(0)" ::: "memory");
        }
        __builtin_amdgcn_s_barrier(); asm volatile("" ::: "memory");
    }
    __device__ __forceinline__ void done(const Unit& u, int wid, int lane) const {
        if (!done_cnt) return;
        asm volatile("s_waitcnt vmcnt(0)" ::: "memory"); __builtin_amdgcn_s_barrier(); asm volatile("" ::: "memory");
        if (wid == 0 && lane == 0) { __builtin_amdgcn_fence(__ATOMIC_RELEASE, "agent"); asm volatile("s_waitcnt vmcnt(0)" ::: "memory");
            __hip_atomic_fetch_add(done_cnt + u.pm, 1u, __ATOMIC_RELAXED, __HIP_MEMORY_SCOPE_AGENT); }
    }
    __device__ __forceinline__ bool next(int i, Unit& u) const {
        const long L = (long)i * G + c; if (L >= nwg) return false;
        int wgid = (int)L;
        if (kind >= 2) { u.pm = wgid; u.pn = 0; return true; }
        { const int q = nwg / NXCD, r = nwg % NXCD, xcd = wgid % NXCD, off = wgid / NXCD; wgid = (xcd < r ? xcd * (q + 1) : r * (q + 1) + (xcd - r) * q) + off; }
        const int nig = WGM * nN, gid = wgid / nig, fm = gid * WGM, gsz = (nM - fm) < WGM ? (nM - fm) : WGM;
        u.pm = fm + ((wgid % nig) % gsz); u.pn = (wgid % nig) / gsz; return true;
    }
    __device__ __forceinline__ void base(const Unit& u, const char*& a, const char*& b) const {
        if (kind == 0) { const int pb = u.pm / bdiv; a = A + u.pm * a_pm + u.pn * a_pn + pb * a_pb; b = B + u.pm * b_pm + u.pn * b_pn + pb * b_pb; }
        else if (kind == 1) { const int bt = u.pm / 17, j = u.pm % 17; int o0 = 254 * j; if (o0 > 3842) o0 = 3842; const long start = (long)bt * SEQ + o0 - 2; a = A + start * a_pm; b = B + u.pn * b_pn; }
        else if (kind == 2) { const int L = u.pm, layer = L >> 5, r = L & 31, tm = r >> 3, tn = r & 7;
            a = A + (long)tm * 256 * 2048; b = B + (long)layer * b_pb + (long)tn * 256 * 2048; }
        else if (kind == 3) { const int L = u.pm, layer = L >> 6, r = L & 63, bt = r >> 4, hh = (r >> 2) & 3, kt = r & 3;
            a = A + (long)layer * a_pb + (long)bt * 256 * 4096 + hh * 512; b = B + (long)layer * b_pb + (long)kt * 256 * 2048 + hh * 512; }
        else { const int L = u.pm, layer = L >> 6, r = L & 63, bt = r >> 4, hh = (r >> 2) & 3, nt = r & 3;
            a = A + (long)layer * a_pb + (long)nt * 256 * 2048 + hh * 512; b = B + (long)layer * b_pb + (long)bt * 256 * 4096 + (1024 + hh * 256) * 2; }
    }
};
__device__ __forceinline__ Sched make_sched(int nM, int nN, const void* A, long a_pm, long a_pn, const void* B, long b_pm, long b_pn, int bdiv = 1 << 30, long a_pb = 0, long b_pb = 0) {
    Sched s; s.done_cnt = nullptr; s.wait_cnt = nullptr; s.wait_target = 0; s.done_kind = 0; s.wait_kind = 0; s.kind = 0; s.nM = nM; s.nN = nN; s.nwg = nM * nN; s.G = gridDim.x; s.c = blockIdx.x; s.bdiv = bdiv; s.A = (const char*)A; s.B = (const char*)B;
    s.a_pm = a_pm; s.a_pn = a_pn; s.a_pb = a_pb; s.b_pm = b_pm; s.b_pn = b_pn; s.b_pb = b_pb; return s;
}

template <class Epi>
__device__ __forceinline__ void gemm_phase(LAS unsigned char* lds, const GemmDesc g, const Sched& S, const Epi& E, int wv) {
    int tid_ = wv * 64 + lane_id_v();
    const int tid = tid_, wid = __builtin_amdgcn_readfirstlane(tid >> 6), lane = tid & 63, wr = wid >> 2, wc = wid & 3, fr = lane & 15, fq = lane >> 4;
    const int K = g.K, nt = K / BK;
    unsigned voffA[2], voffB[2];
#pragma unroll
    for (int i = 0; i < 2; ++i) { int R, C; stage_rc(tid * 16 + i * 8192, R, C); const int Rb = (int)Epi::PERM == 2 ? ((R & ~31) + perm_sw(R & 31)) : (int)Epi::PERM == 1 ? ((R & ~31) + perm32(R & 31)) : R;
        voffA[i] = (unsigned)(R * g.lda + C) * 2u; voffB[i] = (unsigned)(Rb * g.ldb + C) * 2u; }
    const size_t kstep = (size_t)(BK * 2);
    const size_t hstepA = (size_t)HALF * g.lda * 2, hstepB = (size_t)HALF * g.ldb * 2;
    const unsigned ldsw = (unsigned)wid * 1024u;
    const int aoff = lds_byte(wr * 64 + fr, fq * 8), boff = lds_byte(wc * 32 + fr, fq * 8);
#define PG8_SA(b, h) (((b) * 2 + (h)) * HTB)
#define PG8_SB(b, h) ((4 + (b) * 2 + (h)) * HTB)
#define PG8_STAGE(bufoff, gbase, voff) do { _Pragma("unroll") for (int _i = 0; _i < 2; ++_i) \
        __builtin_amdgcn_global_load_lds((const unsigned*)((const char*)(gbase) + (voff)[_i]), (LAS unsigned*)(lds + (bufoff) + ldsw + _i * 8192), 16, 0, 0); } while (0)
#define PG8_LDA(dst, b, h) do { _Pragma("unroll") for (int m = 0; m < 4; ++m) _Pragma("unroll") for (int k = 0; k < 2; ++k) dst[m][k] = *(const LAS bf16x8*)(lds + PG8_SA(b, h) + aoff + m * 2048 + k * 1024); } while (0)
#define PG8_LDB(dst, b, h) do { _Pragma("unroll") for (int n = 0; n < 2; ++n) _Pragma("unroll") for (int k = 0; k < 2; ++k) dst[n][k] = *(const LAS bf16x8*)(lds + PG8_SB(b, h) + boff + n * 2048 + k * 1024); } while (0)
#define PG8_MMA(ai, bj, At, Bt) do { __builtin_amdgcn_s_setprio(1); _Pragma("unroll") for (int m = 0; m < 4; ++m) _Pragma("unroll") for (int n = 0; n < 2; ++n) _Pragma("unroll") for (int k = 0; k < 2; ++k) \
        acc[ai][bj][m][n] = __builtin_amdgcn_mfma_f32_16x16x32_bf16(Bt[n][k], At[m][k], acc[ai][bj][m][n], 0, 0, 0); __builtin_amdgcn_s_setprio(0); } while (0)
#define PG8_WAIT_V(n) asm volatile("s_waitcnt vmcnt(" #n ")" ::: "memory")
#define PG8_WAIT_L(n) asm volatile("s_waitcnt lgkmcnt(" #n ")" ::: "memory")
#define PG8_BAR __builtin_amdgcn_s_barrier()
#define PG8_SCHED __builtin_amdgcn_sched_barrier(0)
    Unit cur, nxt; int ui = 0;
    if (!S.next(0, cur)) return;
    f32x4 acc[2][2][4][2];
#pragma unroll
    for (int a = 0; a < 2; ++a)
#pragma unroll
        for (int b = 0; b < 2; ++b)
#pragma unroll
            for (int m = 0; m < 4; ++m)
#pragma unroll
                for (int n = 0; n < 2; ++n) acc[a][b][m][n] = (f32x4){0.f, 0.f, 0.f, 0.f};
    bf16x8 At[4][2], B0[2][2], B1[2][2];
    const char* cA; const char* cB; S.base(cur, cA, cB);
    S.a_ready(cur, wid);
    PG8_STAGE(PG8_SB(0, 0), cB, voffB); PG8_STAGE(PG8_SB(0, 1), cB + hstepB, voffB); PG8_STAGE(PG8_SA(0, 0), cA, voffA); PG8_STAGE(PG8_SA(0, 1), cA + hstepA, voffA);
    if (wr == 1) PG8_BAR;
    PG8_WAIT_V(2); PG8_BAR;
    PG8_STAGE(PG8_SB(1, 0), cB + kstep, voffB); PG8_STAGE(PG8_SA(1, 0), cA + kstep, voffA); PG8_STAGE(PG8_SB(1, 1), cB + hstepB + kstep, voffB);
    PG8_WAIT_V(6); PG8_BAR;
    for (;;) {
        const bool has_next = S.next(ui + 1, nxt);
        const char* nA = cA; const char* nB = cB; if (has_next) S.base(nxt, nA, nB);
        for (int t = 0; t < nt; t += 2) {
            const bool last = (t == nt - 2);
            if (last && has_next) S.a_ready(nxt, wid);
            const char* a1 = cA + (size_t)(t + 1) * kstep;
            const char* a2 = last ? nA : cA + (size_t)(t + 2) * kstep; const char* b2 = last ? nB : cB + (size_t)(t + 2) * kstep;
            const char* a3 = a2 + kstep; const char* b3 = b2 + kstep;
            PG8_LDB(B0, 0, 0); PG8_LDB(B1, 0, 1); PG8_SCHED; PG8_LDA(At, 0, 0); PG8_STAGE(PG8_SA(1, 1), a1 + hstepA, voffA);
            PG8_WAIT_V(8); PG8_WAIT_L(0); PG8_BAR; PG8_MMA(0, 0, At, B0); PG8_MMA(0, 1, At, B1); PG8_BAR; PG8_SCHED;
            PG8_LDA(At, 0, 1); PG8_STAGE(PG8_SB(0, 0), b2, voffB); PG8_STAGE(PG8_SB(0, 1), b2 + hstepB, voffB); PG8_STAGE(PG8_SA(0, 0), a2, voffA);
            PG8_WAIT_V(8); PG8_WAIT_L(0); PG8_BAR; PG8_MMA(1, 0, At, B0); PG8_MMA(1, 1, At, B1); PG8_BAR; PG8_SCHED;
            PG8_LDB(B0, 1, 0); PG8_LDB(B1, 1, 1); PG8_SCHED; PG8_LDA(At, 1, 0); PG8_STAGE(PG8_SA(0, 1), a2 + hstepA, voffA);
            PG8_WAIT_V(8); PG8_WAIT_L(0); PG8_BAR; PG8_MMA(0, 0, At, B0); PG8_MMA(0, 1, At, B1); PG8_BAR; PG8_SCHED;
            PG8_LDA(At, 1, 1); PG8_STAGE(PG8_SB(1, 0), b3, voffB); PG8_STAGE(PG8_SB(1, 1), b3 + hstepB, voffB); PG8_STAGE(PG8_SA(1, 0), a3, voffA);
            PG8_WAIT_V(8); PG8_WAIT_L(0); PG8_BAR; PG8_MMA(1, 0, At, B0); PG8_MMA(1, 1, At, B1); PG8_BAR; PG8_SCHED;
        }
        if (wr == 0) PG8_BAR;
        { int fr_e = fr, fq_e = fq; asm volatile("" : "+v"(fr_e), "+v"(fq_e)); E(acc, cur, wr, wc, fr_e, fq_e); }
        S.done(cur, wid, lane);
        if (!has_next) break;
#pragma unroll
        for (int a = 0; a < 2; ++a)
#pragma unroll
            for (int b = 0; b < 2; ++b)
#pragma unroll
                for (int m = 0; m < 4; ++m)
#pragma unroll
                    for (int n = 0; n < 2; ++n) acc[a][b][m][n] = (f32x4){0.f, 0.f, 0.f, 0.f};
        cur = nxt; cA = nA; cB = nB; ++ui;
        if (wr == 1) PG8_BAR;
    }
    PG8_WAIT_V(0);
    PG8_BAR;
#undef PG8_SA
#undef PG8_SB
#undef PG8_STAGE
#undef PG8_LDA
#undef PG8_LDB
#undef PG8_MMA
#undef PG8_WAIT_V
#undef PG8_WAIT_L
#undef PG8_SCHED
}
#define MK_BAR() do { asm volatile("s_waitcnt vmcnt(0) lgkmcnt(0)" ::: "memory"); __builtin_amdgcn_s_barrier(); asm volatile("" ::: "memory"); } while (0)
#define MK_LBAR() do { asm volatile("s_waitcnt lgkmcnt(0)" ::: "memory"); __builtin_amdgcn_s_barrier(); asm volatile("" ::: "memory"); } while (0)

typedef f32x4 AccT[2][2][4][2];
#ifndef MK_LO
#define MK_LO 1
#endif
__device__ __forceinline__ f32x4 unpack_bf4(u32x2 w) { f32x4 r; r[0] = __builtin_bit_cast(float, w.x << 16); r[1] = __builtin_bit_cast(float, w.x & 0xffff0000u); r[2] = __builtin_bit_cast(float, w.y << 16); r[3] = __builtin_bit_cast(float, w.y & 0xffff0000u); return r; }
__device__ __forceinline__ f32x4 load_hilo4(const bf16_t* hi, const bf16_t* lo, size_t off) { return unpack_bf4(*(const u32x2*)(hi + off)) + unpack_bf4(*(const u32x2*)(lo + off)); }
__device__ __forceinline__ void load_hilo8(const bf16_t* hi, const bf16_t* lo, size_t off, f32x4& a, f32x4& b) { const u32x4 h4 = *(const u32x4*)(hi + off); u32x4 l4 = (u32x4){0u, 0u, 0u, 0u}; if (MK_LO) l4 = *(const u32x4*)(lo + off);
    u32x2 ha, hb_, la, lb; ha.x = h4.x; ha.y = h4.y; hb_.x = h4.z; hb_.y = h4.w; la.x = l4.x; la.y = l4.y; lb.x = l4.z; lb.y = l4.w; a = unpack_bf4(ha) + unpack_bf4(la); b = unpack_bf4(hb_) + unpack_bf4(lb); }
__device__ __forceinline__ void store_hilo4(bf16_t* hi, bf16_t* lo, size_t off, f32x4 v) { u32x2 w; w.x = cvtpk(v[0], v[1]); w.y = cvtpk(v[2], v[3]); const f32x4 d = v - unpack_bf4(w); u32x2 l; l.x = cvtpk(d[0], d[1]); l.y = cvtpk(d[2], d[3]);
    *(u32x2*)(hi + off) = w; *(u32x2*)(lo + off) = l; }
constexpr int RSN = MK_LO ? 1 : 8;
__device__ __forceinline__ float rs_of(const float* rsq, int row) {
    if (RSN == 1) return rsqrtf(rsq[row] * (1.f / D) + EPS);
    const f32x4 x = *(const f32x4*)(rsq + (size_t)row * 8), y = *(const f32x4*)(rsq + (size_t)row * 8 + 4);
    return rsqrtf((((x[0] + x[1]) + (x[2] + x[3])) + ((y[0] + y[1]) + (y[2] + y[3]))) * (1.f / D) + EPS); }

struct EpiBf {
    static constexpr bool PERM = true;
    bf16_t* O; int ldc; long o_pm, o_pn; const float* rsq; const float* csq;
    __device__ __forceinline__ void operator()(const AccT& acc, const Unit& u, int wr, int wc, int fr, int fq) const {
        bf16_t* base = O + u.pm * o_pm + u.pn * o_pn;
        float cs[2][8];
#pragma unroll
        for (int bj = 0; bj < 2; ++bj)
#pragma unroll
            for (int e = 0; e < 8; ++e) cs[bj][e] = csq ? rs_of(csq, u.pn * 256 + bj * HALF + wc * 32 + 8 * fq + e) : 1.f;
#pragma unroll
        for (int ai = 0; ai < 2; ++ai)
#pragma unroll
            for (int m = 0; m < 4; ++m) { const int row = ai * HALF + wr * 64 + m * 16 + fr; const float r = rsq ? rs_of(rsq, u.pm * 256 + row) : 1.f;
#pragma unroll
                for (int bj = 0; bj < 2; ++bj) { const f32x4 v0 = acc[ai][bj][m][0], v1 = acc[ai][bj][m][1]; u32x4 w;
                    w.x = cvtpk(v0[0] * r * cs[bj][0], v0[1] * r * cs[bj][1]); w.y = cvtpk(v0[2] * r * cs[bj][2], v0[3] * r * cs[bj][3]);
                    w.z = cvtpk(v1[0] * r * cs[bj][4], v1[1] * r * cs[bj][5]); w.w = cvtpk(v1[2] * r * cs[bj][6], v1[3] * r * cs[bj][7]);
                    *(u32x4*)(base + (size_t)row * ldc + bj * HALF + wc * 32 + 8 * fq) = w; } }
    }
};
struct EpiKV {
    static constexpr bool PERM = true;
    bf16_t* KV; const float* msq;
    __device__ __forceinline__ void operator()(const AccT& acc, const Unit& u, int wr, int wc, int fr, int fq) const {
        const int L = u.pm, layer = L >> 5, r = L & 31, tm = r >> 3, tn = r & 7;
        EpiBf e; e.ldc = 2048; e.o_pm = 256 * 2048; e.o_pn = 256; e.O = KV + (size_t)layer * 1024 * 2048; e.rsq = msq; e.csq = nullptr; Unit v; v.pm = tm; v.pn = tn;
        e(acc, v, wr, wc, fr, fq);
    }
};
template <int ISN> struct EpiMN {
    static constexpr bool PERM = true;
    bf16_t* O;
    __device__ __forceinline__ void operator()(const AccT& acc, const Unit& u, int wr, int wc, int fr, int fq) const {
        const int L = u.pm, layer = L >> 6, r = L & 63, bt = r >> 4, hh = (r >> 2) & 3, t4 = r & 3;
        EpiBf e; e.ldc = 1024; e.o_pm = 256 * 1024; e.o_pn = 256; e.O = O + ((size_t)layer * 4 + bt) * 1024 * 1024; e.rsq = nullptr; e.csq = nullptr; Unit v;
        if (!ISN) { v.pm = hh; v.pn = t4; } else { v.pm = t4; v.pn = hh; }
        e(acc, v, wr, wc, fr, fq);
    }
};
template <int GLU> struct EpiRes {
    static constexpr bool PERM = true;
    const float* base32; bf16_t* hi; bf16_t* lo; float* rsq; LAS float* xl;
    __device__ __forceinline__ void operator()(const AccT& acc, const Unit& u, int wr, int wc, int fr, int fq) const {
        constexpr int NBJ = GLU ? 1 : 2;
#pragma unroll
        for (int q = 0; q < 4; ++q) { const int ai = q >> 1, m0 = (q & 1) * 2;
            f32x4 bv[2][NBJ][2];
#pragma unroll
            for (int mm = 0; mm < 2; ++mm) { const int row = u.pm * 256 + ai * HALF + wr * 64 + (m0 + mm) * 16 + fr;
#pragma unroll
                for (int bj = 0; bj < NBJ; ++bj) { const int col = GLU ? (u.pn * 128 + wc * 32 + 8 * fq) : (u.pn * 256 + bj * HALF + wc * 32 + 8 * fq); const size_t off = (size_t)row * D + col;
                    if (base32) { bv[mm][bj][0] = *(const f32x4*)(base32 + off); bv[mm][bj][1] = *(const f32x4*)(base32 + off + 4); }
                    else { const u32x4 h4 = *(const u32x4*)(hi + off); u32x4 l4 = (u32x4){0u, 0u, 0u, 0u}; if (MK_LO) l4 = *(const u32x4*)(lo + off); u32x2 ha, hb_, la, lb; ha.x = h4.x; ha.y = h4.y; hb_.x = h4.z; hb_.y = h4.w; la.x = l4.x; la.y = l4.y; lb.x = l4.z; lb.y = l4.w;
                        bv[mm][bj][0] = unpack_bf4(ha) + unpack_bf4(la); bv[mm][bj][1] = unpack_bf4(hb_) + unpack_bf4(lb); } } }
#pragma unroll
            for (int mm = 0; mm < 2; ++mm) { const int m = m0 + mm; const int row = u.pm * 256 + ai * HALF + wr * 64 + m * 16 + fr; float ss = 0.f;
#pragma unroll
                for (int bj = 0; bj < NBJ; ++bj) { const int col = GLU ? (u.pn * 128 + wc * 32 + 8 * fq) : (u.pn * 256 + bj * HALF + wc * 32 + 8 * fq); const size_t off = (size_t)row * D + col;
                    f32x4 v[2];
#pragma unroll
                    for (int n = 0; n < 2; ++n) { f32x4 t = acc[ai][bj][m][n];
                        if (GLU) { const f32x4 gt = acc[ai][1][m][n]; t[0] *= sigmoidf_(gt[0]); t[1] *= sigmoidf_(gt[1]); t[2] *= sigmoidf_(gt[2]); t[3] *= sigmoidf_(gt[3]); }
                        t = t + bv[mm][bj][n]; v[n] = t; ss += (t[0] * t[0] + t[1] * t[1]) + (t[2] * t[2] + t[3] * t[3]); }
                    u32x4 h4; h4.x = cvtpk(v[0][0], v[0][1]); h4.y = cvtpk(v[0][2], v[0][3]); h4.z = cvtpk(v[1][0], v[1][1]); h4.w = cvtpk(v[1][2], v[1][3]);
                    u32x2 ha, hb_; ha.x = h4.x; ha.y = h4.y; hb_.x = h4.z; hb_.y = h4.w; const f32x4 d0 = v[0] - unpack_bf4(ha), d1 = v[1] - unpack_bf4(hb_);
                    u32x4 l4; l4.x = cvtpk(d0[0], d0[1]); l4.y = cvtpk(d0[2], d0[3]); l4.z = cvtpk(d1[0], d1[1]); l4.w = cvtpk(d1[2], d1[3]);
                    *(u32x4*)(hi + off) = h4; if (MK_LO) *(u32x4*)(lo + off) = l4; }
                ss += shx(ss, 16, fq * 16 + fr); ss += shx(ss, 32, fq * 16 + fr);
                if (fq == 0) xl[wc * 256 + ai * HALF + wr * 64 + m * 16 + fr] = ss; }
        }
        MK_LBAR();
        { const int t = (wr * 4 + wc) * 64 + fq * 16 + fr; if (t < 256) { const float s = (xl[t] + xl[256 + t]) + (xl[512 + t] + xl[768 + t]); if (RSN == 1) __hip_atomic_fetch_add(rsq + u.pm * 256 + t, s, __ATOMIC_RELAXED, __HIP_MEMORY_SCOPE_AGENT);
                else { float* rp = rsq + (size_t)(u.pm * 256 + t) * 8; rp[u.pn] = s; if (!GLU) rp[4 + u.pn] = 0.f; } } }
    }
};
struct EpiSoftmax {
    static constexpr bool PERM = true;
    bf16_t* P; LAS float* xl; const float* rsq;
    __device__ __forceinline__ void operator()(AccT& acc, const Unit& u, int wr, int wc, int fr, int fq) const {
        LAS float* mx = xl; LAS float* sm = xl + 1024;
#pragma unroll
        for (int ai = 0; ai < 2; ++ai)
#pragma unroll
            for (int m = 0; m < 4; ++m) { float mm = -3.0e38f; const float rr = rs_of(rsq, u.pm * 256 + ai * HALF + wr * 64 + m * 16 + fr);
#pragma unroll
                for (int bj = 0; bj < 2; ++bj)
#pragma unroll
                    for (int n = 0; n < 2; ++n) { const f32x4 v = acc[ai][bj][m][n] * rr; acc[ai][bj][m][n] = v; mm = fmaxf(mm, fmaxf(fmaxf(v[0], v[1]), fmaxf(v[2], v[3]))); }
                mm = fmaxf(mm, shx(mm, 16, fq * 16 + fr)); mm = fmaxf(mm, shx(mm, 32, fq * 16 + fr));
                if (fq == 0) mx[wc * 256 + ai * HALF + wr * 64 + m * 16 + fr] = mm; }
        MK_LBAR();
#pragma unroll
        for (int ai = 0; ai < 2; ++ai)
#pragma unroll
            for (int m = 0; m < 4; ++m) { const int row = ai * HALF + wr * 64 + m * 16 + fr;
                const float mm = fmaxf(fmaxf(mx[row], mx[256 + row]), fmaxf(mx[512 + row], mx[768 + row])); float s = 0.f;
#pragma unroll
                for (int bj = 0; bj < 2; ++bj)
#pragma unroll
                    for (int n = 0; n < 2; ++n)
#pragma unroll
                        for (int j = 0; j < 4; ++j) { const float e = fast_exp2(acc[ai][bj][m][n][j] - mm); acc[ai][bj][m][n][j] = e; s += e; }
                s += shx(s, 16, fq * 16 + fr); s += shx(s, 32, fq * 16 + fr);
                if (fq == 0) sm[wc * 256 + row] = s; }
        MK_LBAR();
#pragma unroll
        for (int ai = 0; ai < 2; ++ai)
#pragma unroll
            for (int m = 0; m < 4; ++m) { int zo = 0; asm volatile("" : "+v"(zo)); const int row = ai * HALF + wr * 64 + m * 16 + fr + zo;
                const float inv = fast_rcp((sm[row] + sm[256 + row]) + (sm[512 + row] + sm[768 + row]));
#pragma unroll
                for (int bj = 0; bj < 2; ++bj) { const f32x4 v0 = acc[ai][bj][m][0], v1 = acc[ai][bj][m][1]; u32x4 w;
                    w.x = cvtpk(v0[0] * inv, v0[1] * inv); w.y = cvtpk(v0[2] * inv, v0[3] * inv);
                    w.z = cvtpk(v1[0] * inv, v1[1] * inv); w.w = cvtpk(v1[2] * inv, v1[3] * inv);
                    *(u32x4*)(P + (size_t)(u.pm * 256 + row) * D + u.pn * 256 + bj * HALF + wc * 32 + 8 * fq) = w; } }
    }
};
struct EpiConvGlu {
    static constexpr int PERM = 2;
    bf16_t* Gb; const float* rsq; const float* cw; const float* cb; LAS float* xl;
    __device__ __forceinline__ void operator()(AccT& acc, const Unit& u, int wr, int wc, int fr, int fq) const {
        const int bt = u.pm / 17, jt = u.pm % 17; int o0 = 254 * jt; if (o0 > 3842) o0 = 3842;
        const int tib0 = o0 - 2; const long tok0 = (long)bt * SEQ + tib0;
#pragma unroll
        for (int ai = 0; ai < 2; ++ai)
#pragma unroll
            for (int m = 0; m < 4; ++m) { const int R = ai * HALF + wr * 64 + m * 16 + fr; const bool ok = (tib0 + R) >= 0; const float r = ok ? rs_of(rsq, (int)(tok0 + R)) : 0.f;
#pragma unroll
                for (int bj = 0; bj < 2; ++bj)
#pragma unroll
                    for (int n = 0; n < 2; ++n) acc[ai][bj][m][n] = acc[ai][bj][m][n] * r; }
        if (fr >= 14) {
#pragma unroll
            for (int ai = 0; ai < 2; ++ai) { LAS float* hp = xl + ((((ai * 2 + wr) * 4 + wc) * 2 + (fr - 14)) * 4 + fq) * 16;
#pragma unroll
                for (int bj = 0; bj < 2; ++bj)
#pragma unroll
                    for (int n = 0; n < 2; ++n) *(LAS f32x4*)(hp + (bj * 2 + n) * 4) = acc[ai][bj][3][n]; }
        }
        MK_LBAR();
        const int f0 = u.pn * 128 + wc * 32 + 8 * (fq & 1) + 4 * (fq >> 1);
        unsigned dep = 0u;
#pragma unroll
        for (int n = 0; n < 2; ++n) {
            int zo = 0; asm volatile("" : "+v"(zo) : "v"(dep));
            const float* cwp = cw + f0 + 16 * n + zo; const float* cbp = cb + f0 + 16 * n + zo;
            f32x4 w0[2], w1[2], w2[2], bb[2];
#pragma unroll
            for (int bj = 0; bj < 2; ++bj) { w0[bj] = *(const f32x4*)(cwp + bj * FF); w1[bj] = *(const f32x4*)(cwp + 2 * FF + bj * FF); w2[bj] = *(const f32x4*)(cwp + 4 * FF + bj * FF); bb[bj] = *(const f32x4*)(cbp + bj * FF); }
#pragma unroll
            for (int ai = 0; ai < 2; ++ai) { const int grp = ai * 2 + wr;
                f32x4 pv[2]; u32x2 wprev; wprev.x = 0u; wprev.y = 0u;
#pragma unroll
                for (int bj = 0; bj < 2; ++bj) { f32x4 hv = (f32x4){0.f, 0.f, 0.f, 0.f};
                    if (grp > 0 && fr >= 14) hv = *(const LAS f32x4*)(xl + (((((grp - 1) * 4 + wc) * 2 + (fr - 14)) * 4 + fq) * 16) + (bj * 2 + n) * 4);
                    pv[bj] = hv; }
#pragma unroll
                for (int m = 0; m < 4; ++m) { const int R = ai * HALF + wr * 64 + m * 16 + fr;
                    f32x4 res[2];
#pragma unroll
                    for (int bj = 0; bj < 2; ++bj) { const f32x4 cur = acc[ai][bj][m][n]; f32x4 x1, x2;
#pragma unroll
                        for (int j = 0; j < 4; ++j) {
                            const float c1 = fr == 15 ? pv[bj][j] : cur[j], c2 = fr >= 14 ? pv[bj][j] : cur[j];
                            x1[j] = dppf<0x121>(c1); x2[j] = dppf<0x122>(c2); }
                        res[bj] = w2[bj] * cur + w1[bj] * x1 + w0[bj] * x2 + bb[bj]; pv[bj] = cur; }
                    f32x4 e4;
#pragma unroll
                    for (int j = 0; j < 4; ++j) e4[j] = fast_exp2(res[1][j] * -LOG2E);
                    e4 = e4 + 1.f;
#pragma unroll
                    for (int j = 0; j < 4; ++j) e4[j] = fast_rcp(e4[j]);
                    const f32x4 a = res[1] * e4 * res[0];
                    u32x2 w; w.x = cvtpk(a[0], a[1]); w.y = cvtpk(a[2], a[3]); dep = w.y;
                    if (!(m & 1)) wprev = w;
                    else {
                        const auto r0 = __builtin_amdgcn_permlane32_swap(wprev.x, w.x, false, false); const auto r1 = __builtin_amdgcn_permlane32_swap(wprev.y, w.y, false, false);
                        u32x4 w4; w4.x = r0[0]; w4.y = r1[0]; w4.z = r0[1]; w4.w = r1[1];
                        const int Rs = (fq < 2) ? R - 16 : R;
                        if (Rs >= 2) *(u32x4*)(Gb + (size_t)(tok0 + Rs) * FF + u.pn * 128 + wc * 32 + 16 * n + 8 * (fq & 1)) = w4; } } }
        }
        MK_LBAR();
    }
};
struct EpiS5S {
    static constexpr bool PERM = false;
    float* Sst;
    __device__ __forceinline__ void operator()(const AccT& acc, const Unit& u, int wr, int wc, int fr, int fq) const {
#pragma unroll
        for (int ai = 0; ai < 2; ++ai)
#pragma unroll
            for (int m = 0; m < 4; ++m) { const int row = u.pm * 256 + ai * HALF + wr * 64 + m * 16 + fr;
#pragma unroll
                for (int n = 0; n < 2; ++n) *(f32x4*)(Sst + (size_t)row * 128 + wc * 32 + n * 16 + fq * 4) = acc[ai][0][m][n]; }
    }
};
__device__ __forceinline__ float gelu_tanh(float x) { const float uu = 0.7978845608028654f * (x + 0.044715f * x * x * x); const float e = fast_exp2(2.f * LOG2E * uu); return x * (1.f - fast_rcp(1.f + e)); }
struct EpiS5Y {
    static constexpr bool PERM = false;
    bf16_t* Y; const bf16_t* Z; const float* dvec;
    __device__ __forceinline__ void operator()(const AccT& acc, const Unit& u, int wr, int wc, int fr, int fq) const {
        const int g = u.pm >> 2, mt = u.pm & 3;
#pragma unroll
        for (int ai = 0; ai < 2; ++ai)
#pragma unroll
            for (int m = 0; m < 4; ++m) { const int nrow = mt * 256 + ai * HALF + wr * 64 + m * 16 + fr;
#pragma unroll
                for (int bj = 0; bj < 2; ++bj)
#pragma unroll
                    for (int n = 0; n < 2; ++n) { const int col = bj * HALF + wc * 32 + n * 16 + fq * 4; const int t = col >> 4, i0 = col & 15;
                        const u32x2 uz = *(const u32x2*)(Z + ((size_t)g * 1024 + nrow) * 384 + col);
                        const float u0 = __builtin_bit_cast(float, uz.x << 16), u1 = __builtin_bit_cast(float, uz.x & 0xffff0000u), u2 = __builtin_bit_cast(float, uz.y << 16), u3 = __builtin_bit_cast(float, uz.y & 0xffff0000u);
                        const f32x4 dv = *(const f32x4*)(dvec + g * 16 + i0); const f32x4 a = acc[ai][bj][m][n];
                        u32x2 w; w.x = cvtpk(gelu_tanh(a[0] + dv[0] * u0), gelu_tanh(a[1] + dv[1] * u1)); w.y = cvtpk(gelu_tanh(a[2] + dv[2] * u2), gelu_tanh(a[3] + dv[3] * u3));
                        *(u32x2*)(Y + (size_t)(nrow * 16 + t) * D + g * 16 + i0) = w; } }
    }
};
}
namespace mk {
#define RLX_AGENT __ATOMIC_RELAXED, __HIP_MEMORY_SCOPE_AGENT
#define XB_TMO      128
#define XB_XCNT(j)  (256  + 64 * (j))
#define XB_XSUB(j)  (1280 + 64 * (j))
#define XB_XGEN(j)  (2304 + 64 * (j))
#define XB_TOP      3328
#define XB_TOPGEN   3392
#define XCD_BAR_WORDS 3456
#define XB_SPIN_CAP (1u << 18)

__device__ __forceinline__ unsigned xb_ld(unsigned* p)              { return __hip_atomic_load(p, __ATOMIC_RELAXED, __HIP_MEMORY_SCOPE_AGENT); }
__device__ __forceinline__ unsigned xb_add(unsigned* p, unsigned v) { return __hip_atomic_fetch_add(p, v, __ATOMIC_RELAXED, __HIP_MEMORY_SCOPE_AGENT); }
__device__ __forceinline__ unsigned xb_xcc_id() { return (unsigned)__builtin_amdgcn_s_getreg((3 << 11) | 20) & 0xFu; }
#define XB_SPIN(cond, bar) do { unsigned _sp = 0; while (cond) { __builtin_amdgcn_s_sleep(1); \
    if ((++_sp & 255u) == 0u) { if (xb_ld(&(bar)[XB_TMO])) break; if (_sp > XB_SPIN_CAP) { atomicAdd(&(bar)[XB_TMO], 1u); break; } } } } while (0)

struct XcdBarrier {
    unsigned* bar; unsigned x;
    volatile LAS unsigned* st;
};

__device__ __forceinline__ XcdBarrier xcd_barrier_post(unsigned* bar, volatile LAS unsigned* st) {
    XcdBarrier b; b.bar = bar; b.x = xb_xcc_id(); b.st = st;
    if (threadIdx.x == 0) (void)xb_add(&bar[XB_XCNT(b.x)], 1u);
    return b;
}
__device__ __forceinline__ void xcd_barrier_complete(unsigned* bar, unsigned x, unsigned& nloc, unsigned& nx) {
    const unsigned G = gridDim.x * gridDim.y * gridDim.z;
    unsigned sum, cnt, mine, sp = 0u;
    for (;;) {
        sum = 0u; cnt = 0u; mine = 0u;
#pragma unroll
        for (unsigned j = 0; j < 16; ++j) { const unsigned c = xb_ld(&bar[XB_XCNT(j)]); sum += c; cnt += (c > 0u) ? 1u : 0u; mine = (j == x) ? c : mine; }
        if (sum == G) break;
        __builtin_amdgcn_s_sleep(1);
        if ((++sp & 255u) == 0u) { if (xb_ld(&bar[XB_TMO])) break; if (sp > XB_SPIN_CAP) { atomicAdd(&bar[XB_TMO], 1u); break; } }
    }
    nloc = mine > 0u ? mine : 1u; nx = cnt > 0u ? cnt : 1u;
}

__device__ __forceinline__ void xcd_barrier(const XcdBarrier& b) {
    asm volatile("s_waitcnt vmcnt(0)" ::: "memory");
    __syncthreads();
    if (threadIdx.x == 0) {
        unsigned* bar = b.bar;
        __builtin_amdgcn_s_waitcnt(0);
        unsigned nloc = b.st[0], nx = b.st[1];
        if (nloc == 0u) { xcd_barrier_complete(bar, b.x, nloc, nx); b.st[0] = nloc; b.st[1] = nx; }
        const unsigned old = xb_add(&bar[XB_XSUB(b.x)], 1u);
        const unsigned gen = old / nloc;
        if (old + 1u == (gen + 1u) * nloc) {
            __builtin_amdgcn_fence(__ATOMIC_RELEASE, "agent");
            asm volatile("s_waitcnt vmcnt(0)" ::: "memory");
            const unsigned og = xb_add(&bar[XB_TOP], 1u);
            const unsigned tg = og / nx;
            __builtin_amdgcn_fence(__ATOMIC_ACQUIRE, "agent");
            if (og + 1u == (tg + 1u) * nx) xb_add(&bar[XB_TOPGEN], 1u);
            else XB_SPIN(xb_ld(&bar[XB_TOPGEN]) == tg, bar);
            xb_add(&bar[XB_XGEN(b.x)], 1u);
            asm volatile("s_waitcnt vmcnt(0)" ::: "memory");
        } else {
            __builtin_amdgcn_fence(__ATOMIC_ACQUIRE, "agent");
            XB_SPIN(xb_ld(&bar[XB_XGEN(b.x)]) == gen, bar);
            asm volatile("s_waitcnt vmcnt(0)" ::: "memory");
        }
    }
    __syncthreads();
}
}
namespace mk {
constexpr size_t MiB = 1u << 20;
constexpr size_t OFF_RS = 1 * MiB;
constexpr size_t OFF_W = 2 * MiB;
constexpr size_t OFF_WQP = 113 * MiB;
constexpr size_t OFF_HB = 122 * MiB;
constexpr size_t OFF_MEMB = 154 * MiB;
constexpr size_t OFF_KV = 156 * MiB;
constexpr size_t OFF_S5WB = 172 * MiB;
constexpr size_t OFF_S5TW = 180 * MiB;
constexpr size_t OFF_MT = 192 * MiB;
constexpr size_t OFF_NT = 224 * MiB;
constexpr size_t OFF_SCR = 256 * MiB;
constexpr size_t WS_NEED = 352 * MiB;
constexpr size_t W_PW = 0, W_QKV = 524288, W_SO = 3670016, W_GLU = 4718592, W_L0 = 6815744, W_LSTRIDE = 12845056;
constexpr size_t WL_Q = 0, WL_KV = 1048576, WL_O = 3145728, WL_UP = 4194304, WL_DN = 9961472;

struct P { const float* in[27]; float* out; unsigned char* ws; int lo, hi; };
__device__ __forceinline__ int otid(int wv) { return wv * 64 + lane_id_v(); }

__device__ __forceinline__ void transpose_item(const float* W, int ldw, int k0, int n0, bf16_t* WT, int ldk, int drow0, const float* sk, const float* sn, float cst, LAS float* scr, int lane) {
    f32x4 v[8];
#pragma unroll
    for (int i = 0; i < 8; ++i) { const int kk = 8 * i + (lane >> 3); v[i] = *(const f32x4*)(W + (size_t)(k0 + kk) * ldw + n0 + 4 * (lane & 7)); }
#pragma unroll
    for (int i = 0; i < 8; ++i) { const int kk = 8 * i + (lane >> 3); LAS float* d = scr + kk * 33 + 4 * (lane & 7); d[0] = v[i][0]; d[1] = v[i][1]; d[2] = v[i][2]; d[3] = v[i][3]; }
    asm volatile("s_waitcnt lgkmcnt(0)" ::: "memory");
    const int c = lane & 7;
    f32x4 ka = (f32x4){1.f, 1.f, 1.f, 1.f}, kb = ka; if (sk) { ka = *(const f32x4*)(sk + k0 + 8 * c); kb = *(const f32x4*)(sk + k0 + 8 * c + 4); }
#pragma unroll
    for (int j = 0; j < 4; ++j) { const int n = (lane >> 3) + 8 * j; const LAS float* s = scr + (8 * c) * 33 + n; const float sc = cst * (sn ? sn[n0 + n] : 1.f);
        u32x4 o; o.x = cvtpk(s[0 * 33] * sc * ka[0], s[1 * 33] * sc * ka[1]); o.y = cvtpk(s[2 * 33] * sc * ka[2], s[3 * 33] * sc * ka[3]); o.z = cvtpk(s[4 * 33] * sc * kb[0], s[5 * 33] * sc * kb[1]); o.w = cvtpk(s[6 * 33] * sc * kb[2], s[7 * 33] * sc * kb[3]);
        *(u32x4*)(WT + (size_t)(drow0 + n) * ldk + k0 + 8 * c) = o; }
    asm volatile("s_waitcnt lgkmcnt(0)" ::: "memory");
}
struct WJob { const float* W; int K, N; bf16_t* dst; const float* sk; const float* sn; int half; float cst; int qcols; };
__device__ __forceinline__ WJob wjob(const P& p, int id) {
    bf16_t* Wb = (bf16_t*)(p.ws + OFF_W); WJob j; j.sk = nullptr; j.sn = nullptr; j.half = 0; j.cst = 1.f; j.qcols = 1 << 30;
    if (id < 8) { const int jj = id >> 2, g = id & 3; j.W = p.in[3] + (size_t)id * 65536; j.K = 256; j.N = 256; j.dst = Wb + W_PW + (size_t)id * 65536; j.sk = p.in[2] + (jj * 3) * D + g * 256; j.sn = p.in[4] + jj * D + g * 256; }
    else if (id == 8) { j.W = p.in[5]; j.K = D; j.N = 3 * D; j.dst = Wb + W_QKV; j.sk = p.in[2] + 1 * D; j.cst = 0.125f * LOG2E; j.qcols = D; }
    else if (id == 9) { j.W = p.in[6]; j.K = D; j.N = D; j.dst = Wb + W_SO; }
    else if (id == 10) { j.W = p.in[15]; j.K = D; j.N = 2 * D; j.dst = Wb + W_GLU; j.half = D; }
    else { const int i = (id - 11) / 5, w = (id - 11) % 5; bf16_t* L = Wb + W_L0 + (size_t)i * W_LSTRIDE;
        if (w == 0) { j.W = p.in[18] + (size_t)i * D * D; j.K = D; j.N = D; j.dst = L + WL_Q; j.sk = p.in[16] + i * D; j.cst = 0.0625f * LOG2E; }
        else if (w == 1) { j.W = p.in[19] + (size_t)i * D * 2 * D; j.K = D; j.N = 2 * D; j.dst = L + WL_KV; j.sk = p.in[17] + i * D; }
        else if (w == 2) { j.W = p.in[20] + (size_t)i * D * D; j.K = D; j.N = D; j.dst = L + WL_O; }
        else if (w == 3) { j.W = p.in[22] + (size_t)i * D * 2 * FF; j.K = D; j.N = 2 * FF; j.dst = L + WL_UP; j.sk = p.in[21] + i * D; j.half = FF; }
        else { j.W = p.in[25] + (size_t)i * FF * D; j.K = FF; j.N = D; j.dst = L + WL_DN; } }
    return j;
}
constexpr int N_WJOBS = 31;
__device__ __forceinline__ int wjob_items(int id) {
    if (id < 8) return 4 * 8; if (id == 8) return 16 * 96; if (id == 9) return 16 * 32; if (id == 10) return 16 * 64;
    const int w = (id - 11) % 5; return w == 0 ? 0   : w == 1 ? 16 * 64 : w == 2 ? 16 * 32 : w == 3 ? 16 * 176 : 44 * 32;
}
__device__ __forceinline__ void row_to_bf16(const float* xrow, bf16_t* orow, float* sq, float* copy, int lane) {
    const f32x4* xr = (const f32x4*)xrow + lane; f32x4 v[4]; float s = 0.f;
#pragma unroll
    for (int j = 0; j < 4; ++j) { v[j] = xr[64 * j]; s += (v[j][0] * v[j][0] + v[j][1] * v[j][1]) + (v[j][2] * v[j][2] + v[j][3] * v[j][3]); }
    s = wave_sum(s, lane); if (lane < RSN) sq[lane] = lane == 0 ? s : 0.f;
#pragma unroll
    for (int j = 0; j < 4; ++j) { if (orow) { u32x2 w; w.x = cvtpk(v[j][0], v[j][1]); w.y = cvtpk(v[j][2], v[j][3]); *((u32x2*)orow + lane + 64 * j) = w; } if (copy) *((f32x4*)copy + lane + 64 * j) = v[j]; }
}
__device__ __forceinline__ void s5_items(const P& p, LAS float* sl, int wv) {
    const int tid = otid(wv); bf16_t* WB = (bf16_t*)(p.ws + OFF_S5WB); bf16_t* TW = (bf16_t*)(p.ws + OFF_S5TW);
    const float* a_re = p.in[7]; const float* a_im = p.in[8]; const float* ldt = p.in[9]; const float* b_re = p.in[10]; const float* b_im = p.in[11]; const float* c_re = p.in[12]; const float* c_im = p.in[13];
    LAS float* sCr = sl; LAS float* sCi = sl + 1024; LAS float* sBr = sl + 2048; LAS float* sBi = sl + 3072;
    LAS float* pwr = sl + 4096; LAS float* pwi = pwr + 17 * 64; LAS float* wfr = pwi + 17 * 64; LAS float* wfi = wfr + 17 * 64;
    for (int task = blockIdx.x; task < 256; task += gridDim.x) {
        const int g = task >> 2, part = task & 3;
        __syncthreads();
        for (int q = tid; q < 1024; q += 512) { sCr[q] = c_re[g * 1024 + q]; sCi[q] = c_im[g * 1024 + q]; sBr[q] = b_re[g * 1024 + q]; sBi[q] = b_im[g * 1024 + q]; }
        if (tid < 64) { const int pp = tid; const float lr = a_re[g * 64 + pp], li = a_im[g * 64 + pp], dt = expf(ldt[g]); const float xr = lr * dt, xi = li * dt;
            float s1, c1; sincosf(xi, &s1, &c1); const float ex = expf(xr); const float ar = ex * c1, ai = ex * s1;
            const float sh = sinf(0.5f * xi); const float nr = expm1f(xr) * c1 - 2.f * sh * sh, ni = ex * s1; const float den = lr * lr + li * li;
            const float fr_ = (nr * lr + ni * li) / den, fi_ = (ni * lr - nr * li) / den;
            float cr = 1.f, ci = 0.f;
            for (int e = 0; e <= 16; ++e) { pwr[e * 64 + pp] = cr; pwi[e * 64 + pp] = ci; wfr[e * 64 + pp] = cr * fr_ - ci * fi_; wfi[e * 64 + pp] = cr * fi_ + ci * fr_;
                const float tr = cr * ar - ci * ai, ti = cr * ai + ci * ar; cr = tr; ci = ti; } }
        __syncthreads();
        const int r0 = part * 16, r1 = (part == 3) ? 63 : r0 + 16;
        for (int r = r0; r < r1; ++r) {
            if (r < 31) {
                const int l = r - 15;
                if (tid < 256) { const int i = tid >> 4, j = tid & 15; float val = 0.f;
                    if (l >= 0) { for (int pp = 0; pp < 64; ++pp) { const float cr = sCr[i * 64 + pp], ci = sCi[i * 64 + pp], br = sBr[pp * 16 + j], bi = sBi[pp * 16 + j];
                            const float wr_ = wfr[l * 64 + pp], wi_ = wfi[l * 64 + pp]; val += (cr * wr_ - ci * wi_) * br - (cr * wi_ + ci * wr_) * bi; } }
                    const bf16_t bv = (bf16_t)(cvtpk(val, 0.f) & 0xffffu);
                    for (int t = 0; t < 16; ++t) { const int s = t - l; if (s >= 0 && s < 16) TW[((size_t)g * 256 + t * 16 + i) * 384 + s * 16 + j] = bv; } }
            } else if (r < 47) {
                const int s = r - 31, e = 15 - s;
                for (int q4 = tid; q4 < 2048; q4 += 512) { const int q = q4 >> 4, j = q4 & 15, pp = q >> 1, im = q & 1; const float br = sBr[pp * 16 + j], bi = sBi[pp * 16 + j]; const float wr_ = wfr[e * 64 + pp], wi_ = wfi[e * 64 + pp];
                    const float val = im ? (wr_ * bi + wi_ * br) : (wr_ * br - wi_ * bi);
                    WB[((size_t)g * 256 + q) * 256 + s * 16 + j] = (bf16_t)(cvtpk(val, 0.f) & 0xffffu); WB[((size_t)g * 256 + 128 + q) * 256 + s * 16 + j] = 0; }
            } else {
                const int t = r - 47, e = t + 1;
                for (int q4 = tid; q4 < 2048; q4 += 512) { const int i = q4 >> 7, q = q4 & 127, pp = q >> 1, im = q & 1; const float cr = sCr[i * 64 + pp], ci = sCi[i * 64 + pp]; const float wr_ = pwr[e * 64 + pp], wi_ = pwi[e * 64 + pp];
                    const float val = im ? -(cr * wi_ + ci * wr_) : (cr * wr_ - ci * wi_);
                    TW[((size_t)g * 256 + t * 16 + i) * 384 + 256 + q] = (bf16_t)(cvtpk(val, 0.f) & 0xffffu); }
            }
        }
    }
    __syncthreads();
}
__device__ __forceinline__ void prologue(const P& p, LAS unsigned char* lds, int wv) {
    const int tid = otid(wv), lane = tid & 63, wave = tid >> 6; const int gw = blockIdx.x * 8 + wave, NGW = gridDim.x * 8;
    float* RS = MK_LO ? (float*)(p.ws + OFF_RS) : p.out;
    if (blockIdx.x & 1) { s5_items(p, (LAS float*)lds, wv); __syncthreads(); }
    if (RSN == 1) for (size_t i = (size_t)blockIdx.x * 512 + tid; i < (size_t)12 * T / 4; i += (size_t)gridDim.x * 512) ((f32x4*)(RS + T))[i] = (f32x4){0.f, 0.f, 0.f, 0.f};
    bf16_t* HB = (bf16_t*)(p.ws + OFF_HB);
    for (int m = gw; m < T; m += NGW) row_to_bf16(p.in[0] + (size_t)m * D, nullptr, RS + (size_t)m * RSN, nullptr, lane);
    bf16_t* MB = (bf16_t*)(p.ws + OFF_MEMB);
    for (int m = gw; m < 1024; m += NGW) row_to_bf16(p.in[1] + (size_t)m * D, MB + (size_t)m * D, RS + ((size_t)13 * T + m) * RSN, nullptr, lane);
    LAS float* scr = (LAS float*)(lds + wave * 16384);
    int total = 0;
    for (int id = 0; id < N_WJOBS; ++id) total += wjob_items(id);
    for (int it = gw; it < total; it += NGW) {
        int r = it, id = 0; for (;; ++id) { const int c = wjob_items(id); if (r < c) break; r -= c; }
        const WJob j = wjob(p, id); const int nblk = j.N / 32, kb = r / nblk, nb = r % nblk, k0 = 64 * kb, n0 = 32 * nb;
        int drow0 = n0; if (j.half) { const int hf = n0 / j.half, f = n0 % j.half; drow0 = (f / 128) * 256 + hf * 128 + (f % 128); }
        transpose_item(j.W, j.N, k0, n0, j.dst, j.K, drow0, j.sk, j.sn, n0 < j.qcols ? j.cst : 1.f, scr, lane);
    }
    { bf16_t* WQP = (bf16_t*)(p.ws + OFF_WQP);
      for (size_t idx = (size_t)blockIdx.x * 512 + tid; idx < (size_t)4 * D * D / 8; idx += (size_t)gridDim.x * 512) { const size_t e0 = idx * 8; const int i = (int)(e0 >> 20), k = (int)(e0 >> 10) & 1023;
          const float sc = p.in[16][i * D + k] * (0.0625f * LOG2E); const f32x4 x0 = *(const f32x4*)(p.in[18] + e0), x1 = *(const f32x4*)(p.in[18] + e0 + 4);
          u32x4 w; w.x = cvtpk(x0[0] * sc, x0[1] * sc); w.y = cvtpk(x0[2] * sc, x0[3] * sc); w.z = cvtpk(x1[0] * sc, x1[1] * sc); w.w = cvtpk(x1[2] * sc, x1[3] * sc); *(u32x4*)(WQP + e0) = w; } }
    __syncthreads();
    if (!(blockIdx.x & 1)) s5_items(p, (LAS float*)lds, wv);
}
__device__ __forceinline__ void ld8(const float* h32, const bf16_t* hi, const bf16_t* lo, size_t off, f32x4& a, f32x4& b) {
    if (h32) { a = *(const f32x4*)(h32 + off); b = *(const f32x4*)(h32 + off + 4); } else load_hilo8(hi, lo, off, a, b); }
__device__ __forceinline__ void pool_prep(const float* h32, const bf16_t* hi, const bf16_t* lo, const float* rsq, bf16_t* ph, int wv) {
    for (size_t idx = (size_t)blockIdx.x * 512 + otid(wv); idx < (size_t)(T / 16) * 128; idx += (size_t)gridDim.x * 512) {
        const int tok0 = (int)(idx >> 7) * 16, c = ((int)idx & 127) * 8; const int win = 2 << (c >> 8); const int tib0 = tok0 & (SEQ - 1);
        f32x4 sa = (f32x4){0.f, 0.f, 0.f, 0.f}, sb = sa;
        for (int k = win - 1; k >= 1; --k) if (tib0 - k >= 0) { const float r = rs_of(rsq, tok0 - k); f32x4 xa, xb; ld8(h32, hi, lo, (size_t)(tok0 - k) * D + c, xa, xb); sa = sa + xa * r; sb = sb + xb * r; }
#pragma unroll
        for (int t = 0; t < 16; ++t) { const int row = tok0 + t; const float r = rs_of(rsq, row); f32x4 xa, xb; ld8(h32, hi, lo, (size_t)row * D + c, xa, xb); xa = xa * r; xb = xb * r; sa = sa + xa; sb = sb + xb;
            const int cnt = min(tib0 + t + 1, win); const float ic = 1.f / (float)cnt; const f32x4 oa = sa * ic - xa, ob = sb * ic - xb;
            u32x4 w; w.x = cvtpk(oa[0], oa[1]); w.y = cvtpk(oa[2], oa[3]); w.z = cvtpk(ob[0], ob[1]); w.w = cvtpk(ob[2], ob[3]);
            *(u32x4*)(ph + (size_t)row * D + c) = w;
            const int ro = tib0 + t - (win - 1);
            if (ro >= 0) { const float r2 = rs_of(rsq, row - (win - 1)); f32x4 ya, yb; ld8(h32, hi, lo, (size_t)(row - (win - 1)) * D + c, ya, yb); sa = sa - ya * r2; sb = sb - yb * r2; } }
    }
}
__device__ __forceinline__ void s5_zfill(const bf16_t* hi, const bf16_t* lo, const float* rsq, const float* gain, bf16_t* Z, int wv) {
    for (size_t idx = (size_t)blockIdx.x * 512 + otid(wv); idx < (size_t)T * 128; idx += (size_t)gridDim.x * 512) {
        const int tok = (int)(idx >> 7), c = ((int)idx & 127) * 8; const float r = rs_of(rsq, tok);
        f32x4 a, b; load_hilo8(hi, lo, (size_t)tok * D + c, a, b); const f32x4 ga = *(const f32x4*)(gain + c), gb = *(const f32x4*)(gain + c + 4);
        u32x4 w; w.x = cvtpk(a[0] * r * ga[0], a[1] * r * ga[1]); w.y = cvtpk(a[2] * r * ga[2], a[3] * r * ga[3]); w.z = cvtpk(b[0] * r * gb[0], b[1] * r * gb[1]); w.w = cvtpk(b[2] * r * gb[2], b[3] * r * gb[3]);
        const int g = c >> 4, n = tok >> 4, t = tok & 15;
        *(u32x4*)(Z + ((size_t)g * 1024 + n) * 384 + t * 16 + (c & 15)) = w;
    }
}
__device__ __forceinline__ void s5_scan(const P& p, const float* Sst, bf16_t* Z, int j5, int wv) {
    const int tid = otid(wv); const int lane = tid & 63, wave = tid >> 6; const int gw = blockIdx.x * 8 + wave, NGW = gridDim.x * 8;
    for (int task = gw; task < 256; task += NGW) {
        const int b = task >> 6, g = task & 63;
        const float lr = p.in[7][j5 * 4096 + g * 64 + lane], li = p.in[8][j5 * 4096 + g * 64 + lane], dt = expf(p.in[9][j5 * 64 + g]);
        const float mg = expf(16.f * lr * dt); float sn, cs; sincosf(16.f * li * dt, &sn, &cs); const float ar = mg * cs, ai = mg * sn;
        float xr = 0.f, xi = 0.f;
        for (int n0 = 0; n0 < 256; n0 += 16) {
            f32x2 sv[16];
#pragma unroll
            for (int k = 0; k < 16; ++k) sv[k] = *(const f32x2*)(Sst + ((size_t)g * 1024 + b * 256 + n0 + k) * 128 + 2 * lane);
#pragma unroll
            for (int k = 0; k < 16; ++k) { *(unsigned*)(Z + ((size_t)g * 1024 + b * 256 + n0 + k) * 384 + 256 + 2 * lane) = cvtpk(xr, xi);
                const float nr = ar * xr - ai * xi + sv[k][0], ni = ar * xi + ai * xr + sv[k][1]; xr = nr; xi = ni; }
        }
    }
}
__device__ __forceinline__ void sync_state(const float* h, bf16_t* HB, float* rsq, int wv) {
    const int tid = otid(wv); const int lane = tid & 63, wave = tid >> 6; const int gw = blockIdx.x * 8 + wave, NGW = gridDim.x * 8;
    for (int m = gw; m < T; m += NGW) row_to_bf16(h + (size_t)m * D, HB + (size_t)m * D, rsq + m, nullptr, lane);
}

#define MFMA32(a, b, c) __builtin_amdgcn_mfma_f32_32x32x16_bf16((a), (b), (c), 0, 0, 0)
__device__ __forceinline__ void sb_attn(const bf16_t* QK, const bf16_t* VT, bf16_t* O, int opitch, int wv) {
    const int tid = otid(wv); const int lane = tid & 63, wave = tid >> 6; const int n = lane & 31, half = lane >> 5;
    const int gw = blockIdx.x * 8 + wave, NGW = gridDim.x * 8;
    for (int task = gw; task < 8192; task += NGW) {
        const int qt = 127 - (task >> 6), bh = task & 63, b = bh >> 4, h = bh & 15;
        const int tok0 = b * SEQ + qt * 32;
        bf16x8 qf[4];
#pragma unroll
        for (int kk = 0; kk < 4; ++kk) qf[kk] = *(const bf16x8*)(QK + (size_t)(tok0 + n) * 2048 + h * 64 + 16 * kk + 8 * half);
        f32x16 o0, o1;
#pragma unroll
        for (int i = 0; i < 16; ++i) { o0[i] = 0.f; o1[i] = 0.f; }
        float R = 0.f;
        for (int kt = qt; kt >= 0; --kt) {
            const int key0 = b * SEQ + kt * 32;
            bf16x8 kf[4];
#pragma unroll
            for (int kk = 0; kk < 4; ++kk) kf[kk] = *(const bf16x8*)(QK + (size_t)(key0 + n) * 2048 + 1024 + h * 64 + 16 * kk + 8 * half);
            u32x2 vlo[2][2], vhi[2][2];
#pragma unroll
            for (int dd = 0; dd < 2; ++dd)
#pragma unroll
                for (int s = 0; s < 2; ++s) { const bf16_t* vp = VT + (size_t)(h * 64 + 32 * dd + n) * T + key0 + 16 * s + 4 * half; vlo[dd][s] = *(const u32x2*)vp; vhi[dd][s] = *(const u32x2*)(vp + 8); }
            f32x16 sa;
#pragma unroll
            for (int i = 0; i < 16; ++i) sa[i] = 0.f;
#pragma unroll
            for (int kk = 0; kk < 4; ++kk) sa = MFMA32(kf[kk], qf[kk], sa);
            const bool diag = (kt == qt);
            float Lv[16], go[4], gp[4];
#pragma unroll
            for (int r = 0; r < 16; ++r) { const float w = sa[r]; const int m = (r & 3) + 8 * (r >> 2) + 4 * half; const bool valid = !diag || (m < n);
                const float sp = fmaxf(w, 0.f) + fast_log2(1.f + fast_exp2(-fabsf(w))); Lv[r] = valid ? -sp : 0.f; sa[r] = valid ? w : -1.0e30f; }
#pragma unroll
            for (int j = 0; j < 4; ++j) { go[j] = (Lv[4 * j] + Lv[4 * j + 1]) + (Lv[4 * j + 2] + Lv[4 * j + 3]); gp[j] = shx(go[j], 32, lane); }
            float G[4]; G[3] = 0.f; G[2] = go[3] + gp[3]; G[1] = G[2] + (go[2] + gp[2]); G[0] = G[1] + (go[1] + gp[1]); const float tot = G[0] + (go[0] + gp[0]);
            float av[16];
#pragma unroll
            for (int j = 0; j < 4; ++j) { const float bs = R + G[j] + (half == 0 ? gp[j] : 0.f);
                const float s3 = 0.f, s2 = Lv[4 * j + 3], s1 = s2 + Lv[4 * j + 2], s0 = s1 + Lv[4 * j + 1];
                av[4 * j + 0] = fast_exp2(sa[4 * j + 0] + Lv[4 * j + 0] + bs + s0); av[4 * j + 1] = fast_exp2(sa[4 * j + 1] + Lv[4 * j + 1] + bs + s1);
                av[4 * j + 2] = fast_exp2(sa[4 * j + 2] + Lv[4 * j + 2] + bs + s2); av[4 * j + 3] = fast_exp2(sa[4 * j + 3] + Lv[4 * j + 3] + bs + s3); }
            R += tot;
#pragma unroll
            for (int s = 0; s < 2; ++s) { u32x4 pk; pk.x = cvtpk(av[8 * s + 0], av[8 * s + 1]); pk.y = cvtpk(av[8 * s + 2], av[8 * s + 3]); pk.z = cvtpk(av[8 * s + 4], av[8 * s + 5]); pk.w = cvtpk(av[8 * s + 6], av[8 * s + 7]);
                const bf16x8 pf = __builtin_bit_cast(bf16x8, pk);
                u32x4 v0; v0.x = vlo[0][s].x; v0.y = vlo[0][s].y; v0.z = vhi[0][s].x; v0.w = vhi[0][s].y; u32x4 v1; v1.x = vlo[1][s].x; v1.y = vlo[1][s].y; v1.z = vhi[1][s].x; v1.w = vhi[1][s].y;
                o0 = MFMA32(__builtin_bit_cast(bf16x8, v0), pf, o0); o1 = MFMA32(__builtin_bit_cast(bf16x8, v1), pf, o1); }
            if (__ballot(R >= -150.f) == 0ull) break;
        }
#pragma unroll
        for (int j = 0; j < 4; ++j) { u32x2 w0, w1; w0.x = cvtpk(o0[4 * j], o0[4 * j + 1]); w0.y = cvtpk(o0[4 * j + 2], o0[4 * j + 3]); w1.x = cvtpk(o1[4 * j], o1[4 * j + 1]); w1.y = cvtpk(o1[4 * j + 2], o1[4 * j + 3]);
            bf16_t* op = O + (size_t)(tok0 + n) * opitch + h * 64 + 8 * j + 4 * half; *(u32x2*)op = w0; *(u32x2*)(op + 32) = w1; }
    }
}

__global__ void __launch_bounds__(512, 2) mega(P p) {
    extern __shared__ __attribute__((aligned(16))) unsigned char lds_raw[];
    LAS unsigned char* lds = (LAS unsigned char*)lds_raw;
    LAS float* xl = (LAS float*)(lds + XLDS_OFF);
    cg::grid_group grid = cg::this_grid();
    const int wv = __builtin_amdgcn_readfirstlane((int)threadIdx.x >> 6);
    unsigned char* ws = p.ws;
    float* RS = MK_LO ? (float*)(ws + OFF_RS) : p.out; const float* MSQ = RS + (size_t)13 * T * RSN;
    bf16_t* Wb = (bf16_t*)(ws + OFF_W); bf16_t* HB = (bf16_t*)(ws + OFF_HB); bf16_t* MB = (bf16_t*)(ws + OFF_MEMB);
    bf16_t* KVm = (bf16_t*)(ws + OFF_KV); bf16_t* MT = (bf16_t*)(ws + OFF_MT); bf16_t* NT = (bf16_t*)(ws + OFF_NT);
    unsigned char* scr = ws + OFF_SCR;
    bf16_t* LO = (bf16_t*)p.out;
    unsigned* CNT = (unsigned*)ws + 8192;
    int ph = 0;
#define PH_BEGIN if (ph >= p.lo && ph < p.hi) {
#ifndef DUP
#define DUP 0
#endif
#if HYBRID
#define GRID_SYNC() grid.sync()
#else
    if (otid(wv) == 0) { ((volatile LAS unsigned*)(lds + XLDS_OFF + 12288))[0] = 0u; ((volatile LAS unsigned*)(lds + XLDS_OFF + 12288))[1] = 0u; }
    __syncthreads();
    (void)xcd_barrier_post((unsigned*)p.ws + 1024, (volatile LAS unsigned*)(lds + XLDS_OFF + 12288));
    if (p.lo < 0) grid.sync();
#define GRID_SYNC() do { XcdBarrier xb_; xb_.bar = (unsigned*)p.ws + 1024; xb_.x = xb_xcc_id(); xb_.st = (volatile LAS unsigned*)(lds + XLDS_OFF + 12288); xcd_barrier(xb_); } while (0)
#endif
#define PH_END_NOSYNC } ++ph;
#define PH_END } ++ph; if (ph > p.lo && ph < p.hi) { GRID_SYNC(); if (DUP == 3) GRID_SYNC(); }

    PH_BEGIN prologue(p, lds, wv); if (DUP == 2) { __syncthreads(); prologue(p, lds, wv); } PH_END
    PH_BEGIN
        Sched S; S.done_cnt = nullptr; S.wait_cnt = nullptr; S.wait_target = 0; S.done_kind = 0; S.wait_kind = 0; S.kind = 2; S.nM = 128; S.nN = 1; S.nwg = 128; S.G = gridDim.x; S.c = blockIdx.x; S.bdiv = 1; S.A = (const char*)MB; S.B = (const char*)(Wb + W_L0 + WL_KV);
        S.a_pm = S.a_pn = S.a_pb = S.b_pm = S.b_pn = 0; S.b_pb = (long)W_LSTRIDE * 2;
        EpiKV E{KVm, MSQ}; gemm_phase(lds, GemmDesc{D, D, D}, S, E, wv);
        pool_prep(p.in[0], HB, LO, RS, (bf16_t*)scr, wv);
    PH_END
    PH_BEGIN
        { Sched S; S.done_cnt = nullptr; S.wait_cnt = nullptr; S.wait_target = 0; S.done_kind = 0; S.wait_kind = 0; S.kind = 3; S.nM = 256; S.nN = 1; S.nwg = 256; S.G = gridDim.x; S.c = blockIdx.x; S.bdiv = 1; S.A = (const char*)KVm; S.B = (const char*)(ws + OFF_WQP);
          S.a_pm = S.a_pn = S.b_pm = S.b_pn = 0; S.a_pb = 1024L * 2048 * 2; S.b_pb = 1024L * 1024 * 2;
          EpiMN<0> E{MT}; gemm_phase(lds, GemmDesc{2048, D, 256}, S, E, wv); }
        { Sched S; S.done_cnt = nullptr; S.wait_cnt = nullptr; S.wait_target = 0; S.done_kind = 0; S.wait_kind = 0; S.kind = 4; S.nM = 256; S.nN = 1; S.nwg = 256; S.G = gridDim.x; S.c = blockIdx.x; S.bdiv = 1; S.A = (const char*)(Wb + W_L0 + WL_O); S.B = (const char*)KVm;
          S.a_pm = S.a_pn = S.b_pm = S.b_pn = 0; S.a_pb = (long)W_LSTRIDE * 2; S.b_pb = 1024L * 2048 * 2;
          EpiMN<1> E{NT}; gemm_phase(lds, GemmDesc{D, 2048, 256}, S, E, wv); }
        { Sched S = make_sched(64, 4, (bf16_t*)scr, 256L * D * 2, 256 * 2, Wb + W_PW, 0, 65536L * 2);
          EpiRes<0> E{p.in[0], HB, LO, RS + (size_t)1 * T * RSN, xl}; gemm_phase(lds, GemmDesc{D, 256, 256}, S, E, wv); }
    PH_END
    for (int i = 0; i < 4; ++i) {
        const int kind = i % 3, j = i / 3; bf16_t* WL = Wb + W_L0 + (size_t)i * W_LSTRIDE;
        float* rs_mix = RS + (size_t)(3 * i) * T * RSN; float* rs_xa = RS + (size_t)(3 * i + 1) * T * RSN; float* rs_ffn = RS + (size_t)(3 * i + 2) * T * RSN; float* rs_next = RS + (size_t)(3 * i + 3) * T * RSN;
        if (kind == 0) {
            bf16_t* PH = (bf16_t*)scr;
            const float* hin = (i == 0) ? p.in[0] : nullptr;
            if (i != 0) {
            PH_BEGIN pool_prep(hin, HB, LO, rs_mix, PH, wv); PH_END
            PH_BEGIN
                Sched S = make_sched(64, 4, PH, 256L * D * 2, 256 * 2, Wb + W_PW + (size_t)j * 4 * 65536, 0, 65536L * 2);
                EpiRes<0> E{hin, HB, LO, rs_xa, xl}; gemm_phase(lds, GemmDesc{D, 256, 256}, S, E, wv);
            PH_END
            }
        } else if (kind == 1) {
            bf16_t* QK = (bf16_t*)scr; bf16_t* VT = (bf16_t*)(scr + 64 * MiB);
            PH_BEGIN
                { Sched S = make_sched(64, 8, HB, 256L * D * 2, 0, Wb + W_QKV, 0, 256L * D * 2); EpiBf E{QK, 2048, 256L * 2048, 256, rs_mix, nullptr}; gemm_phase(lds, GemmDesc{D, D, D}, S, E, wv); }
                { Sched S = make_sched(4, 64, Wb + W_QKV + (size_t)2048 * D, 256L * D * 2, 0, HB, 0, 256L * D * 2); EpiBf E{VT, T, 256L * T, 256, nullptr, rs_mix}; gemm_phase(lds, GemmDesc{D, D, D}, S, E, wv); }
            PH_END
            PH_BEGIN sb_attn(QK, VT, QK, 2048, wv); PH_END
            PH_BEGIN
                Sched S = make_sched(64, 4, QK, 256L * 2048 * 2, 0, Wb + W_SO, 0, 256L * D * 2);
                EpiRes<0> E{nullptr, HB, LO, rs_xa, xl}; gemm_phase(lds, GemmDesc{2048, D, D}, S, E, wv);
            PH_END
        } else {
            bf16_t* Z = (bf16_t*)scr; float* Sst = (float*)(scr + 48 * MiB); bf16_t* Y = (bf16_t*)(scr + 48 * MiB);
            bf16_t* WB5 = (bf16_t*)(ws + OFF_S5WB); bf16_t* TW5 = (bf16_t*)(ws + OFF_S5TW);
            PH_BEGIN s5_zfill(HB, LO, rs_mix, p.in[2] + i * D, Z, wv); if (DUP == 9) s5_zfill(HB, LO, rs_mix, p.in[2] + i * D, Z, wv); PH_END
            PH_BEGIN
                Sched S = make_sched(256, 1, Z, 256L * 384 * 2, 0, WB5, 0, 0, 4, 0, 256L * 256 * 2);
                EpiS5S E{Sst}; gemm_phase(lds, GemmDesc{384, 256, 256}, S, E, wv); if (DUP == 9) gemm_phase(lds, GemmDesc{384, 256, 256}, S, E, wv);
            PH_END
            PH_BEGIN s5_scan(p, Sst, Z, j, wv); if (DUP == 7) s5_scan(p, Sst, Z, j, wv); PH_END
            PH_BEGIN
                Sched S = make_sched(256, 1, Z, 256L * 384 * 2, 0, TW5, 0, 0, 4, 0, 256L * 384 * 2);
                EpiS5Y E{Y, Z, p.in[14] + j * D}; gemm_phase(lds, GemmDesc{384, 384, 384}, S, E, wv); if (DUP == 9) gemm_phase(lds, GemmDesc{384, 384, 384}, S, E, wv);
            PH_END
            PH_BEGIN
                Sched S = make_sched(64, 8, Y, 256L * D * 2, 0, Wb + W_GLU, 0, 256L * D * 2);
                EpiRes<1> E{nullptr, HB, LO, rs_xa, xl}; gemm_phase(lds, GemmDesc{D, D, D}, S, E, wv);
            PH_END
        }
        {
            bf16_t* Pm = (bf16_t*)scr;
            PH_BEGIN
                Sched S = make_sched(64, 4, HB, 256L * D * 2, 0, MT + (size_t)i * 4 * 1024 * 1024, 0, 256L * D * 2, 16, 0, 1024L * 1024 * 2);
                if (!HYBRID) S.done_cnt = CNT + (i * 8 + 0) * 128;
                EpiSoftmax E{Pm, xl, rs_xa}; gemm_phase(lds, GemmDesc{D, D, D}, S, E, wv);
            PH_END_NOSYNC
            PH_BEGIN
                Sched S = make_sched(64, 4, Pm, 256L * D * 2, 0, NT + (size_t)i * 4 * 1024 * 1024, 0, 256L * D * 2, 16, 0, 1024L * 1024 * 2);
                if (!HYBRID) { S.wait_cnt = CNT + (i * 8 + 0) * 128; S.wait_target = 4; }
                EpiRes<0> E{nullptr, HB, LO, rs_ffn, xl}; gemm_phase(lds, GemmDesc{D, D, D}, S, E, wv);
            PH_END
        }
        {
            bf16_t* Gb = (bf16_t*)scr;
            PH_BEGIN
                Sched S; S.done_cnt = nullptr; S.wait_cnt = nullptr; S.wait_target = 0; S.done_kind = 0; S.wait_kind = 0; S.kind = 1; S.nM = 68; S.nN = 22; S.nwg = 68 * 22; S.G = gridDim.x; S.c = blockIdx.x; S.bdiv = 1; S.A = (const char*)HB; S.B = (const char*)(WL + WL_UP);
                S.a_pm = D * 2; S.a_pn = S.a_pb = S.b_pm = S.b_pb = 0; S.b_pn = 256L * D * 2;
                EpiConvGlu E{Gb, rs_ffn, p.in[23] + (size_t)i * 3 * 2 * FF, p.in[24] + (size_t)i * 2 * FF, xl}; gemm_phase(lds, GemmDesc{D, D, D}, S, E, wv); if (DUP == 1) gemm_phase(lds, GemmDesc{D, D, D}, S, E, wv);
            PH_END
            PH_BEGIN
                Sched S = make_sched(64, 4, Gb, 256L * FF * 2, 0, WL + WL_DN, 0, 256L * FF * 2);
                EpiRes<0> E{nullptr, HB, LO, rs_next, xl}; gemm_phase(lds, GemmDesc{FF, FF, FF}, S, E, wv);
            PH_END
        }
    }
    PH_BEGIN
        const int tid = otid(wv), lane = tid & 63, wave = tid >> 6; const int gw = blockIdx.x * 8 + wave, NGW = gridDim.x * 8;
        f32x4 fv[8][4]; float fr_[8];
#pragma unroll
        for (int k = 0; k < 8; ++k) { const int m = gw + k * NGW; float s = 0.f;
#pragma unroll
            for (int j = 0; j < 2; ++j) { if (m < T) load_hilo8(HB, LO, (size_t)m * D + 8 * lane + 512 * j, fv[k][2 * j], fv[k][2 * j + 1]); else { fv[k][2 * j] = (f32x4){0.f, 0.f, 0.f, 0.f}; fv[k][2 * j + 1] = fv[k][2 * j]; } }
#pragma unroll
            for (int j = 0; j < 4; ++j) s += (fv[k][j][0] * fv[k][j][0] + fv[k][j][1] * fv[k][j][1]) + (fv[k][j][2] * fv[k][j][2] + fv[k][j][3] * fv[k][j][3]);
            fr_[k] = rsqrtf(wave_sum(s, lane) * (1.f / D) + EPS); }
        if (MK_LO) GRID_SYNC();
#pragma unroll
        for (int k = 0; k < 8; ++k) { const int m = gw + k * NGW;
            if (m < T) {
#pragma unroll
                for (int j = 0; j < 4; ++j) { const int col = 8 * lane + 512 * (j >> 1) + 4 * (j & 1); const f32x4 gg = *(const f32x4*)(p.in[26] + col); *(f32x4*)(p.out + (size_t)m * D + col) = fv[k][j] * fr_[k] * gg; } } }
        for (int m = gw + 8 * NGW; m < T; m += NGW) { }
    PH_END
#undef PH_BEGIN
#undef PH_END
}
__global__ void __launch_bounds__(512) k_sync_state(const float* h, bf16_t* HB, float* rsq) { sync_state(h, HB, rsq, threadIdx.x >> 6); }
}
#ifndef OPT_MASK
#define OPT_MASK 63
#endif
#ifndef HYBRID
#define HYBRID 0
#endif
static void mega_launch(hipStream_t stream, mk::P p, int lo, int hi, int grid) {
    p.lo = lo; p.hi = hi; void* args[] = {&p};
    hipError_t e = hipLaunchCooperativeKernel((const void*)mk::mega, dim3(grid), dim3(512), args, mk::LDS_BYTES, stream);
    if (e != hipSuccess) fprintf(stderr, "cooperative launch failed: %s (grid %d)\n", hipGetErrorString(e), grid);
}
extern "C" void kernel_launch(void* const* d_in, const int* in_sizes, int n_in, void* d_out, int out_size, void* d_ws, size_t ws_size, hipStream_t stream) {
    static int grid = 0;
    if (grid == 0) {
        if (n_in != 27 || ws_size < mk::WS_NEED) { fprintf(stderr, "kernel_launch: unexpected n_in %d / ws %zu\n", n_in, ws_size); grid = -1; return; }
        int dev = 0, cus = 0, per_cu = 0;
        hipGetDevice(&dev); hipDeviceGetAttribute(&cus, hipDeviceAttributeMultiprocessorCount, dev);
        hipFuncSetAttribute((const void*)mk::mega, hipFuncAttributeMaxDynamicSharedMemorySize, mk::LDS_BYTES);
        hipOccupancyMaxActiveBlocksPerMultiprocessor(&per_cu, (const void*)mk::mega, 512, mk::LDS_BYTES);
        if (per_cu < 1) per_cu = 1;
        (void)hipGetLastError();
        grid = cus * per_cu;
    }
    if (grid < 0) return;
    mk::P p{}; for (int i = 0; i < 27; ++i) p.in[i] = (const float*)d_in[i];
    p.out = (float*)d_out; p.ws = (unsigned char*)d_ws;
#if !HYBRID
    hipMemsetAsync(d_ws, 0, 65536, stream);
    mega_launch(stream, p, 0, 1000, grid);
#else
    nv::In in{}; for (int i = 0; i < 27; ++i) in.p[i] = (const float*)d_in[i];
    float* h = (float*)d_out; float* scr = (float*)((unsigned char*)d_ws + mk::OFF_SCR);
    mega_launch(stream, p, 0, 2, grid);
    int ph = 2;
    for (int i = 0; i < 4; ++i) {
        const int kind = i % 3; const int nmix = kind == 0 ? 2 : kind == 1 ? 3 : 5;
        for (int sub = 0; sub < 3; ++sub) {
            const int np = sub == 0 ? nmix : sub == 1 ? 4 : 2; const int bit = sub == 0 ? kind : sub == 1 ? 3 : 4;
            if ((OPT_MASK >> bit) & 1) {
                mk::k_sync_state<<<256, 512, 0, stream>>>(h, (mk::bf16_t*)((unsigned char*)d_ws + mk::OFF_HB), (float*)((unsigned char*)d_ws + mk::OFF_RS) + (size_t)(3 * i + sub) * mk::T);
                mega_launch(stream, p, ph, ph + np, grid);
            } else nv::sublayer(stream, in, h, scr, i, sub);
            ph += np;
        }
    }
    if ((OPT_MASK >> 5) & 1) mega_launch(stream, p, 38, 39, grid); else nv::final_norm(stream, in, h);
#endif
}
```
